# Optimizing an MI355X kernel written in HIP

```python
import math
import jax
import jax.numpy as jnp
from jax import lax
import numpy as np


D_MODEL = 1024
BATCH = 2
SEQ = 8192
DEPTH = 2

GRID_W = 64
CTX_LEN = 256
N_MIXERS = 2
RMS_EPS = 1e-6

RW_HEAD = 64
RW_WIDTH = D_MODEL
RW_HEADS = RW_WIDTH // RW_HEAD
W_LORA = 64
A_LORA = 64
RW_IN_COLS = 4 * RW_WIDTH + 2 * (W_LORA + A_LORA)
RW_MIX_COLS = 3 * RW_WIDTH + 2 * (W_LORA + A_LORA)
GN_EPS = 64e-5

DA_HEADS = 8
DA_HEAD = 64
DA_VHEAD = 2 * DA_HEAD
DA_QW = DA_HEADS * 2 * DA_HEAD
DA_VW = DA_HEADS * DA_VHEAD
DA_GW = DA_VW
DA_IN_COLS = 2 * DA_QW + DA_VW + DA_GW
SUBLN_EPS = 1e-5
ROPE_THETA = 10000.0
ROPE_FREQS = DA_HEAD // 4
Q_BLOCK = 128

N_A = (DEPTH + 1) // 2
N_B = DEPTH // 2

kernel_name = "hybrid_rwkv7_diffattn_prefix_flow_block"


def rms_norm(x, g, eps=RMS_EPS):
    xf = x.astype(jnp.float32)
    y = xf * lax.rsqrt(jnp.mean(xf * xf, axis=-1, keepdims=True) + eps)
    return (y * g.astype(jnp.float32)).astype(x.dtype)


def centred_token_shift(u, mu):
    prev = jnp.pad(u[:, :-1], ((0, 0), (1, 0), (0, 0)))
    nxt = jnp.pad(u[:, 1:], ((0, 0), (0, 1), (0, 0)))
    return u + mu * (0.5 * (prev + nxt) - u)


def rwkv7_streams(h, w_in, mu, w0, w2, a0, a2, k_k, k_a):
    B, T, _ = h.shape
    C = RW_WIDTH
    heads = lambda t: t.reshape(t.shape[:-1] + (RW_HEADS, RW_HEAD))
    proj = (h @ w_in).astype(jnp.float32)
    g = proj[..., 3 * C:4 * C]
    mixed = centred_token_shift(
        jnp.concatenate([proj[..., :3 * C], proj[..., 4 * C:]], axis=-1), mu.astype(jnp.float32))
    r, k, v = mixed[..., :C], mixed[..., C:2 * C], mixed[..., 2 * C:3 * C]
    lw = mixed[..., 3 * C:3 * C + 2 * W_LORA].reshape(B, T, 2, W_LORA)
    la = mixed[..., 3 * C + 2 * W_LORA:].reshape(B, T, 2, A_LORA)
    w_raw = w0 + jnp.einsum("btdr,drc->btdc", jnp.tanh(lw), w2)
    decay = jnp.exp(-jnp.exp(-jax.nn.softplus(-w_raw) - 0.5))
    a = jax.nn.sigmoid(a0 + jnp.einsum("btdr,drc->btdc", la, a2))
    kk = heads(k * k_k)
    kk = kk * lax.rsqrt(jnp.sum(kk * kk, axis=-1, keepdims=True) + 1e-12)
    kd = k[:, :, None, :] * (1.0 + (a - 1.0) * k_a)
    return heads(r), heads(v), kk, heads(decay), heads(a), heads(kd), g


def wkv_scan(r, w, k, v, kk, a, s0, reverse):
    xs = tuple(jnp.moveaxis(t, 1, 0) for t in (r, w, k, v, kk, a))

    def step(S, inp):
        r_t, w_t, k_t, v_t, kk_t, a_t = inp
        sa = jnp.einsum("bhvk,bhk->bhv", S, kk_t)
        S = (S * w_t[:, :, None, :]
             - sa[..., None] * (kk_t * a_t)[:, :, None, :]
             + v_t[..., None] * k_t[:, :, None, :])
        return S, jnp.einsum("bhvk,bhk->bhv", S, r_t)

    s_fin, o = lax.scan(step, s0, xs, reverse=reverse)
    return jnp.moveaxis(o, 0, 1), s_fin


def scan_direction(streams, d, s0, reverse):
    r, v, kk, decay, a, kd, _ = streams
    return wkv_scan(r, decay[:, :, d], kd[:, :, d], v, kk, a[:, :, d], s0, reverse)


def rwkv7_readout(o, streams, r_k, gn_g, gn_b, w_out, out_dtype):
    r, v, _, _, _, kd, g = streams
    B, T = o.shape[:2]
    mean = jnp.mean(o, axis=-1, keepdims=True)
    var = jnp.mean(jnp.square(o - mean), axis=-1, keepdims=True)
    y = ((o - mean) * lax.rsqrt(var + GN_EPS)).reshape(B, T, RW_WIDTH) * gn_g + gn_b
    bonus = jnp.sum(jnp.sum(r[:, :, None] * kd * r_k, axis=-1, keepdims=True) * v[:, :, None], axis=2)
    y = (y + bonus.reshape(B, T, RW_WIDTH)) * jax.nn.silu(g)
    return y.astype(out_dtype) @ w_out


def rwkv7_mixer(h, hc, w_in, mu, w0, w2, a0, a2, k_k, k_a, r_k, gn_g, gn_b, w_out, ctx_out):
    lat = rwkv7_streams(h, w_in, mu, w0, w2, a0, a2, k_k, k_a)
    con = rwkv7_streams(hc, w_in, mu, w0, w2, a0, a2, k_k, k_a)
    s0 = jnp.zeros((h.shape[0], RW_HEADS, RW_HEAD, RW_HEAD), jnp.float32)
    oc_f, sc_f = scan_direction(con, 0, s0, False)
    oc_b, sc_b = scan_direction(con, 1, s0, True)
    ol_f, _ = scan_direction(lat, 0, sc_f, False)
    ol_b, _ = scan_direction(lat, 1, sc_b, True)
    y = rwkv7_readout(ol_f + ol_b, lat, r_k, gn_g, gn_b, w_out, h.dtype)
    yc = rwkv7_readout(oc_f + oc_b, con, r_k, gn_g, gn_b, w_out, hc.dtype) if ctx_out else None
    return y, yc


def axial_rope_tables(rows):
    row_ids = jnp.repeat(jnp.arange(rows), GRID_W).astype(jnp.float32)
    col_ids = jnp.tile(jnp.arange(GRID_W), rows).astype(jnp.float32)
    inv_freq = ROPE_THETA ** (-jnp.arange(ROPE_FREQS, dtype=jnp.float32) / ROPE_FREQS)
    ang = jnp.stack([row_ids[:, None] * inv_freq, col_ids[:, None] * inv_freq], axis=1)
    return jnp.cos(ang), jnp.sin(ang)


def apply_axial_rope(x, cos, sin):
    xr = x.reshape(x.shape[:-1] + (2, 2, ROPE_FREQS))
    x1, x2 = xr[..., 0, :], xr[..., 1, :]
    c = cos[None, :, None, None].astype(x.dtype)
    s = sin[None, :, None, None].astype(x.dtype)
    out = jnp.stack([x1 * c - x2 * s, x2 * c + x1 * s], axis=-2)
    return out.reshape(x.shape)


def diff_attention_blocks(q, k_all, v_all, lam):
    B, T = q.shape[:2]
    nb = T // Q_BLOCK
    qb = jnp.moveaxis(q.reshape((B, nb, Q_BLOCK) + q.shape[2:]), 1, 0)
    scale = DA_HEAD ** -0.5

    def block(q_blk):
        s = jnp.einsum("bqhcd,bkhcd->bchqk", q_blk, k_all).astype(jnp.float32) * scale
        p = jax.nn.softmax(s, axis=-1)
        attn = p[:, 0] - lam * p[:, 1]
        return jnp.einsum("bhqk,bkhe->bqhe", attn.astype(v_all.dtype), v_all)

    o = lax.map(block, qb)
    return jnp.moveaxis(o, 0, 1).reshape(B, T, DA_HEADS, DA_VHEAD)


def diff_finish(o, g, subln, lam_init, w_out):
    B, T = o.shape[:2]
    y = rms_norm(o, subln, SUBLN_EPS) * (1.0 - lam_init)
    return (y.reshape(B, T, DA_VW) * jax.nn.silu(g)) @ w_out


def diff_mixer(h, hc, layer_idx, w_in, qn, kn, lam_vecs, subln, w_out, cos, sin, ctx_out):
    B, T, _ = h.shape
    Lc = hc.shape[1]
    lam_init = 0.8 - 0.6 * math.exp(-0.3 * layer_idx)
    lv = lam_vecs.astype(jnp.float32)
    lam = jnp.exp(jnp.sum(lv[0] * lv[1])) - jnp.exp(jnp.sum(lv[2] * lv[3])) + lam_init
    proj = h @ w_in
    q = apply_axial_rope(rms_norm(proj[..., :DA_QW].reshape(B, T, DA_HEADS, 2, DA_HEAD), qn), cos, sin)
    k = apply_axial_rope(rms_norm(proj[..., DA_QW:2 * DA_QW].reshape(B, T, DA_HEADS, 2, DA_HEAD), kn), cos, sin)
    v = proj[..., 2 * DA_QW:2 * DA_QW + DA_VW].reshape(B, T, DA_HEADS, DA_VHEAD)
    g = proj[..., 2 * DA_QW + DA_VW:]
    if ctx_out:
        pc = hc @ w_in
        kvc = pc[..., DA_QW:2 * DA_QW + DA_VW]
    else:
        kvc = hc @ w_in[:, DA_QW:2 * DA_QW + DA_VW]
    kc = rms_norm(kvc[..., :DA_QW].reshape(B, Lc, DA_HEADS, 2, DA_HEAD), kn)
    vc = kvc[..., DA_QW:].reshape(B, Lc, DA_HEADS, DA_VHEAD)
    k_all = jnp.concatenate([kc, k], axis=1)
    v_all = jnp.concatenate([vc, v], axis=1)
    y = diff_finish(diff_attention_blocks(q, k_all, v_all, lam), g, subln, lam_init, w_out)
    yc = None
    if ctx_out:
        qc = rms_norm(pc[..., :DA_QW].reshape(B, Lc, DA_HEADS, 2, DA_HEAD), qn)
        yc = diff_finish(diff_attention_blocks(qc, kc, vc, lam), pc[..., 2 * DA_QW + DA_VW:],
                         subln, lam_init, w_out)
    return y, yc


def setup_inputs(seed: int = 0) -> dict:
    key = jax.random.key(seed)
    ks = jax.random.split(key, 26)
    f32 = jnp.float32
    nrm = lambda k, shape, s: jax.random.normal(k, shape, f32) * s
    D = D_MODEL
    return {
        "x": nrm(ks[0], (BATCH, SEQ, D), 1.0),
        "c": nrm(ks[1], (BATCH, D), 1.0),
        "ctx": nrm(ks[2], (BATCH, CTX_LEN, D), 1.0),
        "c_ctx": nrm(ks[3], (D,), 1.0),
        "ada_w": nrm(ks[4], (DEPTH, D, 3 * D), 0.5 * D ** -0.5),
        "ada_b": nrm(ks[5], (DEPTH, 3 * D), 0.02),
        "norm_g": 1.0 + nrm(ks[6], (DEPTH, D), 0.02),
        "rw_in": nrm(ks[7], (N_A, D, RW_IN_COLS), D ** -0.5),
        "rw_mu": jax.random.uniform(ks[8], (N_A, RW_MIX_COLS), f32),
        "rw_w0": jax.random.uniform(ks[9], (N_A, 2, RW_WIDTH), f32, minval=-6.0, maxval=-1.0),
        "rw_w2": nrm(ks[10], (N_A, 2, W_LORA, RW_WIDTH), 0.1 * W_LORA ** -0.5),
        "rw_a0": nrm(ks[11], (N_A, 2, RW_WIDTH), 0.1),
        "rw_a2": nrm(ks[12], (N_A, 2, A_LORA, RW_WIDTH), 0.1 * A_LORA ** -0.5),
        "rw_kk": 0.85 + nrm(ks[13], (N_A, RW_WIDTH), 0.05),
        "rw_ka": 1.0 + nrm(ks[14], (N_A, RW_WIDTH), 0.05),
        "rw_rk": nrm(ks[15], (N_A, RW_HEADS, RW_HEAD), 0.1),
        "rw_gn_g": 1.0 + nrm(ks[16], (N_A, RW_WIDTH), 0.02),
        "rw_gn_b": nrm(ks[17], (N_A, RW_WIDTH), 0.02),
        "rw_out": nrm(ks[18], (N_A, RW_WIDTH, D), RW_WIDTH ** -0.5),
        "da_in": nrm(ks[19], (N_B, D, DA_IN_COLS), D ** -0.5),
        "da_qn": 1.0 + nrm(ks[20], (N_B, DA_HEAD), 0.02),
        "da_kn": 1.0 + nrm(ks[21], (N_B, DA_HEAD), 0.02),
        "da_lam": nrm(ks[22], (N_B, 4, DA_HEAD), 0.1),
        "da_subln": 1.0 + nrm(ks[23], (N_B, DA_VHEAD), 0.02),
        "da_out": nrm(ks[24], (N_B, DA_VW, D), DA_VW ** -0.5),
    }


def reference(x, c, ctx, c_ctx, ada_w, ada_b, norm_g, rw_in, rw_mu, rw_w0, rw_w2, rw_a0, rw_a2,
              rw_kk, rw_ka, rw_rk, rw_gn_g, rw_gn_b, rw_out, da_in, da_qn, da_kn, da_lam,
              da_subln, da_out):
    n_lat = x.shape[1]
    rows = n_lat // GRID_W
    cos, sin = axial_rope_tables(rows)
    xc = ctx
    for i in range(DEPTH):
        last = i == DEPTH - 1
        j = i // N_MIXERS
        mod = jax.nn.silu(c) @ ada_w[i] + ada_b[i]
        shift, scale, gate = jnp.split(mod[:, None, :], 3, axis=-1)
        modc = jax.nn.silu(c_ctx) @ ada_w[i] + ada_b[i]
        shift_c, scale_c, gate_c = jnp.split(modc, 3)
        h = rms_norm(x, norm_g[i]) * (1.0 + scale) + shift
        hc = rms_norm(xc, norm_g[i]) * (1.0 + scale_c) + shift_c
        if i % N_MIXERS == 0:
            y, yc = rwkv7_mixer(h, hc, rw_in[j], rw_mu[j], rw_w0[j], rw_w2[j], rw_a0[j], rw_a2[j],
                                rw_kk[j], rw_ka[j], rw_rk[j], rw_gn_g[j], rw_gn_b[j], rw_out[j],
                                not last)
        else:
            y, yc = diff_mixer(h, hc, i, da_in[j], da_qn[j], da_kn[j], da_lam[j], da_subln[j],
                               da_out[j], cos, sin, not last)
        x = x + gate * y
        if not last:
            xc = xc + gate_c * yc
    return x
```

```cpp
#include <hip/hip_runtime.h>
#include <hip/hip_cooperative_groups.h>
#include <cstdio>
namespace cg = cooperative_groups;

#define DI __device__ __forceinline__
typedef unsigned short u16;
using bf16x8 = __attribute__((ext_vector_type(8))) short;
using s16x4  = __attribute__((ext_vector_type(4))) short;
using f32x16 = __attribute__((ext_vector_type(16))) float;
using f32x4  = __attribute__((ext_vector_type(4))) float;
using f32x32 = __attribute__((ext_vector_type(32))) float;
using f2     = __attribute__((ext_vector_type(2))) float;
using u32x4  = __attribute__((ext_vector_type(4))) unsigned;
using u32x2  = __attribute__((ext_vector_type(2))) unsigned;

constexpr int T_LAT = 16384, T_CTX = 512, T_ALL = 16896, DM = 1024;
constexpr int N0 = 4352, N1 = 4096;
constexpr int LKV = 8448;
constexpr int NCHUNK = 32, LCH = 264, NSUB = 33;

constexpr size_t MiB = 1048576;
constexpr size_t OFF_WT_IN0 = 0;
constexpr size_t OFF_WT_OUT0 = 8912896;
constexpr size_t OFF_WT_IN1 = 11010048;
constexpr size_t OFF_WT_OUT1 = 19398656;
constexpr size_t OFF_W2T = 21495808;
constexpr size_t OFF_A2T = 21757952;
constexpr size_t OFF_MOD = 21 * MiB;
constexpr size_t OFF_ROPE = OFF_MOD + 73728;
constexpr size_t OFF_BONUS = 21 * MiB + 131072;
constexpr size_t OFF_XC1 = 24 * MiB;
constexpr size_t OFF_OCTX = 26 * MiB;
constexpr size_t OFF_BAR = 29 * MiB;
constexpr size_t OFF_PROJ = 30 * MiB;
constexpr size_t OFF_HB = 171 * MiB;
constexpr size_t OFF_STP = 171 * MiB;
constexpr size_t OFF_STS = 203 * MiB;
constexpr size_t OFF_RAW = 30 * MiB;
constexpr size_t OFF_VT = 96 * MiB;
constexpr size_t OFF_KS = 129 * MiB;
constexpr size_t OFF_GB = 204 * MiB;
constexpr size_t OFF_QS = OFF_HB;
constexpr size_t OFF_Y2 = OFF_RAW;

constexpr int LDS_BYTES = 78336;

struct Params {
  const float *x, *c, *ctx, *c_ctx, *ada_w, *ada_b, *norm_g, *rw_in, *rw_mu, *rw_w0, *rw_w2, *rw_a0, *rw_a2,
      *rw_kk, *rw_ka, *rw_rk, *rw_gn_g, *rw_gn_b, *rw_out, *da_in, *da_qn, *da_kn, *da_lam, *da_subln, *da_out;
  float* out;
  char* ws;
};

DI u16 f2bf(float x) { unsigned u = __float_as_uint(x); u += 0x7fffu + ((u >> 16) & 1u); return (u16)(u >> 16); }
DI float bf2f(u16 h) { return __uint_as_float(((unsigned)h) << 16); }
DI unsigned pack2(float a, float b) { return (unsigned)f2bf(a) | ((unsigned)f2bf(b) << 16); }
typedef __bf16 bf16v2 __attribute__((ext_vector_type(2)));
DI unsigned cvtpk(float a, float b) { f2 v = {a, b}; return __builtin_bit_cast(unsigned, __builtin_convertvector(v, bf16v2)); }
DI float fsig(float x) { return __builtin_amdgcn_rcpf(1.0f + __expf(-x)); }
DI int ltid() { int t = threadIdx.x; asm volatile("" : "+v"(t)); return t; }
DI float bflo(unsigned u) { return __uint_as_float(u << 16); }
DI float bfhi(unsigned u) { return __uint_as_float(u & 0xffff0000u); }
DI float sigmoidf_(float x) { return 1.0f / (1.0f + __expf(-x)); }
DI float siluf_(float x) { return x * sigmoidf_(x); }
DI int crow(int i, int h) { return (i & 3) + 8 * (i >> 2) + 4 * h; }
DI void unpack8(const u32x4& u, float* f) {
  f[0] = bflo(u[0]); f[1] = bfhi(u[0]); f[2] = bflo(u[1]); f[3] = bfhi(u[1]);
  f[4] = bflo(u[2]); f[5] = bfhi(u[2]); f[6] = bflo(u[3]); f[7] = bfhi(u[3]);
}
#define WAVE_LDS_SYNC() asm volatile("s_waitcnt lgkmcnt(0)" ::: "memory")
#define MFMA32(a, b, c) __builtin_amdgcn_mfma_f32_32x32x16_bf16((a), (b), (c), 0, 0, 0)
#define MFMA16(a, b, c) __builtin_amdgcn_mfma_f32_16x16x32_bf16((a), (b), (c), 0, 0, 0)

__device__ const float INV_FREQ[16] = {
    1.0f, 0.5623413251903491f, 0.31622776601683794f, 0.1778279410038923f, 0.1f, 0.05623413251903491f,
    0.03162277660168379f, 0.01778279410038923f, 0.01f, 0.005623413251903491f, 0.0031622776601683794f,
    0.001778279410038923f, 0.001f, 0.0005623413251903491f, 0.00031622776601683794f, 0.0001778279410038923f};

DI void transpose_tile(const float* __restrict__ src, u16* __restrict__ dst, int K, int N, int kt, int nt, float* tile) {
  const int TIDX = ltid();
  const int tid = TIDX;
  {
    const int n = tid & 63, k0 = tid >> 6;
#pragma unroll
    for (int i = 0; i < 16; ++i) {
      const int k = k0 + 4 * i;
      tile[k * 65 + n] = src[(size_t)(kt * 64 + k) * N + nt * 64 + n];
    }
  }
  __syncthreads();
  {
    const int n = tid >> 2, kq = tid & 3;
    unsigned pk[8];
#pragma unroll
    for (int j = 0; j < 8; ++j) pk[j] = pack2(tile[(kq * 16 + 2 * j) * 65 + n], tile[(kq * 16 + 2 * j + 1) * 65 + n]);
    u32x4* d = (u32x4*)(dst + (size_t)(nt * 64 + n) * K + kt * 64 + kq * 16);
    d[0] = u32x4{pk[0], pk[1], pk[2], pk[3]};
    d[1] = u32x4{pk[4], pk[5], pk[6], pk[7]};
  }
  __syncthreads();
}

DI void phase_prep(const Params& p, char* smem) {
  const int TIDX = ltid();
  float* tile = (float*)smem;
  const int tid = TIDX;
  constexpr int T_IN0 = 16 * 68, T_OUT = 256, T_IN1 = 16 * 64, T_LORA = 16;
  constexpr int E0 = T_IN0, E1 = E0 + T_OUT, E2 = E1 + T_IN1, E3 = E2 + T_OUT, E4 = E3 + 2 * T_LORA, E5 = E4 + 2 * T_LORA;
  constexpr int NMOD = 192;
  constexpr int TOTAL = E5 + NMOD + 1;
  for (int it = blockIdx.x; it < TOTAL; it += gridDim.x) {
    if (it < E0) { transpose_tile(p.rw_in, (u16*)(p.ws + OFF_WT_IN0), 1024, N0, it / 68, it % 68, tile); }
    else if (it < E1) { int j = it - E0; transpose_tile(p.rw_out, (u16*)(p.ws + OFF_WT_OUT0), 1024, 1024, j >> 4, j & 15, tile); }
    else if (it < E3) {   }
    else if (it < E4) { int j = it - E3; int d = j >> 4; transpose_tile(p.rw_w2 + (size_t)d * 65536, (u16*)(p.ws + OFF_W2T) + (size_t)d * 65536, 64, 1024, 0, j & 15, tile); }
    else if (it < E5) { int j = it - E4; int d = j >> 4; transpose_tile(p.rw_a2 + (size_t)d * 65536, (u16*)(p.ws + OFF_A2T) + (size_t)d * 65536, 64, 1024, 0, j & 15, tile); }
    else if (it < E5 + NMOD) {
      const int j = it - E5; const int layer = j / 96; const int nb = (j % 96) * 32;
      const int n = nb + (tid & 31), kg = tid >> 5;
      const float* W = p.ada_w + (size_t)layer * 1024 * 3072;
      float a0 = 0.f, a1 = 0.f, a2 = 0.f;
#pragma unroll 8
      for (int k = kg * 128; k < kg * 128 + 128; ++k) {
        const float w = W[(size_t)k * 3072 + n];
        a0 += siluf_(p.c[k]) * w; a1 += siluf_(p.c[1024 + k]) * w; a2 += siluf_(p.c_ctx[k]) * w;
      }
      tile[(kg * 3 + 0) * 32 + (tid & 31)] = a0; tile[(kg * 3 + 1) * 32 + (tid & 31)] = a1; tile[(kg * 3 + 2) * 32 + (tid & 31)] = a2;
      __syncthreads();
      if (tid < 96) {
        const int s = tid >> 5, nn = tid & 31;
        float acc = p.ada_b[layer * 3072 + nb + nn];
#pragma unroll
        for (int g = 0; g < 8; ++g) acc += tile[(g * 3 + s) * 32 + nn];
        ((float*)(p.ws + OFF_MOD))[(layer * 3 + s) * 3072 + nb + nn] = acc;
      }
      __syncthreads();
    } else {
      float* rope = (float*)(p.ws + OFF_ROPE);
      for (int e = tid; e < 2048; e += 256) {
        const int pos = e >> 4, f = e & 15;
        const float ang = (float)pos * INV_FREQ[f];
        const float rev = ang * 0.15915494309189535f;
        const float fr = rev - rintf(rev);
        const float a = fr * 6.283185307179586f;
        rope[e] = __cosf(a); rope[2048 + e] = __sinf(a);
      }
    }
  }
}

DI void phase_normmod(const Params& p, int layer, const float* __restrict__ xl, const float* __restrict__ xc, bool zero_o) {
  const int TIDX = ltid();
  const int lane = TIDX & 63, wv = __builtin_amdgcn_readfirstlane(TIDX >> 6);
  const float* mod = (const float*)(p.ws + OFF_MOD) + layer * 3 * 3072;
  const float* g = p.norm_g + layer * 1024;
  u16* hb = (u16*)(p.ws + OFF_HB);
  for (int row = blockIdx.x * 4 + wv; row < T_ALL; row += gridDim.x * 4) {
    const float* src; const float* m;
    if (row < T_LAT) { src = xl + (size_t)row * 1024; m = mod + (row >> 13) * 3072; }
    else { src = xc + (size_t)(row - T_LAT) * 1024; m = mod + 2 * 3072; }
    float v[16];
    float ss = 0.f;
#pragma unroll
    for (int q = 0; q < 4; ++q) {
      const f32x4 t = *(const f32x4*)(src + lane * 16 + q * 4);
      v[q * 4] = t[0]; v[q * 4 + 1] = t[1]; v[q * 4 + 2] = t[2]; v[q * 4 + 3] = t[3];
      ss += t[0] * t[0] + t[1] * t[1] + t[2] * t[2] + t[3] * t[3];
    }
#pragma unroll
    for (int o = 32; o >= 1; o >>= 1) ss += __shfl_xor(ss, o);
    const float rstd = rsqrtf(ss * (1.0f / 1024.0f) + 1e-6f);
    unsigned pk[8];
#pragma unroll
    for (int j = 0; j < 8; ++j) {
      const int c0 = lane * 16 + 2 * j;
      const float h0 = v[2 * j] * rstd * g[c0] * (1.0f + m[1024 + c0]) + m[c0];
      const float h1 = v[2 * j + 1] * rstd * g[c0 + 1] * (1.0f + m[1024 + c0 + 1]) + m[c0 + 1];
      pk[j] = pack2(h0, h1);
    }
    u32x4* d = (u32x4*)(hb + (size_t)row * 1024 + lane * 16);
    d[0] = u32x4{pk[0], pk[1], pk[2], pk[3]};
    d[1] = u32x4{pk[4], pk[5], pk[6], pk[7]};
    if (zero_o) {
      float* o = (row < T_LAT) ? (p.out + (size_t)row * 1024) : ((float*)(p.ws + OFF_OCTX) + (size_t)(row - T_LAT) * 1024);
      const f32x4 z = {0.f, 0.f, 0.f, 0.f};
#pragma unroll
      for (int q = 0; q < 4; ++q) *(f32x4*)(o + lane * 16 + q * 4) = z;
    }
  }
}

constexpr int LDT = 72;
#ifndef REP_GEMM
#define REP_GEMM 1
#endif
#ifndef REP_SCAN
#define REP_SCAN 1
#endif
#ifndef REP_ATTN
#define REP_ATTN 1
#endif
template <int EPI>
DI void phase_gemm(const Params& p, char* smem, const u16* __restrict__ A, const u16* __restrict__ Bt, int Mtiles, int Ntiles) {
  const int TIDX = ltid();
  u16* As0 = (u16*)smem;
  const int tid = TIDX, lane = tid & 63, wv = __builtin_amdgcn_readfirstlane(tid >> 6);
  const int r = lane & 31, h = lane >> 5;
  const int wm = wv >> 1, wn = wv & 1;
  const int ntiles = Mtiles * Ntiles;
  const int npad = (ntiles + 511) & ~511;
  int repg = (EPI == 0 || EPI == 2) ? REP_GEMM : 1; asm volatile("" : "+s"(repg));
  for (int rp = 0; rp < repg; ++rp)
  for (int tt = blockIdx.x; tt < npad; tt += gridDim.x) {
    const int tile = (tt & ~511) + ((tt & 7) << 6) + ((tt >> 3) & 63);
    if (tile >= ntiles) continue;
    const int band = tile / (4 * Ntiles), rem = tile % (4 * Ntiles);
    const int mt_ = band * 4 + (rem & 3), nt_ = rem >> 2;
    const int m0 = mt_ * 128, n0 = nt_ * 128;
    f32x16 acc[2][2];
#pragma unroll
    for (int a = 0; a < 2; ++a)
#pragma unroll
      for (int b = 0; b < 2; ++b)
#pragma unroll
        for (int i = 0; i < 16; ++i) acc[a][b][i] = 0.f;
    u32x4 ra[4], rb[4];
    const u16* Ag = A + (size_t)m0 * 1024;
    const u16* Bg = Bt + (size_t)n0 * 1024;
#pragma unroll
    for (int i = 0; i < 4; ++i) {
      const int id = tid + 256 * i; const int row = id >> 3, cc = id & 7;
      ra[i] = *(const u32x4*)(Ag + (size_t)row * 1024 + cc * 8);
      rb[i] = *(const u32x4*)(Bg + (size_t)row * 1024 + cc * 8);
    }
    __syncthreads();
    for (int kt = 0; kt < 16; ++kt) {
      u16* As = As0 + (kt & 1) * (256 * LDT);
      u16* Bs = As + 128 * LDT;
#pragma unroll
      for (int i = 0; i < 4; ++i) {
        const int id = tid + 256 * i; const int row = id >> 3, cc = id & 7;
        *(u32x4*)(As + row * LDT + cc * 8) = ra[i];
        *(u32x4*)(Bs + row * LDT + cc * 8) = rb[i];
      }
      __syncthreads();
      if (kt + 1 < 16) {
#pragma unroll
        for (int i = 0; i < 4; ++i) {
          const int id = tid + 256 * i; const int row = id >> 3, cc = id & 7;
          ra[i] = *(const u32x4*)(Ag + (size_t)row * 1024 + (kt + 1) * 64 + cc * 8);
          rb[i] = *(const u32x4*)(Bg + (size_t)row * 1024 + (kt + 1) * 64 + cc * 8);
        }
      }
#pragma unroll
      for (int ks = 0; ks < 4; ++ks) {
        bf16x8 fa[2], fb[2];
#pragma unroll
        for (int t = 0; t < 2; ++t) {
          fa[t] = *(const bf16x8*)(As + (wm * 64 + t * 32 + r) * LDT + ks * 16 + 8 * h);
          fb[t] = *(const bf16x8*)(Bs + (wn * 64 + t * 32 + r) * LDT + ks * 16 + 8 * h);
        }
#pragma unroll
        for (int a = 0; a < 2; ++a)
#pragma unroll
          for (int b = 0; b < 2; ++b) acc[a][b] = MFMA32(fa[a], fb[b], acc[a][b]);

      }
    }
#pragma unroll
    for (int a = 0; a < 2; ++a)
#pragma unroll
      for (int b = 0; b < 2; ++b) {
        const int col = n0 + wn * 64 + b * 32 + r;
        const int rbase = m0 + wm * 64 + a * 32;
        if (EPI == 0) {
          u16* C = (u16*)(p.ws + OFF_PROJ);
#pragma unroll
          for (int i = 0; i < 16; ++i) C[(size_t)(rbase + crow(i, h)) * N0 + col] = f2bf(acc[a][b][i]);
        } else if (EPI == 1) {
          const float* mod = (const float*)(p.ws + OFF_MOD);
#pragma unroll
          for (int i = 0; i < 16; ++i) {
            const int row = rbase + crow(i, h);
            if (row < T_LAT) {
              const float gate = mod[(row >> 13) * 3072 + 2048 + col];
              p.out[(size_t)row * 1024 + col] = p.x[(size_t)row * 1024 + col] + gate * acc[a][b][i];
            } else {
              const int rc = row - T_LAT;
              const float gate = mod[2 * 3072 + 2048 + col];
              ((float*)(p.ws + OFF_XC1))[(size_t)rc * 1024 + col] = p.ctx[(size_t)rc * 1024 + col] + gate * acc[a][b][i];
            }
          }
        } else if (EPI == 2) {
          if (n0 < 2048) {
            u16* C = (u16*)(p.ws + OFF_RAW);
#pragma unroll
            for (int i = 0; i < 16; ++i) C[(size_t)(rbase + crow(i, h)) * 2048 + col] = f2bf(acc[a][b][i]);
          } else if (n0 < 3072) {
            u16* Vt = (u16*)(p.ws + OFF_VT);
            const int e = col - 2048;
#pragma unroll
            for (int g = 0; g < 4; ++g) {
              const int row = rbase + 8 * g + 4 * h;
              int bb, pp;
              if (row < T_LAT) { bb = row >> 13; pp = 256 + (row & 8191); } else { bb = (row - T_LAT) >> 8; pp = (row - T_LAT) & 255; }
              u32x2 v = {cvtpk(acc[a][b][4 * g], acc[a][b][4 * g + 1]), cvtpk(acc[a][b][4 * g + 2], acc[a][b][4 * g + 3])};
              const int q4 = (pp >> 2) & 3;
              const int pq = (pp & ~15) | ((((q4 & 1) << 1) | (q4 >> 1)) << 2);
              *(u32x2*)(Vt + ((size_t)bb * 1024 + e) * LKV + pq) = v;
            }
          } else {
            u16* G = (u16*)(p.ws + OFF_GB);
#pragma unroll
            for (int i = 0; i < 16; ++i) {
              const int row = rbase + crow(i, h);
              if (row < T_LAT) G[(size_t)row * 1024 + col - 3072] = f2bf(siluf_(acc[a][b][i]));
            }
          }
        } else {
          const float* mod = (const float*)(p.ws + OFF_MOD) + 3 * 3072;
#pragma unroll
          for (int i = 0; i < 16; ++i) {
            const int row = rbase + crow(i, h);
            const float gate = mod[(row >> 13) * 3072 + 2048 + col];
            float* o = p.out + (size_t)row * 1024 + col;
            *o = *o + gate * acc[a][b][i];
          }
        }
      }
  }
}

template <int EPI>
DI void phase_gemm_wide(const Params& p, char* smem, const u16* __restrict__ A, const u16* __restrict__ Bt, int Mtiles, int Ntiles) {
  const int TIDX = ltid();
  u16* As = (u16*)smem;
  u16* Bs = As + 128 * LDT;
  const int tid = TIDX, lane = tid & 63, wv = __builtin_amdgcn_readfirstlane(tid >> 6);
  const int r = lane & 31, h = lane >> 5;
  const int wm = wv >> 1, wn = wv & 1;
  const int ntiles = Mtiles * Ntiles;
  const int npad = (ntiles + 511) & ~511;
  int repg = (EPI == 0 || EPI == 2) ? REP_GEMM : 1; asm volatile("" : "+s"(repg));
  for (int rp = 0; rp < repg; ++rp)
  for (int tt = blockIdx.x; tt < npad; tt += gridDim.x) {
    const int tile = (tt & ~511) + ((tt & 7) << 6) + ((tt >> 3) & 63);
    if (tile >= ntiles) continue;
    const int band = tile / (4 * Ntiles), rem = tile % (4 * Ntiles);
    const int mt_ = band * 4 + (rem & 3), nt_ = rem >> 2;
    const int m0 = mt_ * 128, n0 = nt_ * 256;
    f32x16 acc[2][4];
#pragma unroll
    for (int a = 0; a < 2; ++a)
#pragma unroll
      for (int b = 0; b < 4; ++b)
#pragma unroll
        for (int i = 0; i < 16; ++i) acc[a][b][i] = 0.f;
    u32x4 ra[4], rb[8];
    const u16* Ag = A + (size_t)m0 * 1024;
    const u16* Bg = Bt + (size_t)n0 * 1024;
#pragma unroll
    for (int i = 0; i < 8; ++i) {
      const int id = tid + 256 * i; const int row = id >> 3, cc = id & 7;
      if (i < 4) ra[i] = *(const u32x4*)(Ag + (size_t)row * 1024 + cc * 8);
      rb[i] = *(const u32x4*)(Bg + (size_t)row * 1024 + cc * 8);
    }
    for (int kt = 0; kt < 16; ++kt) {
      __syncthreads();
      int ts = tid; asm volatile("" : "+v"(ts));
#pragma unroll
      for (int i = 0; i < 8; ++i) {
        const int id = ts + 256 * i; const int row = id >> 3, cc = id & 7;
        if (i < 4) *(u32x4*)(As + row * LDT + cc * 8) = ra[i];
        *(u32x4*)(Bs + row * LDT + cc * 8) = rb[i];
      }
      __syncthreads();
      if (kt + 1 < 16) {
        int tl = tid; asm volatile("" : "+v"(tl));
#pragma unroll
        for (int i = 0; i < 8; ++i) {
          const int id = tl + 256 * i; const int row = id >> 3, cc = id & 7;
          if (i < 4) ra[i] = *(const u32x4*)(Ag + (size_t)row * 1024 + (kt + 1) * 64 + cc * 8);
          rb[i] = *(const u32x4*)(Bg + (size_t)row * 1024 + (kt + 1) * 64 + cc * 8);
        }
      }
#pragma unroll
      for (int ks = 0; ks < 4; ++ks) {
        bf16x8 fa[2], fb[4];
#pragma unroll
        for (int t = 0; t < 2; ++t) fa[t] = *(const bf16x8*)(As + (wm * 64 + t * 32 + r) * LDT + ks * 16 + 8 * h);
#pragma unroll
        for (int t = 0; t < 4; ++t) fb[t] = *(const bf16x8*)(Bs + (wn * 128 + t * 32 + r) * LDT + ks * 16 + 8 * h);
#pragma unroll
        for (int a = 0; a < 2; ++a)
#pragma unroll
          for (int b = 0; b < 4; ++b) acc[a][b] = MFMA32(fa[a], fb[b], acc[a][b]);

      }
    }
#pragma unroll
    for (int a = 0; a < 2; ++a)
#pragma unroll
      for (int b = 0; b < 4; ++b) {
        const int col = n0 + wn * 128 + b * 32 + r;
        const int rbase = m0 + wm * 64 + a * 32;
        if (EPI == 0) {
          u16* C = (u16*)(p.ws + OFF_PROJ);
#pragma unroll
          for (int i = 0; i < 16; ++i) C[(size_t)(rbase + crow(i, h)) * N0 + col] = f2bf(acc[a][b][i]);
        } else if (EPI == 1) {
          const float* mod = (const float*)(p.ws + OFF_MOD);
#pragma unroll
          for (int i = 0; i < 16; ++i) {
            const int row = rbase + crow(i, h);
            if (row < T_LAT) {
              const float gate = mod[(row >> 13) * 3072 + 2048 + col];
              p.out[(size_t)row * 1024 + col] = p.x[(size_t)row * 1024 + col] + gate * acc[a][b][i];
            } else {
              const int rc = row - T_LAT;
              const float gate = mod[2 * 3072 + 2048 + col];
              ((float*)(p.ws + OFF_XC1))[(size_t)rc * 1024 + col] = p.ctx[(size_t)rc * 1024 + col] + gate * acc[a][b][i];
            }
          }
        } else if (EPI == 2) {
          if (n0 < 2048) {
            u16* C = (u16*)(p.ws + OFF_RAW);
#pragma unroll
            for (int i = 0; i < 16; ++i) C[(size_t)(rbase + crow(i, h)) * 2048 + col] = f2bf(acc[a][b][i]);
          } else if (n0 < 3072) {
            u16* Vt = (u16*)(p.ws + OFF_VT);
            const int e = col - 2048;
#pragma unroll
            for (int g = 0; g < 4; ++g) {
              const int row = rbase + 8 * g + 4 * h;
              int bb, pp;
              if (row < T_LAT) { bb = row >> 13; pp = 256 + (row & 8191); } else { bb = (row - T_LAT) >> 8; pp = (row - T_LAT) & 255; }
              u32x2 v = {cvtpk(acc[a][b][4 * g], acc[a][b][4 * g + 1]), cvtpk(acc[a][b][4 * g + 2], acc[a][b][4 * g + 3])};
              const int q4 = (pp >> 2) & 3;
              const int pq = (pp & ~15) | ((((q4 & 1) << 1) | (q4 >> 1)) << 2);
              *(u32x2*)(Vt + ((size_t)bb * 1024 + e) * LKV + pq) = v;
            }
          } else {
            u16* G = (u16*)(p.ws + OFF_GB);
#pragma unroll
            for (int i = 0; i < 16; ++i) {
              const int row = rbase + crow(i, h);
              if (row < T_LAT) G[(size_t)row * 1024 + col - 3072] = f2bf(siluf_(acc[a][b][i]));
            }
          }
        } else {
          const float* mod = (const float*)(p.ws + OFF_MOD) + 3 * 3072;
#pragma unroll
          for (int i = 0; i < 16; ++i) {
            const int row = rbase + crow(i, h);
            const float gate = mod[(row >> 13) * 3072 + 2048 + col];
            float* o = p.out + (size_t)row * 1024 + col;
            *o = *o + gate * acc[a][b][i];
          }
        }
      }
  }
}

DI void tokmap(int pos, int d, int b, int& row, bool& hp, bool& hn) {
  if (pos < 256) { const int t = d ? 255 - pos : pos; row = T_LAT + b * 256 + t; hp = t > 0; hn = t < 255; }
  else { const int q = pos - 256; const int t = d ? 8191 - q : q; row = b * 8192 + t; hp = t > 0; hn = t < 8191; }
}

DI void load_mix8(const u16* pr, bool hp, bool hn, const float* mu, float* out) {
  const u32x4 uc = *(const u32x4*)pr;
  u32x4 up = {0u, 0u, 0u, 0u}, un = {0u, 0u, 0u, 0u};
  if (hp) up = *(const u32x4*)(pr - N0);
  if (hn) un = *(const u32x4*)(pr + N0);
  float c[8], a[8], n[8];
  unpack8(uc, c); unpack8(up, a); unpack8(un, n);
  const f32x4 m0 = *(const f32x4*)mu, m1 = *(const f32x4*)(mu + 4);
#pragma unroll
  for (int j = 0; j < 8; ++j) {
    const float m = j < 4 ? m0[j & 3] : m1[j & 3];
    out[j] = c[j] + m * (0.5f * (a[j] + n[j]) - c[j]);
  }
}

DI void mixraw8(const u32x4& uc, const u32x4& up, const u32x4& un, bool hp, bool hn, const float* mu, float* out) {
  float c[8], a[8], n[8];
  unpack8(uc, c); unpack8(up, a); unpack8(un, n);
  const f32x4 m0 = *(const f32x4*)mu, m1 = *(const f32x4*)(mu + 4);
#pragma unroll
  for (int j = 0; j < 8; ++j) {
    const float m = j < 4 ? m0[j & 3] : m1[j & 3];
    const float av = hp ? a[j] : 0.f, nv = hn ? n[j] : 0.f;
    out[j] = c[j] + m * (0.5f * (av + nv) - c[j]);
  }
}

template <int PASS>
DI void phase_scan(const Params& p, char* smem) {
  const int TIDX = ltid();
  const int lane = TIDX & 63, wv = __builtin_amdgcn_readfirstlane(TIDX >> 6);
  float* sm = (float*)smem + wv * 3584;
  float* sW = sm; float* sKK = sm + 512; float* sKKA = sm + 1024; float* sKD = sm + 1536; float* sR = sm + 2048; float* sV = sm + 2560; float* sA = sm + 3072;
  const u16* proj = (const u16*)(p.ws + OFF_PROJ);
  float* stP = (float*)(p.ws + OFF_STP);
  float* stS = (float*)(p.ws + OFF_STS);
  float* bonus = (float*)(p.ws + OFF_BONUS);
  const int nwaves = gridDim.x * 4;
  int reps = (PASS == 1) ? REP_SCAN : 1; asm volatile("" : "+s"(reps));
  for (int rp = 0; rp < reps; ++rp)
  for (int item = blockIdx.x * 4 + wv; item < 2048; item += nwaves) {
    const int chain = item >> 5, chunk = item & 31;
    const int d = chain & 1, hh = (chain >> 1) & 15, b = chain >> 5;
    u16* cB = (u16*)(smem + 57344);
    float* cP = (float*)(smem + 57344 + 18432);
    __syncthreads();
    {
      const int tid = TIDX;
#pragma unroll
      for (int i = 0; i < 4; ++i) {
        const int id = tid + 256 * i;
        const int which = id >> 9, row = (id >> 3) & 63, cc = id & 7;
        const u16* src = (const u16*)(p.ws + (which ? OFF_A2T : OFF_W2T)) + ((size_t)d * 1024 + hh * 64 + row) * 64 + cc * 8;
        *(u32x4*)(cB + (which * 64 + row) * 72 + cc * 8) = *(const u32x4*)src;
      }
      if (tid < 160) {
        const int a = tid >> 4, q = (tid & 15) * 4;
        const float* src;
        switch (a) {
          case 0: src = p.rw_mu + 3072 + d * 64; break;
          case 1: src = p.rw_mu + 3072 + 128 + d * 64; break;
          case 2: src = p.rw_mu + hh * 64; break;
          case 3: src = p.rw_mu + 1024 + hh * 64; break;
          case 4: src = p.rw_mu + 2048 + hh * 64; break;
          case 5: src = p.rw_w0 + d * 1024 + hh * 64; break;
          case 6: src = p.rw_a0 + d * 1024 + hh * 64; break;
          case 7: src = p.rw_kk + hh * 64; break;
          case 8: src = p.rw_ka + hh * 64; break;
          default: src = p.rw_rk + hh * 64; break;
        }
        *(f32x4*)(cP + a * 64 + q) = *(const f32x4*)(src + q);
      }
    }
    __syncthreads();
    if (PASS == 1 && chunk == 31) continue;
    f32x16 S[2][2];
    f32x32 P[2];
    {
      int li = lane; asm volatile("" : "+v"(li));
      const int lv = li & 31, lh = li >> 5;
      if (PASS == 1) {
#pragma unroll
        for (int kt = 0; kt < 2; ++kt)
#pragma unroll
          for (int vt = 0; vt < 2; ++vt)
#pragma unroll
            for (int i = 0; i < 16; ++i) {
              S[kt][vt][i] = 0.f;
              P[vt][16 * kt + i] = (32 * kt + (i & 3) + 8 * (i >> 2) + 4 * lh == 32 * vt + lv) ? 1.f : 0.f;
            }
      } else {
        if (chunk == 0) {
#pragma unroll
          for (int kt = 0; kt < 2; ++kt)
#pragma unroll
            for (int vt = 0; vt < 2; ++vt)
#pragma unroll
              for (int i = 0; i < 16; ++i) S[kt][vt][i] = 0.f;
        } else {
          const float* src = stS + (size_t)(item - 1) * 4096;
#pragma unroll
          for (int kt = 0; kt < 2; ++kt)
#pragma unroll
            for (int vt = 0; vt < 2; ++vt)
#pragma unroll
              for (int g = 0; g < 4; ++g) {
                const f32x4 t = *(const f32x4*)(src + (32 * vt + lv) * 64 + 32 * kt + 8 * g + 4 * lh);
                S[kt][vt][4 * g] = t[0]; S[kt][vt][4 * g + 1] = t[1]; S[kt][vt][4 * g + 2] = t[2]; S[kt][vt][4 * g + 3] = t[3];
              }
        }
      }
    }
    for (int sc = 0; sc < NSUB; ++sc) {
      const int p0 = chunk * LCH + sc * 8;
      int ln = lane; asm volatile("" : "+v"(ln));
      u32x4 rawA[2][3], rawB[3][3];
      bool hpA, hnA, hpB, hnB; int rowB;
      {
        int rowA; tokmap(p0 + (ln & 7), d, b, rowA, hpA, hnA);
        const u16* prA = proj + (size_t)rowA * N0 + 4096 + d * 64 + (ln >> 4) * 8 + ((ln >> 3) & 1) * 32;
        const ptrdiff_t dpA = hpA ? -N0 : 0, dnA = hnA ? N0 : 0;
#pragma unroll
        for (int X = 0; X < 2; ++X) {
          const u16* q = prA + X * 128;
          rawA[X][0] = *(const u32x4*)q; rawA[X][1] = *(const u32x4*)(q + dpA); rawA[X][2] = *(const u32x4*)(q + dnA);
        }
        tokmap(p0 + (ln >> 3), d, b, rowB, hpB, hnB);
        const u16* prB = proj + (size_t)rowB * N0 + hh * 64 + (ln & 7) * 8;
        const ptrdiff_t dpB = hpB ? -N0 : 0, dnB = hnB ? N0 : 0;
#pragma unroll
        for (int X = (PASS == 2 ? 0 : 1); X < 3; ++X) {
          const u16* q = prB + X * 1024;
          rawB[X][0] = *(const u32x4*)q; rawB[X][1] = *(const u32x4*)(q + dpB); rawB[X][2] = *(const u32x4*)(q + dnB);
        }
      }
      {
        const int m = ln & 15, kg = ln >> 4;
        bf16x8 fa[2][2];
        const int ssel = (m >> 3) & 1;
#pragma unroll
        for (int X = 0; X < 2; ++X) {
          float mx[8];
          mixraw8(rawA[X][0], rawA[X][1], rawA[X][2], hpA, hnA, cP + X * 64 + ssel * 32 + kg * 8, mx);
          if (X == 0) {
#pragma unroll
            for (int j = 0; j < 8; ++j) { const float e = __expf(2.0f * mx[j]); mx[j] = 1.0f - 2.0f * __builtin_amdgcn_rcpf(e + 1.0f); }
          }
          u32x4 own = {cvtpk(mx[0], mx[1]), cvtpk(mx[2], mx[3]), cvtpk(mx[4], mx[5]), cvtpk(mx[6], mx[7])};
          u32x4 oth;
#pragma unroll
          for (int q = 0; q < 4; ++q) oth[q] = (unsigned)__shfl_down((int)own[q], 8);
          fa[X][0] = __builtin_bit_cast(bf16x8, own);
          fa[X][1] = __builtin_bit_cast(bf16x8, ssel ? own : oth);
        }
#pragma unroll
        for (int nt = 0; nt < 4; ++nt) {
          f32x4 aw = {0.f, 0.f, 0.f, 0.f}, aa = {0.f, 0.f, 0.f, 0.f};
#pragma unroll
          for (int s = 0; s < 2; ++s) {
            const bf16x8 bw = *(const bf16x8*)(cB + (16 * nt + m) * 72 + s * 32 + kg * 8);
            const bf16x8 ba = *(const bf16x8*)(cB + (64 + 16 * nt + m) * 72 + s * 32 + kg * 8);
            aw = MFMA16(fa[0][s], bw, aw);
            aa = MFMA16(fa[1][s], ba, aa);
          }
          const int ch = 16 * nt + m;
          const float w0 = cP[5 * 64 + ch];
          const float a0 = cP[6 * 64 + ch];
          if (kg < 2) {
#pragma unroll
            for (int rg = 0; rg < 4; ++rg) {
              sW[(4 * kg + rg) * 64 + ch] = w0 + aw[rg];
              sA[(4 * kg + rg) * 64 + ch] = a0 + aa[rg];
            }
          }
        }
      }
      WAVE_LDS_SYNC();
      __builtin_amdgcn_sched_barrier(0);
      {
        const int tk = ln >> 3, g = ln & 7;
        const int row = rowB;
        const int cb = hh * 64 + g * 8;
        float rr[8], kk[8], vv[8];
        if (PASS == 2) mixraw8(rawB[0][0], rawB[0][1], rawB[0][2], hpB, hnB, cP + 2 * 64 + g * 8, rr);
        else { for (int j = 0; j < 8; ++j) rr[j] = 0.f; }
        mixraw8(rawB[1][0], rawB[1][1], rawB[1][2], hpB, hnB, cP + 3 * 64 + g * 8, kk);
        mixraw8(rawB[2][0], rawB[2][1], rawB[2][2], hpB, hnB, cP + 4 * 64 + g * 8, vv);
        float av[8], kkn[8], kd[8], pkkv[8], pkav[8], prkv[8];
        { const f32x4 t0 = *(const f32x4*)(sA + tk * 64 + g * 8), t1 = *(const f32x4*)(sA + tk * 64 + g * 8 + 4);
          av[0] = fsig(t0[0]); av[1] = fsig(t0[1]); av[2] = fsig(t0[2]); av[3] = fsig(t0[3]); av[4] = fsig(t1[0]); av[5] = fsig(t1[1]); av[6] = fsig(t1[2]); av[7] = fsig(t1[3]); }
        { const f32x4 t0 = *(const f32x4*)(sW + tk * 64 + g * 8), t1 = *(const f32x4*)(sW + tk * 64 + g * 8 + 4);
          f32x4 o0, o1;
#pragma unroll
          for (int j = 0; j < 4; ++j) { o0[j] = __expf(-0.6065306597126334f * fsig(t0[j])); o1[j] = __expf(-0.6065306597126334f * fsig(t1[j])); }
          *(f32x4*)(sW + tk * 64 + g * 8) = o0; *(f32x4*)(sW + tk * 64 + g * 8 + 4) = o1; }
        WAVE_LDS_SYNC();
        { float Wc = 1.0f;
#pragma unroll
          for (int j = 0; j < 8; ++j) { Wc *= sW[j * 64 + ln]; sW[j * 64 + ln] = Wc; } }
        WAVE_LDS_SYNC();
        float wcur[8], wprv[8];
        { const f32x4 t0 = *(const f32x4*)(sW + tk * 64 + g * 8), t1 = *(const f32x4*)(sW + tk * 64 + g * 8 + 4);
          const int tp = tk > 0 ? tk - 1 : 0;
          const f32x4 u0 = *(const f32x4*)(sW + tp * 64 + g * 8), u1 = *(const f32x4*)(sW + tp * 64 + g * 8 + 4);
#pragma unroll
          for (int j = 0; j < 4; ++j) { wcur[j] = t0[j]; wcur[j + 4] = t1[j]; wprv[j] = tk > 0 ? u0[j] : 1.0f; wprv[j + 4] = tk > 0 ? u1[j] : 1.0f; } }
        { const float* q7 = cP + 7 * 64 + g * 8;
          const f32x4 a0 = *(const f32x4*)(q7), a1 = *(const f32x4*)(q7 + 4), b0 = *(const f32x4*)(q7 + 64), b1 = *(const f32x4*)(q7 + 68),
                      c0 = *(const f32x4*)(q7 + 128), c1 = *(const f32x4*)(q7 + 132);
#pragma unroll
          for (int j = 0; j < 4; ++j) { pkkv[j] = a0[j]; pkkv[j + 4] = a1[j]; pkav[j] = b0[j]; pkav[j + 4] = b1[j]; prkv[j] = c0[j]; prkv[j + 4] = c1[j]; } }
        float ss = 0.f, bon = 0.f;
#pragma unroll
        for (int j = 0; j < 8; ++j) {
          kkn[j] = kk[j] * pkkv[j]; ss += kkn[j] * kkn[j];
          kd[j] = kk[j] * (1.0f + (av[j] - 1.0f) * pkav[j]);
          bon += rr[j] * kd[j] * prkv[j];
        }
        ss += __shfl_xor(ss, 1); ss += __shfl_xor(ss, 2); ss += __shfl_xor(ss, 4);
        const float inv = rsqrtf(ss + 1e-12f);
        if (PASS == 2) {
          bon += __shfl_xor(bon, 1); bon += __shfl_xor(bon, 2); bon += __shfl_xor(bon, 4);
          if (g == 0) bonus[(size_t)d * (T_ALL * 16) + (size_t)row * 16 + hh] = bon;
        }
        float iw[8];
#pragma unroll
        for (int j = 0; j < 8; ++j) iw[j] = __builtin_amdgcn_rcpf(wcur[j]);
        float* o;
        o = sKK + tk * 64 + g * 8;
        *(f32x4*)o = f32x4{kkn[0] * inv * wprv[0], kkn[1] * inv * wprv[1], kkn[2] * inv * wprv[2], kkn[3] * inv * wprv[3]};
        *(f32x4*)(o + 4) = f32x4{kkn[4] * inv * wprv[4], kkn[5] * inv * wprv[5], kkn[6] * inv * wprv[6], kkn[7] * inv * wprv[7]};
        o = sKKA + tk * 64 + g * 8;
        *(f32x4*)o = f32x4{kkn[0] * inv * av[0] * iw[0], kkn[1] * inv * av[1] * iw[1], kkn[2] * inv * av[2] * iw[2], kkn[3] * inv * av[3] * iw[3]};
        *(f32x4*)(o + 4) = f32x4{kkn[4] * inv * av[4] * iw[4], kkn[5] * inv * av[5] * iw[5], kkn[6] * inv * av[6] * iw[6], kkn[7] * inv * av[7] * iw[7]};
        o = sKD + tk * 64 + g * 8;
        *(f32x4*)o = f32x4{kd[0] * iw[0], kd[1] * iw[1], kd[2] * iw[2], kd[3] * iw[3]};
        *(f32x4*)(o + 4) = f32x4{kd[4] * iw[4], kd[5] * iw[5], kd[6] * iw[6], kd[7] * iw[7]};
        if (PASS == 2) {
          o = sR + tk * 64 + g * 8;
          *(f32x4*)o = f32x4{rr[0] * wcur[0], rr[1] * wcur[1], rr[2] * wcur[2], rr[3] * wcur[3]};
          *(f32x4*)(o + 4) = f32x4{rr[4] * wcur[4], rr[5] * wcur[5], rr[6] * wcur[6], rr[7] * wcur[7]};
        }
        o = sV + tk * 64 + g * 8;
        *(f32x4*)o = f32x4{vv[0], vv[1], vv[2], vv[3]};
        *(f32x4*)(o + 4) = f32x4{vv[4], vv[5], vv[6], vv[7]};
      }
      WAVE_LDS_SYNC();
      __builtin_amdgcn_sched_barrier(0);
      float* obase = nullptr; ptrdiff_t ostep = d ? -1024 : 1024;
      if (PASS == 2) {
        int row0; bool hp0, hn0; tokmap(p0, d, b, row0, hp0, hn0);
        obase = ((row0 < T_LAT) ? (p.out + (size_t)row0 * 1024) : ((float*)(p.ws + OFF_OCTX) + (size_t)(row0 - T_LAT) * 1024)) + hh * 64 + lane;
      }
      const int lv31 = lane & 31, lh1 = lane >> 5;
#pragma unroll 1
      for (int j = 0; j < 8; ++j) {
        f32x4 kkv[2][4];
#pragma unroll
        for (int kt = 0; kt < 2; ++kt)
#pragma unroll
          for (int g = 0; g < 4; ++g) kkv[kt][g] = *(const f32x4*)(sKK + j * 64 + 32 * kt + 8 * g + 4 * lh1);
        float aop[2], vvv[2];
        const float akka = sKKA[j * 64 + lane];
#pragma unroll
        for (int t = 0; t < 2; ++t) {
          aop[t] = (lh1 ? sKD : sKKA)[j * 64 + 32 * t + lv31];
          vvv[t] = sV[j * 64 + 32 * t + lv31];
        }
        float saS[2], saP[2];
#pragma unroll
        for (int vt = 0; vt < 2; ++vt) {
          f2 a2 = {0.f, 0.f}, b2 = {0.f, 0.f};
#pragma unroll
          for (int kt = 0; kt < 2; ++kt)
#pragma unroll
            for (int g = 0; g < 4; ++g) {
              a2 += f2{S[kt][vt][4 * g], S[kt][vt][4 * g + 1]} * f2{kkv[kt][g][0], kkv[kt][g][1]};
              a2 += f2{S[kt][vt][4 * g + 2], S[kt][vt][4 * g + 3]} * f2{kkv[kt][g][2], kkv[kt][g][3]};
              if (PASS == 1) {
                b2 += f2{P[vt][16 * kt + 4 * g], P[vt][16 * kt + 4 * g + 1]} * f2{kkv[kt][g][0], kkv[kt][g][1]};
                b2 += f2{P[vt][16 * kt + 4 * g + 2], P[vt][16 * kt + 4 * g + 3]} * f2{kkv[kt][g][2], kkv[kt][g][3]};
              }
            }
          float x = a2[0] + a2[1];
          x += __shfl_xor(x, 32);
          saS[vt] = x;
          if (PASS == 1) { float y = b2[0] + b2[1]; y += __shfl_xor(y, 32); saP[vt] = y; }
        }
#pragma unroll
        for (int vt = 0; vt < 2; ++vt) {
          const float bS = lh1 ? vvv[vt] : -saS[vt];
          if (PASS == 1) P[vt] = __builtin_amdgcn_mfma_f32_32x32x1f32(akka, -saP[vt], P[vt], 0, 0, 0);
#pragma unroll
          for (int kt = 0; kt < 2; ++kt) {
            S[kt][vt] = __builtin_amdgcn_mfma_f32_32x32x2f32(aop[kt], bS, S[kt][vt], 0, 0, 0);
          }
        }
        if (PASS == 2) {
          f32x4 rv[2][4];
#pragma unroll
          for (int kt = 0; kt < 2; ++kt)
#pragma unroll
            for (int g = 0; g < 4; ++g) rv[kt][g] = *(const f32x4*)(sR + j * 64 + 32 * kt + 8 * g + 4 * lh1);
          float ov[2];
#pragma unroll
          for (int vt = 0; vt < 2; ++vt) {
            f2 a2 = {0.f, 0.f};
#pragma unroll
            for (int kt = 0; kt < 2; ++kt)
#pragma unroll
              for (int g = 0; g < 4; ++g) {
                a2 += f2{S[kt][vt][4 * g], S[kt][vt][4 * g + 1]} * f2{rv[kt][g][0], rv[kt][g][1]};
                a2 += f2{S[kt][vt][4 * g + 2], S[kt][vt][4 * g + 3]} * f2{rv[kt][g][2], rv[kt][g][3]};
              }
            float x = a2[0] + a2[1];
            x += __shfl_xor(x, 32);
            ov[vt] = x;
          }
          atomicAdd(obase + (ptrdiff_t)j * ostep, lh1 ? ov[1] : ov[0]);
        }
      }
      {
        f32x4 w7[2][4];
#pragma unroll
        for (int kt = 0; kt < 2; ++kt)
#pragma unroll
          for (int g = 0; g < 4; ++g) w7[kt][g] = *(const f32x4*)(sW + 7 * 64 + 32 * kt + 8 * g + 4 * lh1);
#pragma unroll
        for (int kt = 0; kt < 2; ++kt)
#pragma unroll
          for (int vt = 0; vt < 2; ++vt)
#pragma unroll
            for (int i = 0; i < 16; ++i) {
              S[kt][vt][i] *= w7[kt][i >> 2][i & 3];
              if (PASS == 1) P[vt][16 * kt + i] *= w7[kt][i >> 2][i & 3];
            }
      }
      WAVE_LDS_SYNC();
    }
    if (PASS == 1) {
      int li = lane; asm volatile("" : "+v"(li));
      const int lv = li & 31, lh = li >> 5;
      float* dP = stP + (size_t)item * 4096;
      float* dS = stS + (size_t)item * 4096;
#pragma unroll
      for (int kt = 0; kt < 2; ++kt)
#pragma unroll
        for (int vt = 0; vt < 2; ++vt)
#pragma unroll
          for (int g = 0; g < 4; ++g) {
            const int off = (32 * vt + lv) * 64 + 32 * kt + 8 * g + 4 * lh;
            *(f32x4*)(dP + off) = f32x4{P[vt][16 * kt + 4 * g], P[vt][16 * kt + 4 * g + 1], P[vt][16 * kt + 4 * g + 2], P[vt][16 * kt + 4 * g + 3]};
            *(f32x4*)(dS + off) = f32x4{S[kt][vt][4 * g], S[kt][vt][4 * g + 1], S[kt][vt][4 * g + 2], S[kt][vt][4 * g + 3]};
          }
    }
  }
}

DI void phase_carry(const Params& p, char* smem) {
  const int TIDX = ltid();
  float* cur = (float*)smem;
  const int tid = TIDX, lane = tid & 63, w = __builtin_amdgcn_readfirstlane(tid >> 6);
  const int lc = lane & 15, lq = lane >> 4;
  float* stP = (float*)(p.ws + OFF_STP);
  float* stS = (float*)(p.ws + OFF_STS);
  for (int it = blockIdx.x; it < 256; it += gridDim.x) {
    const int chain = it >> 2, rg = it & 3;
    const size_t slot0 = (size_t)chain * 32;
    __syncthreads();
    {
      const int row = tid >> 4, c4 = (tid & 15) * 4;
      const f32x4 t = *(const f32x4*)(stS + (slot0 * 64 + rg * 16 + row) * 64 + c4);
      *(f32x4*)(cur + row * 68 + c4) = t;
    }
    __syncthreads();
    float pn[16]; f32x4 an;
    {
      const float* Pm = stP + (slot0 + 1) * 4096;
#pragma unroll
      for (int s = 0; s < 16; ++s) pn[s] = Pm[(size_t)(4 * s + lq) * 64 + 16 * w + lc];
#pragma unroll
      for (int rr = 0; rr < 4; ++rr) an[rr] = stS[((slot0 + 1) * 64 + rg * 16 + 4 * lq + rr) * 64 + 16 * w + lc];
    }
    for (int c = 1; c < 31; ++c) {
      const size_t slot = slot0 + c;
      float pj[16]; f32x4 acc = an;
#pragma unroll
      for (int s = 0; s < 16; ++s) pj[s] = pn[s];
      if (c + 1 < 31) {
        const float* Pm = stP + (slot + 1) * 4096;
#pragma unroll
        for (int s = 0; s < 16; ++s) pn[s] = Pm[(size_t)(4 * s + lq) * 64 + 16 * w + lc];
#pragma unroll
        for (int rr = 0; rr < 4; ++rr) an[rr] = stS[((slot + 1) * 64 + rg * 16 + 4 * lq + rr) * 64 + 16 * w + lc];
      }
#pragma unroll
      for (int s = 0; s < 16; ++s) {
        const float a = cur[lc * 68 + 4 * s + lq];
        acc = __builtin_amdgcn_mfma_f32_16x16x4f32(a, pj[s], acc, 0, 0, 0);
      }
      __syncthreads();
#pragma unroll
      for (int rr = 0; rr < 4; ++rr) {
        cur[(4 * lq + rr) * 68 + 16 * w + lc] = acc[rr];
        stS[(slot * 64 + rg * 16 + 4 * lq + rr) * 64 + 16 * w + lc] = acc[rr];
      }
      __syncthreads();
    }
  }
  {
    const int nidle = (int)gridDim.x > 256 ? (int)gridDim.x - 256 : 0;
    int t0, tstep;
    if (nidle > 0) { t0 = (int)blockIdx.x - 256; tstep = nidle; if (t0 < 0) t0 = 1 << 30; }
    else { t0 = (int)blockIdx.x; tstep = (int)gridDim.x; }
    __syncthreads();
    for (int t = t0; t < 1280; t += tstep) {
      if (t < 1024) transpose_tile(p.da_in, (u16*)(p.ws + OFF_WT_IN1), 1024, N1, t >> 6, t & 63, (float*)smem);
      else { const int j = t - 1024; transpose_tile(p.da_out, (u16*)(p.ws + OFF_WT_OUT1), 1024, 1024, j >> 4, j & 15, (float*)smem); }
    }
  }
}

DI void phase_readout(const Params& p) {
  const int TIDX = ltid();
  const int lane = TIDX & 63, wv = __builtin_amdgcn_readfirstlane(TIDX >> 6);
  const u16* proj = (const u16*)(p.ws + OFF_PROJ);
  const float* bonus = (const float*)(p.ws + OFF_BONUS);
  u16* hb = (u16*)(p.ws + OFF_HB);
  for (int row = blockIdx.x * 4 + wv; row < T_ALL; row += gridDim.x * 4) {
    const float* o = (row < T_LAT) ? (p.out + (size_t)row * 1024) : ((const float*)(p.ws + OFF_OCTX) + (size_t)(row - T_LAT) * 1024);
    bool hp, hn;
    if (row < T_LAT) { const int t = row & 8191; hp = t > 0; hn = t < 8191; } else { const int t = (row - T_LAT) & 255; hp = t > 0; hn = t < 255; }
    const int c0 = lane * 16, hh = lane >> 2;
    float ov[16];
    float s = 0.f;
#pragma unroll
    for (int q = 0; q < 4; ++q) { const f32x4 t = *(const f32x4*)(o + c0 + q * 4); ov[q * 4] = t[0]; ov[q * 4 + 1] = t[1]; ov[q * 4 + 2] = t[2]; ov[q * 4 + 3] = t[3]; s += t[0] + t[1] + t[2] + t[3]; }
    s += __shfl_xor(s, 1); s += __shfl_xor(s, 2);
    const float mean = s * (1.0f / 64.0f);
    float vs = 0.f;
#pragma unroll
    for (int j = 0; j < 16; ++j) { const float dlt = ov[j] - mean; vs += dlt * dlt; }
    vs += __shfl_xor(vs, 1); vs += __shfl_xor(vs, 2);
    const float rstd = rsqrtf(vs * (1.0f / 64.0f) + 64e-5f);
    const float bon = bonus[(size_t)row * 16 + hh] + bonus[(size_t)(T_ALL * 16) + (size_t)row * 16 + hh];
    float vm[16];
    const u16* pr = proj + (size_t)row * N0;
    load_mix8(pr + 2048 + c0, hp, hn, p.rw_mu + 2048 + c0, vm);
    load_mix8(pr + 2048 + c0 + 8, hp, hn, p.rw_mu + 2048 + c0 + 8, vm + 8);
    float gv[16];
    unpack8(*(const u32x4*)(pr + 3072 + c0), gv);
    unpack8(*(const u32x4*)(pr + 3072 + c0 + 8), gv + 8);
    unsigned pk[8];
#pragma unroll
    for (int j = 0; j < 8; ++j) {
      const int ca = c0 + 2 * j, cb = ca + 1;
      const float ya = ((ov[2 * j] - mean) * rstd * p.rw_gn_g[ca] + p.rw_gn_b[ca] + bon * vm[2 * j]) * siluf_(gv[2 * j]);
      const float yb = ((ov[2 * j + 1] - mean) * rstd * p.rw_gn_g[cb] + p.rw_gn_b[cb] + bon * vm[2 * j + 1]) * siluf_(gv[2 * j + 1]);
      pk[j] = pack2(ya, yb);
    }
    u32x4* dd = (u32x4*)(hb + (size_t)row * 1024 + c0);
    dd[0] = u32x4{pk[0], pk[1], pk[2], pk[3]};
    dd[1] = u32x4{pk[4], pk[5], pk[6], pk[7]};
  }
}

DI void phase_qkprep(const Params& p) {
  const int TIDX = ltid();
  const int lane = TIDX & 63, wv = __builtin_amdgcn_readfirstlane(TIDX >> 6);
  const u16* raw = (const u16*)(p.ws + OFF_RAW);
  u16* Qs = (u16*)(p.ws + OFF_QS);
  u16* Ks = (u16*)(p.ws + OFF_KS);
  const float* rope = (const float*)(p.ws + OFF_ROPE);
  const int grp = lane >> 1, axis = lane & 1;
  const bool isq = grp < 16;
  const int hd = (grp & 15) >> 1, comp = grp & 1;
  const float* gain = (isq ? p.da_qn : p.da_kn) + axis * 32;
  for (int row = blockIdx.x * 4 + wv; row < T_ALL; row += gridDim.x * 4) {
    const bool lat = row < T_LAT;
    int b, t;
    if (lat) { b = row >> 13; t = row & 8191; } else { b = (row - T_LAT) >> 8; t = (row - T_LAT) & 255; }
    const u16* src = raw + (size_t)row * 2048 + lane * 32;
    float v[32];
#pragma unroll
    for (int q = 0; q < 4; ++q) unpack8(*(const u32x4*)(src + q * 8), v + q * 8);
    float ss = 0.f;
#pragma unroll
    for (int j = 0; j < 32; ++j) ss += v[j] * v[j];
    ss += __shfl_xor(ss, 1);
    const float rstd = rsqrtf(ss * (1.0f / 64.0f) + 1e-6f);
#pragma unroll
    for (int j = 0; j < 32; ++j) v[j] = v[j] * rstd * gain[j];
    if (lat) {
      const int pos = axis == 0 ? (t >> 6) : (t & 63);
#pragma unroll
      for (int f = 0; f < 16; ++f) {
        const float c = rope[pos * 16 + f], s = rope[2048 + pos * 16 + f];
        const float x1 = v[f], x2 = v[16 + f];
        v[f] = x1 * c - x2 * s; v[16 + f] = x2 * c + x1 * s;
      }
    }
    u16* dst;
    float sc = 1.0f;
    if (isq) {
      if (!lat) continue;
      sc = 0.125f * 1.4426950408889634f;
      dst = Qs + (((size_t)(b * 8 + hd) * 2 + comp) * 8192 + t) * 64 + axis * 32;
    } else {
      const int pp = lat ? 256 + t : t;
      dst = Ks + (((size_t)(b * 8 + hd) * 2 + comp) * LKV + pp) * 64 + axis * 32;
    }
#pragma unroll
    for (int q = 0; q < 4; ++q) {
      u32x4 o = {pack2(v[q * 8] * sc, v[q * 8 + 1] * sc), pack2(v[q * 8 + 2] * sc, v[q * 8 + 3] * sc),
                 pack2(v[q * 8 + 4] * sc, v[q * 8 + 5] * sc), pack2(v[q * 8 + 6] * sc, v[q * 8 + 7] * sc)};
      *(u32x4*)(dst + q * 8) = o;
    }
  }
}

typedef __attribute__((address_space(3))) unsigned* lds_uptr;
typedef __attribute__((address_space(1))) const unsigned* glb_uptr;
DI void dma16(const void* g, char* ldsbase) {
  __builtin_amdgcn_global_load_lds((glb_uptr)(g), (lds_uptr)(ldsbase), 16, 0, 0);
}

DI void attn_issue_tile(const u16* Kg, const u16* Vg, int k0, char* buf, int wv, int lane) {
  asm volatile("" : "+v"(lane));
  const int rr = lane >> 3, cp = lane & 7;
#pragma unroll
  for (int i = 0; i < 4; ++i) {
    const int seg = wv * 4 + i;
    const int c = seg >> 3, key = (seg & 7) * 8 + rr;
    const int sw = (key >> 1) & 7;
    dma16(Kg + ((size_t)c * LKV + k0 + key) * 64 + ((cp ^ sw) << 3), buf + seg * 1024);
    const int e = seg * 8 + rr;
    const int swv = (e >> 1) & 7;
    dma16(Vg + (size_t)e * LKV + k0 + ((cp ^ swv) << 3), buf + 16384 + seg * 1024);
  }
}

DI void phase_attn(const Params& p, char* smem) {
  const int TIDX = ltid();
  const int tid = TIDX, lane = tid & 63, wv = __builtin_amdgcn_readfirstlane(tid >> 6);
  const int r = lane & 31, h = lane >> 5;
  const u16* Qs = (const u16*)(p.ws + OFF_QS);
  const u16* Ks = (const u16*)(p.ws + OFF_KS);
  const u16* Vt = (const u16*)(p.ws + OFF_VT);
  const u16* GB = (const u16*)(p.ws + OFF_GB);
  u16* Y2 = (u16*)(p.ws + OFF_Y2);
  float lam;
  {
    float a = p.da_lam[lane] * p.da_lam[64 + lane];
    float bq = p.da_lam[128 + lane] * p.da_lam[192 + lane];
#pragma unroll
    for (int o = 32; o >= 1; o >>= 1) { a += __shfl_xor(a, o); bq += __shfl_xor(bq, o); }
    lam = __expf(a) - __expf(bq) + 0.35550906759096927f;
  }
  const float one_m_li = 1.0f - 0.35550906759096927f;
  const int sw = (r >> 1) & 7;
  int repa = REP_ATTN; asm volatile("" : "+s"(repa));
  for (int rp = 0; rp < repa; ++rp)
  for (int item = blockIdx.x; item < 1024; item += gridDim.x) {
    const int bh = (item & 7) * 2 + (item >> 9), qt = (item >> 3) & 63;
    const int q0 = qt * 128 + wv * 32;
    const u16* Kg = Ks + (size_t)bh * 2 * LKV * 64;
    const u16* Vg = Vt + (size_t)bh * 128 * LKV;
    __syncthreads();
    attn_issue_tile(Kg, Vg, 0, smem, wv, lane);
    bf16x8 qf[2][4];
#pragma unroll
    for (int c = 0; c < 2; ++c)
#pragma unroll
      for (int s = 0; s < 4; ++s)
        qf[c][s] = *(const bf16x8*)(Qs + (((size_t)bh * 2 + c) * 8192 + q0 + r) * 64 + s * 16 + 8 * h);
    f32x16 O[2][4];
#pragma unroll
    for (int c = 0; c < 2; ++c)
#pragma unroll
      for (int e = 0; e < 4; ++e)
#pragma unroll
        for (int i = 0; i < 16; ++i) O[c][e][i] = 0.f;
    f2 lsum[2] = {f2{0.f, 0.f}, f2{0.f, 0.f}};
#pragma unroll 1
    for (int kt = 0; kt < LKV / 64; ++kt) {
      char* buf = smem + (kt & 1) * 32768;
      asm volatile("s_waitcnt vmcnt(0)" ::: "memory");
      __syncthreads();
      if (kt + 1 < LKV / 64) attn_issue_tile(Kg, Vg, (kt + 1) * 64, smem + ((kt + 1) & 1) * 32768, wv, lane);
      const char* Kb = buf + r * 128;
      const char* Vb = buf + 16384 + r * 128;
#pragma unroll
      for (int sub = 0; sub < 2; ++sub) {
        f32x16 sacc[2];
#pragma unroll
        for (int c = 0; c < 2; ++c) {
#pragma unroll
          for (int i = 0; i < 16; ++i) sacc[c][i] = 0.f;
#pragma unroll
          for (int s = 0; s < 4; ++s) {
            const bf16x8 kf = *(const bf16x8*)(Kb + c * 8192 + sub * 4096 + (((2 * s + h) ^ sw) << 4));
            sacc[c] = MFMA32(kf, qf[c][s], sacc[c]);
          }
        }
#pragma unroll
        for (int c = 0; c < 2; ++c) {
          bf16x8 pf[2];
#pragma unroll
          for (int s = 0; s < 2; ++s) {
            float ps[8];
#pragma unroll
            for (int i = 0; i < 8; ++i) ps[i] = __builtin_amdgcn_exp2f(sacc[c][8 * s + i]);
            lsum[c] += f2{ps[0], ps[1]}; lsum[c] += f2{ps[2], ps[3]}; lsum[c] += f2{ps[4], ps[5]}; lsum[c] += f2{ps[6], ps[7]};
            u32x4 pk = {cvtpk(ps[0], ps[1]), cvtpk(ps[2], ps[3]), cvtpk(ps[4], ps[5]), cvtpk(ps[6], ps[7])};
            pf[s] = __builtin_bit_cast(bf16x8, pk);
          }
#pragma unroll
          for (int e = 0; e < 4; ++e)
#pragma unroll
            for (int s = 0; s < 2; ++s) {
              const bf16x8 vf = *(const bf16x8*)(Vb + e * 4096 + (((sub * 4 + 2 * s + h) ^ sw) << 4));
              O[c][e] = MFMA32(vf, pf[s], O[c][e]);
            }
        }
      }
    }
    float l0 = lsum[0][0] + lsum[0][1], l1 = lsum[1][0] + lsum[1][1];
    l0 += __shfl_xor(l0, 32); l1 += __shfl_xor(l1, 32);
    const float i0 = 1.0f / l0, i1 = lam / l1;
    float ss = 0.f;
#pragma unroll
    for (int e = 0; e < 4; ++e)
#pragma unroll
      for (int i = 0; i < 16; ++i) { const float o = O[0][e][i] * i0 - O[1][e][i] * i1; O[0][e][i] = o; ss += o * o; }
    ss += __shfl_xor(ss, 32);
    const float rstd = rsqrtf(ss * (1.0f / 128.0f) + 1e-5f) * one_m_li;
    const int b = bh >> 3, hd = bh & 7;
    int rl = r; asm volatile("" : "+v"(rl));
    const size_t row = (size_t)b * 8192 + q0 + rl;
#pragma unroll
    for (int e = 0; e < 4; ++e) {
#pragma unroll
      for (int g = 0; g < 4; ++g) {
        const int ee = e * 32 + 8 * g + 4 * h;
        const u32x2 gg = *(const u32x2*)(GB + row * 1024 + hd * 128 + ee);
        const float g0 = bflo(gg[0]), g1 = bfhi(gg[0]), g2 = bflo(gg[1]), g3 = bfhi(gg[1]);
        const f32x4 sl = *(const f32x4*)(p.da_subln + ee);
        const float y0 = O[0][e][4 * g] * rstd * sl[0] * g0;
        const float y1 = O[0][e][4 * g + 1] * rstd * sl[1] * g1;
        const float y2 = O[0][e][4 * g + 2] * rstd * sl[2] * g2;
        const float y3 = O[0][e][4 * g + 3] * rstd * sl[3] * g3;
        *(u32x2*)(Y2 + row * 1024 + hd * 128 + ee) = u32x2{cvtpk(y0, y1), cvtpk(y2, y3)};
      }
      asm volatile("" ::: "memory");
    }
  }
}

#define XB_TMO      128
#define XB_XCNT(j)  (256  + 64 * (j))
#define XB_XSUB(j)  (1280 + 64 * (j))
#define XB_XGEN(j)  (2304 + 64 * (j))
#define XB_TOP      3328
#define XB_TOPGEN   3392
#define XCD_BAR_WORDS 3456
#define XB_SPIN_CAP (1u << 18)
#define LAS __attribute__((address_space(3)))

__device__ __forceinline__ unsigned xb_ld(unsigned* p)              { return __hip_atomic_load(p, __ATOMIC_RELAXED, __HIP_MEMORY_SCOPE_AGENT); }
__device__ __forceinline__ unsigned xb_add(unsigned* p, unsigned v) { return __hip_atomic_fetch_add(p, v, __ATOMIC_RELAXED, __HIP_MEMORY_SCOPE_AGENT); }
__device__ __forceinline__ unsigned xb_xcc_id() { return (unsigned)__builtin_amdgcn_s_getreg((3 << 11) | 20) & 0xFu; }
#define XB_SPIN(cond, bar) do { unsigned _sp = 0; while (cond) { __builtin_amdgcn_s_sleep(1); \
    if ((++_sp & 255u) == 0u) { if (xb_ld(&(bar)[XB_TMO])) break; if (_sp > XB_SPIN_CAP) { atomicAdd(&(bar)[XB_TMO], 1u); break; } } } } while (0)

struct XcdBarrier {
    unsigned* bar; unsigned x;
    volatile LAS unsigned* st;
};

__device__ __forceinline__ XcdBarrier xcd_barrier_post(unsigned* bar, volatile LAS unsigned* st) {
    XcdBarrier b; b.bar = bar; b.x = xb_xcc_id(); b.st = st;
    if (threadIdx.x == 0) (void)xb_add(&bar[XB_XCNT(b.x)], 1u);
    return b;
}
__device__ __forceinline__ void xcd_barrier_complete(unsigned* bar, unsigned x, unsigned& nloc, unsigned& nx) {
    const unsigned G = gridDim.x * gridDim.y * gridDim.z;
    unsigned sum, cnt, mine, sp = 0u;
    for (;;) {
        sum = 0u; cnt = 0u; mine = 0u;
#pragma unroll
        for (unsigned j = 0; j < 16; ++j) { const unsigned c = xb_ld(&bar[XB_XCNT(j)]); sum += c; cnt += (c > 0u) ? 1u : 0u; mine = (j == x) ? c : mine; }
        if (sum == G) break;
        __builtin_amdgcn_s_sleep(1);
        if ((++sp & 255u) == 0u) { if (xb_ld(&bar[XB_TMO])) break; if (sp > XB_SPIN_CAP) { atomicAdd(&bar[XB_TMO], 1u); break; } }
    }
    nloc = mine > 0u ? mine : 1u; nx = cnt > 0u ? cnt : 1u;
}

__device__ __forceinline__ void xcd_barrier(const XcdBarrier& b) {
    asm volatile("s_waitcnt vmcnt(0)" ::: "memory");
    __syncthreads();
    if (threadIdx.x == 0) {
        unsigned* bar = b.bar;
        __builtin_amdgcn_s_waitcnt(0);
        unsigned nloc = b.st[0], nx = b.st[1];
        if (nloc == 0u) { xcd_barrier_complete(bar, b.x, nloc, nx); b.st[0] = nloc; b.st[1] = nx; }
        const unsigned old = xb_add(&bar[XB_XSUB(b.x)], 1u);
        const unsigned gen = old / nloc;
        if (old + 1u == (gen + 1u) * nloc) {
            __builtin_amdgcn_fence(__ATOMIC_RELEASE, "agent");
            asm volatile("s_waitcnt vmcnt(0)" ::: "memory");
            const unsigned og = xb_add(&bar[XB_TOP], 1u);
            const unsigned tg = og / nx;
            if (og + 1u == (tg + 1u) * nx) xb_add(&bar[XB_TOPGEN], 1u);
            else XB_SPIN(xb_ld(&bar[XB_TOPGEN]) == tg, bar);
            __builtin_amdgcn_fence(__ATOMIC_ACQUIRE, "agent");
            xb_add(&bar[XB_XGEN(b.x)], 1u);
            asm volatile("s_waitcnt vmcnt(0)" ::: "memory");
        } else {
            XB_SPIN(xb_ld(&bar[XB_XGEN(b.x)]) == gen, bar);
            __builtin_amdgcn_fence(__ATOMIC_ACQUIRE, "agent");
            asm volatile("s_waitcnt vmcnt(0)" ::: "memory");
        }
    }
    __syncthreads();
}


__global__ void __launch_bounds__(256, 2) fwd_megakernel(Params p) {
  extern __shared__ __attribute__((aligned(16))) char smem[];
  __shared__ uint4 xb_words;
  cg::grid_group grid = cg::this_grid();
  if (threadIdx.x == 0) xb_words = make_uint4(0u, 0u, 0u, 0u);
  __syncthreads();
  XcdBarrier xb = xcd_barrier_post((unsigned*)(p.ws + OFF_BAR), (volatile LAS unsigned*)&xb_words);
  phase_prep(p, smem);
  if (p.ws == nullptr) grid.sync();
  xcd_barrier(xb);
  phase_normmod(p, 0, p.x, p.ctx, true);
  xcd_barrier(xb);
  phase_gemm_wide<0>(p, smem, (const u16*)(p.ws + OFF_HB), (const u16*)(p.ws + OFF_WT_IN0), T_ALL / 128, N0 / 256);
  xcd_barrier(xb);
  phase_scan<1>(p, smem);
  xcd_barrier(xb);
  phase_carry(p, smem);
  xcd_barrier(xb);
  phase_scan<2>(p, smem);
  xcd_barrier(xb);
  phase_readout(p);
  xcd_barrier(xb);
  phase_gemm<1>(p, smem, (const u16*)(p.ws + OFF_HB), (const u16*)(p.ws + OFF_WT_OUT0), T_ALL / 128, 8);
  xcd_barrier(xb);
  phase_normmod(p, 1, p.out, (const float*)(p.ws + OFF_XC1), false);
  xcd_barrier(xb);
  phase_gemm_wide<2>(p, smem, (const u16*)(p.ws + OFF_HB), (const u16*)(p.ws + OFF_WT_IN1), T_ALL / 128, N1 / 256);
  xcd_barrier(xb);
  phase_qkprep(p);
  xcd_barrier(xb);
  phase_attn(p, smem);
  xcd_barrier(xb);
  phase_gemm<3>(p, smem, (const u16*)(p.ws + OFF_Y2), (const u16*)(p.ws + OFF_WT_OUT1), T_LAT / 128, 8);
}

extern "C" void kernel_launch(void* const* d_in, const int* in_sizes, int n_in, void* d_out, int out_size, void* d_ws,
                              size_t ws_size, hipStream_t stream) {
  static int grid_blocks = 0;
  if (!grid_blocks) {
    int dev = 0, cus = 0, per_cu = 0;
    hipGetDevice(&dev);
    hipDeviceGetAttribute(&cus, hipDeviceAttributeMultiprocessorCount, dev);
    hipFuncSetAttribute((const void*)fwd_megakernel, hipFuncAttributeMaxDynamicSharedMemorySize, LDS_BYTES);
    hipOccupancyMaxActiveBlocksPerMultiprocessor(&per_cu, fwd_megakernel, 256, LDS_BYTES);
    if (per_cu < 1) per_cu = 1;
    if (per_cu > 2) per_cu = 2;
    grid_blocks = cus * per_cu;
    if (ws_size < 256 * MiB) fprintf(stderr, "kernel_launch: workspace too small: %zu\n", ws_size);
  }
  Params p{};
  const float** pp = (const float**)&p;
  for (int i = 0; i < 25; ++i) pp[i] = (const float*)d_in[i];
  p.out = (float*)d_out;
  p.ws = (char*)d_ws;
  hipMemsetAsync((char*)d_ws + OFF_BAR, 0, XCD_BAR_WORDS * sizeof(unsigned), stream);
  void* args[] = {&p};
  hipError_t e = hipLaunchCooperativeKernel((void*)fwd_megakernel, dim3(grid_blocks), dim3(256), args, LDS_BYTES, stream);
  if (e != hipSuccess) fprintf(stderr, "cooperative launch failed: %s (grid %d)\n", hipGetErrorString(e), grid_blocks);
}
```

```cpp
#include <hip/hip_runtime.h>
#include <hip/hip_cooperative_groups.h>
#include <cstdio>
namespace cg = cooperative_groups;

#define DI __device__ __forceinline__
typedef unsigned short u16;
using bf16x8 = __attribute__((ext_vector_type(8))) short;
using s16x4  = __attribute__((ext_vector_type(4))) short;
using f32x16 = __attribute__((ext_vector_type(16))) float;
using f32x4  = __attribute__((ext_vector_type(4))) float;
using f32x32 = __attribute__((ext_vector_type(32))) float;
using f2     = __attribute__((ext_vector_type(2))) float;
using u32x4  = __attribute__((ext_vector_type(4))) unsigned;
using u32x2  = __attribute__((ext_vector_type(2))) unsigned;

constexpr int T_LAT = 16384, T_CTX = 512, T_ALL = 16896, DM = 1024;
constexpr int N0 = 4352, N1 = 4096;
constexpr int LKV = 8448;
constexpr int NCHUNK = 32, LCH = 264, NSUB = 33;

constexpr size_t MiB = 1048576;
constexpr size_t OFF_WT_IN0 = 0;
constexpr size_t OFF_WT_OUT0 = 8912896;
constexpr size_t OFF_WT_IN1 = 11010048;
constexpr size_t OFF_WT_OUT1 = 19398656;
constexpr size_t OFF_W2T = 21495808;
constexpr size_t OFF_A2T = 21757952;
constexpr size_t OFF_MOD = 21 * MiB;
constexpr size_t OFF_ROPE = OFF_MOD + 73728;
constexpr size_t OFF_BONUS = 21 * MiB + 131072;
constexpr size_t OFF_XC1 = 24 * MiB;
constexpr size_t OFF_OCTX = 26 * MiB;
constexpr size_t OFF_BAR = 29 * MiB;
constexpr size_t OFF_PROJ = 30 * MiB;
constexpr size_t OFF_HB = 171 * MiB;
constexpr size_t OFF_STP = 171 * MiB;
constexpr size_t OFF_STS = 203 * MiB;
constexpr size_t OFF_RAW = 30 * MiB;
constexpr size_t OFF_VT = 96 * MiB;
constexpr size_t OFF_KS = 129 * MiB;
constexpr size_t OFF_GB = 204 * MiB;
constexpr size_t OFF_QS = OFF_HB;
constexpr size_t OFF_Y2 = OFF_RAW;

constexpr int LDS_BYTES = 78336;

struct Params {
  const float *x, *c, *ctx, *c_ctx, *ada_w, *ada_b, *norm_g, *rw_in, *rw_mu, *rw_w0, *rw_w2, *rw_a0, *rw_a2,
      *rw_kk, *rw_ka, *rw_rk, *rw_gn_g, *rw_gn_b, *rw_out, *da_in, *da_qn, *da_kn, *da_lam, *da_subln, *da_out;
  float* out;
  char* ws;
};

DI u16 f2bf(float x) { unsigned u = __float_as_uint(x); u += 0x7fffu + ((u >> 16) & 1u); return (u16)(u >> 16); }
DI float bf2f(u16 h) { return __uint_as_float(((unsigned)h) << 16); }
DI unsigned pack2(float a, float b) { return (unsigned)f2bf(a) | ((unsigned)f2bf(b) << 16); }
typedef __bf16 bf16v2 __attribute__((ext_vector_type(2)));
DI unsigned cvtpk(float a, float b) { f2 v = {a, b}; return __builtin_bit_cast(unsigned, __builtin_convertvector(v, bf16v2)); }
DI float fsig(float x) { return __builtin_amdgcn_rcpf(1.0f + __expf(-x)); }
DI int ltid() { int t = threadIdx.x; asm volatile("" : "+v"(t)); return t; }
DI float bflo(unsigned u) { return __uint_as_float(u << 16); }
DI float bfhi(unsigned u) { return __uint_as_float(u & 0xffff0000u); }
DI float sigmoidf_(float x) { return 1.0f / (1.0f + __expf(-x)); }
DI float siluf_(float x) { return x * sigmoidf_(x); }
DI int crow(int i, int h) { return (i & 3) + 8 * (i >> 2) + 4 * h; }
DI void unpack8(const u32x4& u, float* f) {
  f[0] = bflo(u[0]); f[1] = bfhi(u[0]); f[2] = bflo(u[1]); f[3] = bfhi(u[1]);
  f[4] = bflo(u[2]); f[5] = bfhi(u[2]); f[6] = bflo(u[3]); f[7] = bfhi(u[3]);
}
#define WAVE_LDS_SYNC() asm volatile("s_waitcnt lgkmcnt(0)" ::: "memory")
#define MFMA32(a, b, c) __builtin_amdgcn_mfma_f32_32x32x16_bf16((a), (b), (c), 0, 0, 0)
#define MFMA16(a, b, c) __builtin_amdgcn_mfma_f32_16x16x32_bf16((a), (b), (c), 0, 0, 0)

__device__ const float INV_FREQ[16] = {
    1.0f, 0.5623413251903491f, 0.31622776601683794f, 0.1778279410038923f, 0.1f, 0.05623413251903491f,
    0.03162277660168379f, 0.01778279410038923f, 0.01f, 0.005623413251903491f, 0.0031622776601683794f,
    0.001778279410038923f, 0.001f, 0.0005623413251903491f, 0.00031622776601683794f, 0.0001778279410038923f};

DI void transpose_tile(const float* __restrict__ src, u16* __restrict__ dst, int K, int N, int kt, int nt, float* tile) {
  const int TIDX = ltid();
  const int tid = TIDX;
  {
    const int n = tid & 63, k0 = tid >> 6;
#pragma unroll
    for (int i = 0; i < 16; ++i) {
      const int k = k0 + 4 * i;
      tile[k * 65 + n] = src[(size_t)(kt * 64 + k) * N + nt * 64 + n];
    }
  }
  __syncthreads();
  {
    const int n = tid >> 2, kq = tid & 3;
    unsigned pk[8];
#pragma unroll
    for (int j = 0; j < 8; ++j) pk[j] = pack2(tile[(kq * 16 + 2 * j) * 65 + n], tile[(kq * 16 + 2 * j + 1) * 65 + n]);
    u32x4* d = (u32x4*)(dst + (size_t)(nt * 64 + n) * K + kt * 64 + kq * 16);
    d[0] = u32x4{pk[0], pk[1], pk[2], pk[3]};
    d[1] = u32x4{pk[4], pk[5], pk[6], pk[7]};
  }
  __syncthreads();
}

DI void phase_prep(const Params& p, char* smem) {
  const int TIDX = ltid();
  float* tile = (float*)smem;
  const int tid = TIDX;
  constexpr int T_IN0 = 16 * 68, T_OUT = 256, T_IN1 = 16 * 64, T_LORA = 16;
  constexpr int E0 = T_IN0, E1 = E0 + T_OUT, E2 = E1 + T_IN1, E3 = E2 + T_OUT, E4 = E3 + 2 * T_LORA, E5 = E4 + 2 * T_LORA;
  constexpr int NMOD = 192;
  constexpr int TOTAL = E5 + NMOD + 1;
  for (int it = blockIdx.x; it < TOTAL; it += gridDim.x) {
    if (it < E0) { transpose_tile(p.rw_in, (u16*)(p.ws + OFF_WT_IN0), 1024, N0, it / 68, it % 68, tile); }
    else if (it < E1) { int j = it - E0; transpose_tile(p.rw_out, (u16*)(p.ws + OFF_WT_OUT0), 1024, 1024, j >> 4, j & 15, tile); }
    else if (it < E2) { int j = it - E1; transpose_tile(p.da_in, (u16*)(p.ws + OFF_WT_IN1), 1024, N1, j >> 6, j & 63, tile); }
    else if (it < E3) { int j = it - E2; transpose_tile(p.da_out, (u16*)(p.ws + OFF_WT_OUT1), 1024, 1024, j >> 4, j & 15, tile); }
    else if (it < E4) { int j = it - E3; int d = j >> 4; transpose_tile(p.rw_w2 + (size_t)d * 65536, (u16*)(p.ws + OFF_W2T) + (size_t)d * 65536, 64, 1024, 0, j & 15, tile); }
    else if (it < E5) { int j = it - E4; int d = j >> 4; transpose_tile(p.rw_a2 + (size_t)d * 65536, (u16*)(p.ws + OFF_A2T) + (size_t)d * 65536, 64, 1024, 0, j & 15, tile); }
    else if (it < E5 + NMOD) {
      const int j = it - E5; const int layer = j / 96; const int nb = (j % 96) * 32;
      const int n = nb + (tid & 31), kg = tid >> 5;
      const float* W = p.ada_w + (size_t)layer * 1024 * 3072;
      float a0 = 0.f, a1 = 0.f, a2 = 0.f;
#pragma unroll 8
      for (int k = kg * 128; k < kg * 128 + 128; ++k) {
        const float w = W[(size_t)k * 3072 + n];
        a0 += siluf_(p.c[k]) * w; a1 += siluf_(p.c[1024 + k]) * w; a2 += siluf_(p.c_ctx[k]) * w;
      }
      tile[(kg * 3 + 0) * 32 + (tid & 31)] = a0; tile[(kg * 3 + 1) * 32 + (tid & 31)] = a1; tile[(kg * 3 + 2) * 32 + (tid & 31)] = a2;
      __syncthreads();
      if (tid < 96) {
        const int s = tid >> 5, nn = tid & 31;
        float acc = p.ada_b[layer * 3072 + nb + nn];
#pragma unroll
        for (int g = 0; g < 8; ++g) acc += tile[(g * 3 + s) * 32 + nn];
        ((float*)(p.ws + OFF_MOD))[(layer * 3 + s) * 3072 + nb + nn] = acc;
      }
      __syncthreads();
    } else {
      float* rope = (float*)(p.ws + OFF_ROPE);
      for (int e = tid; e < 2048; e += 256) {
        const int pos = e >> 4, f = e & 15;
        const float ang = (float)pos * INV_FREQ[f];
        const float rev = ang * 0.15915494309189535f;
        const float fr = rev - rintf(rev);
        const float a = fr * 6.283185307179586f;
        rope[e] = __cosf(a); rope[2048 + e] = __sinf(a);
      }
    }
  }
}

DI void phase_normmod(const Params& p, int layer, const float* __restrict__ xl, const float* __restrict__ xc, bool zero_o) {
  const int TIDX = ltid();
  const int lane = TIDX & 63, wv = __builtin_amdgcn_readfirstlane(TIDX >> 6);
  const float* mod = (const float*)(p.ws + OFF_MOD) + layer * 3 * 3072;
  const float* g = p.norm_g + layer * 1024;
  u16* hb = (u16*)(p.ws + OFF_HB);
  for (int row = blockIdx.x * 4 + wv; row < T_ALL; row += gridDim.x * 4) {
    const float* src; const float* m;
    if (row < T_LAT) { src = xl + (size_t)row * 1024; m = mod + (row >> 13) * 3072; }
    else { src = xc + (size_t)(row - T_LAT) * 1024; m = mod + 2 * 3072; }
    float v[16];
    float ss = 0.f;
#pragma unroll
    for (int q = 0; q < 4; ++q) {
      const f32x4 t = *(const f32x4*)(src + lane * 16 + q * 4);
      v[q * 4] = t[0]; v[q * 4 + 1] = t[1]; v[q * 4 + 2] = t[2]; v[q * 4 + 3] = t[3];
      ss += t[0] * t[0] + t[1] * t[1] + t[2] * t[2] + t[3] * t[3];
    }
#pragma unroll
    for (int o = 32; o >= 1; o >>= 1) ss += __shfl_xor(ss, o);
    const float rstd = rsqrtf(ss * (1.0f / 1024.0f) + 1e-6f);
    unsigned pk[8];
#pragma unroll
    for (int j = 0; j < 8; ++j) {
      const int c0 = lane * 16 + 2 * j;
      const float h0 = v[2 * j] * rstd * g[c0] * (1.0f + m[1024 + c0]) + m[c0];
      const float h1 = v[2 * j + 1] * rstd * g[c0 + 1] * (1.0f + m[1024 + c0 + 1]) + m[c0 + 1];
      pk[j] = pack2(h0, h1);
    }
    u32x4* d = (u32x4*)(hb + (size_t)row * 1024 + lane * 16);
    d[0] = u32x4{pk[0], pk[1], pk[2], pk[3]};
    d[1] = u32x4{pk[4], pk[5], pk[6], pk[7]};
    if (zero_o) {
      float* o = (row < T_LAT) ? (p.out + (size_t)row * 1024) : ((float*)(p.ws + OFF_OCTX) + (size_t)(row - T_LAT) * 1024);
      const f32x4 z = {0.f, 0.f, 0.f, 0.f};
#pragma unroll
      for (int q = 0; q < 4; ++q) *(f32x4*)(o + lane * 16 + q * 4) = z;
    }
  }
}

constexpr int LDT = 72;
#ifndef REP_GEMM
#define REP_GEMM 1
#endif
#ifndef REP_SCAN
#define REP_SCAN 1
#endif
#ifndef REP_ATTN
#define REP_ATTN 1
#endif
template <int EPI>
DI void phase_gemm(const Params& p, char* smem, const u16* __restrict__ A, const u16* __restrict__ Bt, int Mtiles, int Ntiles, int Mbase = 0) {
  const int TIDX = ltid();
  u16* As0 = (u16*)smem;
  const int tid = TIDX, lane = tid & 63, wv = __builtin_amdgcn_readfirstlane(tid >> 6);
  const int r = lane & 31, h = lane >> 5;
  const int wm = wv >> 1, wn = wv & 1;
  const int ntiles = Mtiles * Ntiles;
  const int npad = (ntiles + 511) & ~511;
  int repg = (EPI == 0 || EPI == 2) ? REP_GEMM : 1; asm volatile("" : "+s"(repg));
  for (int rp = 0; rp < repg; ++rp)
  for (int tt = blockIdx.x; tt < npad; tt += gridDim.x) {
    const int tile = (tt & ~511) + ((tt & 7) << 6) + ((tt >> 3) & 63);
    if (tile >= ntiles) continue;
    const int band = tile / (4 * Ntiles), rem = tile % (4 * Ntiles);
    const int mt_ = band * 4 + (rem & 3), nt_ = rem >> 2;
    const int m0 = (Mbase + mt_) * 128, n0 = nt_ * 128;
    f32x16 acc[2][2];
#pragma unroll
    for (int a = 0; a < 2; ++a)
#pragma unroll
      for (int b = 0; b < 2; ++b)
#pragma unroll
        for (int i = 0; i < 16; ++i) acc[a][b][i] = 0.f;
    u32x4 ra[4], rb[4];
    const u16* Ag = A + (size_t)m0 * 1024;
    const u16* Bg = Bt + (size_t)n0 * 1024;
#pragma unroll
    for (int i = 0; i < 4; ++i) {
      const int id = tid + 256 * i; const int row = id >> 3, cc = id & 7;
      ra[i] = *(const u32x4*)(Ag + (size_t)row * 1024 + cc * 8);
      rb[i] = *(const u32x4*)(Bg + (size_t)row * 1024 + cc * 8);
    }
    __syncthreads();
    for (int kt = 0; kt < 16; ++kt) {
      u16* As = As0 + (kt & 1) * (256 * LDT);
      u16* Bs = As + 128 * LDT;
#pragma unroll
      for (int i = 0; i < 4; ++i) {
        const int id = tid + 256 * i; const int row = id >> 3, cc = id & 7;
        *(u32x4*)(As + row * LDT + cc * 8) = ra[i];
        *(u32x4*)(Bs + row * LDT + cc * 8) = rb[i];
      }
      __syncthreads();
      if (kt + 1 < 16) {
#pragma unroll
        for (int i = 0; i < 4; ++i) {
          const int id = tid + 256 * i; const int row = id >> 3, cc = id & 7;
          ra[i] = *(const u32x4*)(Ag + (size_t)row * 1024 + (kt + 1) * 64 + cc * 8);
          rb[i] = *(const u32x4*)(Bg + (size_t)row * 1024 + (kt + 1) * 64 + cc * 8);
        }
      }
#pragma unroll
      for (int ks = 0; ks < 4; ++ks) {
        bf16x8 fa[2], fb[2];
#pragma unroll
        for (int t = 0; t < 2; ++t) {
          fa[t] = *(const bf16x8*)(As + (wm * 64 + t * 32 + r) * LDT + ks * 16 + 8 * h);
          fb[t] = *(const bf16x8*)(Bs + (wn * 64 + t * 32 + r) * LDT + ks * 16 + 8 * h);
        }
#pragma unroll
        for (int a = 0; a < 2; ++a)
#pragma unroll
          for (int b = 0; b < 2; ++b) acc[a][b] = MFMA32(fa[a], fb[b], acc[a][b]);
      }
    }
#pragma unroll
    for (int a = 0; a < 2; ++a)
#pragma unroll
      for (int b = 0; b < 2; ++b) {
        const int col = n0 + wn * 64 + b * 32 + r;
        const int rbase = m0 + wm * 64 + a * 32;
        if (EPI == 0) {
          u16* C = (u16*)(p.ws + OFF_PROJ);
#pragma unroll
          for (int i = 0; i < 16; ++i) C[(size_t)(rbase + crow(i, h)) * N0 + col] = f2bf(acc[a][b][i]);
        } else if (EPI == 1) {
          const float* mod = (const float*)(p.ws + OFF_MOD);
#pragma unroll
          for (int i = 0; i < 16; ++i) {
            const int row = rbase + crow(i, h);
            if (row < T_LAT) {
              const float gate = mod[(row >> 13) * 3072 + 2048 + col];
              p.out[(size_t)row * 1024 + col] = p.x[(size_t)row * 1024 + col] + gate * acc[a][b][i];
            } else {
              const int rc = row - T_LAT;
              const float gate = mod[2 * 3072 + 2048 + col];
              ((float*)(p.ws + OFF_XC1))[(size_t)rc * 1024 + col] = p.ctx[(size_t)rc * 1024 + col] + gate * acc[a][b][i];
            }
          }
        } else if (EPI == 2) {
          if (n0 < 2048) {
            u16* C = (u16*)(p.ws + OFF_RAW);
#pragma unroll
            for (int i = 0; i < 16; ++i) C[(size_t)(rbase + crow(i, h)) * 2048 + col] = f2bf(acc[a][b][i]);
          } else if (n0 < 3072) {
            u16* Vt = (u16*)(p.ws + OFF_VT);
            const int e = col - 2048;
#pragma unroll
            for (int g = 0; g < 4; ++g) {
              const int row = rbase + 8 * g + 4 * h;
              int bb, pp;
              if (row < T_LAT) { bb = row >> 13; pp = 256 + (row & 8191); } else { bb = (row - T_LAT) >> 8; pp = (row - T_LAT) & 255; }
              u32x2 v = {cvtpk(acc[a][b][4 * g], acc[a][b][4 * g + 1]), cvtpk(acc[a][b][4 * g + 2], acc[a][b][4 * g + 3])};
              const int q4 = (pp >> 2) & 3;
              const int pq = (pp & ~15) | ((((q4 & 1) << 1) | (q4 >> 1)) << 2);
              *(u32x2*)(Vt + ((size_t)bb * 1024 + e) * LKV + pq) = v;
            }
          } else {
            u16* G = (u16*)(p.ws + OFF_GB);
#pragma unroll
            for (int i = 0; i < 16; ++i) {
              const int row = rbase + crow(i, h);
              if (row < T_LAT) G[(size_t)row * 1024 + col - 3072] = f2bf(siluf_(acc[a][b][i]));
            }
          }
        } else {
          const float* mod = (const float*)(p.ws + OFF_MOD) + 3 * 3072;
#pragma unroll
          for (int i = 0; i < 16; ++i) {
            const int row = rbase + crow(i, h);
            const float gate = mod[(row >> 13) * 3072 + 2048 + col];
            float* o = p.out + (size_t)row * 1024 + col;
            *o = *o + gate * acc[a][b][i];
          }
        }
      }
  }
}

template <int EPI>
DI void phase_gemm_wide(const Params& p, char* smem, const u16* __restrict__ A, const u16* __restrict__ Bt, int Mtiles, int Ntiles, int Mbase = 0) {
  const int TIDX = ltid();
  u16* As = (u16*)smem;
  u16* Bs = As + 128 * LDT;
  const int tid = TIDX, lane = tid & 63, wv = __builtin_amdgcn_readfirstlane(tid >> 6);
  const int r = lane & 31, h = lane >> 5;
  const int wm = wv >> 1, wn = wv & 1;
  const int ntiles = Mtiles * Ntiles;
  const int npad = (ntiles + 511) & ~511;
  int repg = (EPI == 0 || EPI == 2) ? REP_GEMM : 1; asm volatile("" : "+s"(repg));
  for (int rp = 0; rp < repg; ++rp)
  for (int tt = blockIdx.x; tt < npad; tt += gridDim.x) {
    const int tile = (tt & ~511) + ((tt & 7) << 6) + ((tt >> 3) & 63);
    if (tile >= ntiles) continue;
    const int band = tile / (4 * Ntiles), rem = tile % (4 * Ntiles);
    const int mt_ = band * 4 + (rem & 3), nt_ = rem >> 2;
    const int m0 = (Mbase + mt_) * 128, n0 = nt_ * 256;
    f32x16 acc[2][4];
#pragma unroll
    for (int a = 0; a < 2; ++a)
#pragma unroll
      for (int b = 0; b < 4; ++b)
#pragma unroll
        for (int i = 0; i < 16; ++i) acc[a][b][i] = 0.f;
    u32x4 ra[4], rb[8];
    const u16* Ag = A + (size_t)m0 * 1024;
    const u16* Bg = Bt + (size_t)n0 * 1024;
#pragma unroll
    for (int i = 0; i < 8; ++i) {
      const int id = tid + 256 * i; const int row = id >> 3, cc = id & 7;
      if (i < 4) ra[i] = *(const u32x4*)(Ag + (size_t)row * 1024 + cc * 8);
      rb[i] = *(const u32x4*)(Bg + (size_t)row * 1024 + cc * 8);
    }
    for (int kt = 0; kt < 16; ++kt) {
      __syncthreads();
      int ts = tid; asm volatile("" : "+v"(ts));
#pragma unroll
      for (int i = 0; i < 8; ++i) {
        const int id = ts + 256 * i; const int row = id >> 3, cc = id & 7;
        if (i < 4) *(u32x4*)(As + row * LDT + cc * 8) = ra[i];
        *(u32x4*)(Bs + row * LDT + cc * 8) = rb[i];
      }
      __syncthreads();
      if (kt + 1 < 16) {
        int tl = tid; asm volatile("" : "+v"(tl));
#pragma unroll
        for (int i = 0; i < 8; ++i) {
          const int id = tl + 256 * i; const int row = id >> 3, cc = id & 7;
          if (i < 4) ra[i] = *(const u32x4*)(Ag + (size_t)row * 1024 + (kt + 1) * 64 + cc * 8);
          rb[i] = *(const u32x4*)(Bg + (size_t)row * 1024 + (kt + 1) * 64 + cc * 8);
        }
      }
#pragma unroll
      for (int ks = 0; ks < 4; ++ks) {
        bf16x8 fa[2], fb[4];
#pragma unroll
        for (int t = 0; t < 2; ++t) fa[t] = *(const bf16x8*)(As + (wm * 64 + t * 32 + r) * LDT + ks * 16 + 8 * h);
#pragma unroll
        for (int t = 0; t < 4; ++t) fb[t] = *(const bf16x8*)(Bs + (wn * 128 + t * 32 + r) * LDT + ks * 16 + 8 * h);
#pragma unroll
        for (int a = 0; a < 2; ++a)
#pragma unroll
          for (int b = 0; b < 4; ++b) acc[a][b] = MFMA32(fa[a], fb[b], acc[a][b]);
      }
    }
#pragma unroll
    for (int a = 0; a < 2; ++a)
#pragma unroll
      for (int b = 0; b < 4; ++b) {
        const int col = n0 + wn * 128 + b * 32 + r;
        const int rbase = m0 + wm * 64 + a * 32;
        if (EPI == 0) {
          u16* C = (u16*)(p.ws + OFF_PROJ);
#pragma unroll
          for (int i = 0; i < 16; ++i) C[(size_t)(rbase + crow(i, h)) * N0 + col] = f2bf(acc[a][b][i]);
        } else if (EPI == 1) {
          const float* mod = (const float*)(p.ws + OFF_MOD);
#pragma unroll
          for (int i = 0; i < 16; ++i) {
            const int row = rbase + crow(i, h);
            if (row < T_LAT) {
              const float gate = mod[(row >> 13) * 3072 + 2048 + col];
              p.out[(size_t)row * 1024 + col] = p.x[(size_t)row * 1024 + col] + gate * acc[a][b][i];
            } else {
              const int rc = row - T_LAT;
              const float gate = mod[2 * 3072 + 2048 + col];
              ((float*)(p.ws + OFF_XC1))[(size_t)rc * 1024 + col] = p.ctx[(size_t)rc * 1024 + col] + gate * acc[a][b][i];
            }
          }
        } else if (EPI == 2) {
          if (n0 < 2048) {
            u16* C = (u16*)(p.ws + OFF_RAW);
#pragma unroll
            for (int i = 0; i < 16; ++i) C[(size_t)(rbase + crow(i, h)) * 2048 + col] = f2bf(acc[a][b][i]);
          } else if (n0 < 3072) {
            u16* Vt = (u16*)(p.ws + OFF_VT);
            const int e = col - 2048;
#pragma unroll
            for (int g = 0; g < 4; ++g) {
              const int row = rbase + 8 * g + 4 * h;
              int bb, pp;
              if (row < T_LAT) { bb = row >> 13; pp = 256 + (row & 8191); } else { bb = (row - T_LAT) >> 8; pp = (row - T_LAT) & 255; }
              u32x2 v = {cvtpk(acc[a][b][4 * g], acc[a][b][4 * g + 1]), cvtpk(acc[a][b][4 * g + 2], acc[a][b][4 * g + 3])};
              const int q4 = (pp >> 2) & 3;
              const int pq = (pp & ~15) | ((((q4 & 1) << 1) | (q4 >> 1)) << 2);
              *(u32x2*)(Vt + ((size_t)bb * 1024 + e) * LKV + pq) = v;
            }
          } else {
            u16* G = (u16*)(p.ws + OFF_GB);
#pragma unroll
            for (int i = 0; i < 16; ++i) {
              const int row = rbase + crow(i, h);
              if (row < T_LAT) G[(size_t)row * 1024 + col - 3072] = f2bf(siluf_(acc[a][b][i]));
            }
          }
        } else {
          const float* mod = (const float*)(p.ws + OFF_MOD) + 3 * 3072;
#pragma unroll
          for (int i = 0; i < 16; ++i) {
            const int row = rbase + crow(i, h);
            const float gate = mod[(row >> 13) * 3072 + 2048 + col];
            float* o = p.out + (size_t)row * 1024 + col;
            *o = *o + gate * acc[a][b][i];
          }
        }
      }
  }
}

DI void tokmap(int pos, int d, int b, int& row, bool& hp, bool& hn) {
  if (pos < 256) { const int t = d ? 255 - pos : pos; row = T_LAT + b * 256 + t; hp = t > 0; hn = t < 255; }
  else { const int q = pos - 256; const int t = d ? 8191 - q : q; row = b * 8192 + t; hp = t > 0; hn = t < 8191; }
}

DI void load_mix8(const u16* pr, bool hp, bool hn, const float* mu, float* out) {
  const u32x4 uc = *(const u32x4*)pr;
  u32x4 up = {0u, 0u, 0u, 0u}, un = {0u, 0u, 0u, 0u};
  if (hp) up = *(const u32x4*)(pr - N0);
  if (hn) un = *(const u32x4*)(pr + N0);
  float c[8], a[8], n[8];
  unpack8(uc, c); unpack8(up, a); unpack8(un, n);
  const f32x4 m0 = *(const f32x4*)mu, m1 = *(const f32x4*)(mu + 4);
#pragma unroll
  for (int j = 0; j < 8; ++j) {
    const float m = j < 4 ? m0[j & 3] : m1[j & 3];
    out[j] = c[j] + m * (0.5f * (a[j] + n[j]) - c[j]);
  }
}

DI void mixraw8(const u32x4& uc, const u32x4& up, const u32x4& un, bool hp, bool hn, const float* mu, float* out) {
  float c[8], a[8], n[8];
  unpack8(uc, c); unpack8(up, a); unpack8(un, n);
  const f32x4 m0 = *(const f32x4*)mu, m1 = *(const f32x4*)(mu + 4);
#pragma unroll
  for (int j = 0; j < 8; ++j) {
    const float m = j < 4 ? m0[j & 3] : m1[j & 3];
    const float av = hp ? a[j] : 0.f, nv = hn ? n[j] : 0.f;
    out[j] = c[j] + m * (0.5f * (av + nv) - c[j]);
  }
}

template <int PASS>
DI void phase_scan(const Params& p, char* smem) {
  const int TIDX = ltid();
  const int lane = TIDX & 63, wv = __builtin_amdgcn_readfirstlane(TIDX >> 6);
  float* sm = (float*)smem + wv * 3584;
  float* sW = sm; float* sKK = sm + 512; float* sKKA = sm + 1024; float* sKD = sm + 1536; float* sR = sm + 2048; float* sV = sm + 2560; float* sA = sm + 3072;
  const u16* proj = (const u16*)(p.ws + OFF_PROJ);
  float* stP = (float*)(p.ws + OFF_STP);
  float* stS = (float*)(p.ws + OFF_STS);
  float* bonus = (float*)(p.ws + OFF_BONUS);
  const int nwaves = gridDim.x * 4;
  int reps = (PASS == 1) ? REP_SCAN : 1; asm volatile("" : "+s"(reps));
  for (int rp = 0; rp < reps; ++rp)
  for (int item = blockIdx.x * 4 + wv; item < 2048; item += nwaves) {
    const int chain = item >> 5, chunk = item & 31;
    const int d = chain & 1, hh = (chain >> 1) & 15, b = chain >> 5;
    u16* cB = (u16*)(smem + 57344);
    float* cP = (float*)(smem + 57344 + 18432);
    __syncthreads();
    {
      const int tid = TIDX;
#pragma unroll
      for (int i = 0; i < 4; ++i) {
        const int id = tid + 256 * i;
        const int which = id >> 9, row = (id >> 3) & 63, cc = id & 7;
        const u16* src = (const u16*)(p.ws + (which ? OFF_A2T : OFF_W2T)) + ((size_t)d * 1024 + hh * 64 + row) * 64 + cc * 8;
        *(u32x4*)(cB + (which * 64 + row) * 72 + cc * 8) = *(const u32x4*)src;
      }
      if (tid < 160) {
        const int a = tid >> 4, q = (tid & 15) * 4;
        const float* src;
        switch (a) {
          case 0: src = p.rw_mu + 3072 + d * 64; break;
          case 1: src = p.rw_mu + 3072 + 128 + d * 64; break;
          case 2: src = p.rw_mu + hh * 64; break;
          case 3: src = p.rw_mu + 1024 + hh * 64; break;
          case 4: src = p.rw_mu + 2048 + hh * 64; break;
          case 5: src = p.rw_w0 + d * 1024 + hh * 64; break;
          case 6: src = p.rw_a0 + d * 1024 + hh * 64; break;
          case 7: src = p.rw_kk + hh * 64; break;
          case 8: src = p.rw_ka + hh * 64; break;
          default: src = p.rw_rk + hh * 64; break;
        }
        *(f32x4*)(cP + a * 64 + q) = *(const f32x4*)(src + q);
      }
    }
    __syncthreads();
    if (PASS == 1 && chunk == 31) continue;
    f32x16 S[2][2];
    f32x32 P[2];
    {
      int li = lane; asm volatile("" : "+v"(li));
      const int lv = li & 31, lh = li >> 5;
      if (PASS == 1) {
#pragma unroll
        for (int kt = 0; kt < 2; ++kt)
#pragma unroll
          for (int vt = 0; vt < 2; ++vt)
#pragma unroll
            for (int i = 0; i < 16; ++i) {
              S[kt][vt][i] = 0.f;
              P[vt][16 * kt + i] = (32 * kt + (i & 3) + 8 * (i >> 2) + 4 * lh == 32 * vt + lv) ? 1.f : 0.f;
            }
      } else {
        if (chunk == 0) {
#pragma unroll
          for (int kt = 0; kt < 2; ++kt)
#pragma unroll
            for (int vt = 0; vt < 2; ++vt)
#pragma unroll
              for (int i = 0; i < 16; ++i) S[kt][vt][i] = 0.f;
        } else {
          const float* src = stS + (size_t)(item - 1) * 4096;
#pragma unroll
          for (int kt = 0; kt < 2; ++kt)
#pragma unroll
            for (int vt = 0; vt < 2; ++vt)
#pragma unroll
              for (int g = 0; g < 4; ++g) {
                const f32x4 t = *(const f32x4*)(src + (32 * vt + lv) * 64 + 32 * kt + 8 * g + 4 * lh);
                S[kt][vt][4 * g] = t[0]; S[kt][vt][4 * g + 1] = t[1]; S[kt][vt][4 * g + 2] = t[2]; S[kt][vt][4 * g + 3] = t[3];
              }
        }
      }
    }
    for (int sc = 0; sc < NSUB; ++sc) {
      const int p0 = chunk * LCH + sc * 8;
      int ln = lane; asm volatile("" : "+v"(ln));
      u32x4 rawA[2][3], rawB[3][3];
      bool hpA, hnA, hpB, hnB; int rowB;
      {
        int rowA; tokmap(p0 + (ln & 7), d, b, rowA, hpA, hnA);
        const u16* prA = proj + (size_t)rowA * N0 + 4096 + d * 64 + (ln >> 4) * 8 + ((ln >> 3) & 1) * 32;
        const ptrdiff_t dpA = hpA ? -N0 : 0, dnA = hnA ? N0 : 0;
#pragma unroll
        for (int X = 0; X < 2; ++X) {
          const u16* q = prA + X * 128;
          rawA[X][0] = *(const u32x4*)q; rawA[X][1] = *(const u32x4*)(q + dpA); rawA[X][2] = *(const u32x4*)(q + dnA);
        }
        tokmap(p0 + (ln >> 3), d, b, rowB, hpB, hnB);
        const u16* prB = proj + (size_t)rowB * N0 + hh * 64 + (ln & 7) * 8;
        const ptrdiff_t dpB = hpB ? -N0 : 0, dnB = hnB ? N0 : 0;
#pragma unroll
        for (int X = 0; X < 3; ++X) {
          const u16* q = prB + X * 1024;
          rawB[X][0] = *(const u32x4*)q; rawB[X][1] = *(const u32x4*)(q + dpB); rawB[X][2] = *(const u32x4*)(q + dnB);
        }
      }
      {
        const int m = ln & 15, kg = ln >> 4;
        bf16x8 fa[2][2];
        const int ssel = (m >> 3) & 1;
#pragma unroll
        for (int X = 0; X < 2; ++X) {
          float mx[8];
          mixraw8(rawA[X][0], rawA[X][1], rawA[X][2], hpA, hnA, cP + X * 64 + ssel * 32 + kg * 8, mx);
          if (X == 0) {
#pragma unroll
            for (int j = 0; j < 8; ++j) { const float e = __expf(2.0f * mx[j]); mx[j] = 1.0f - 2.0f * __builtin_amdgcn_rcpf(e + 1.0f); }
          }
          u32x4 own = {cvtpk(mx[0], mx[1]), cvtpk(mx[2], mx[3]), cvtpk(mx[4], mx[5]), cvtpk(mx[6], mx[7])};
          u32x4 oth;
#pragma unroll
          for (int q = 0; q < 4; ++q) oth[q] = (unsigned)__shfl_down((int)own[q], 8);
          fa[X][0] = __builtin_bit_cast(bf16x8, own);
          fa[X][1] = __builtin_bit_cast(bf16x8, ssel ? own : oth);
        }
#pragma unroll
        for (int nt = 0; nt < 4; ++nt) {
          f32x4 aw = {0.f, 0.f, 0.f, 0.f}, aa = {0.f, 0.f, 0.f, 0.f};
#pragma unroll
          for (int s = 0; s < 2; ++s) {
            const bf16x8 bw = *(const bf16x8*)(cB + (16 * nt + m) * 72 + s * 32 + kg * 8);
            const bf16x8 ba = *(const bf16x8*)(cB + (64 + 16 * nt + m) * 72 + s * 32 + kg * 8);
            aw = MFMA16(fa[0][s], bw, aw);
            aa = MFMA16(fa[1][s], ba, aa);
          }
          const int ch = 16 * nt + m;
          const float w0 = cP[5 * 64 + ch];
          const float a0 = cP[6 * 64 + ch];
          if (kg < 2) {
#pragma unroll
            for (int rg = 0; rg < 4; ++rg) {
              sW[(4 * kg + rg) * 64 + ch] = w0 + aw[rg];
              sA[(4 * kg + rg) * 64 + ch] = a0 + aa[rg];
            }
          }
        }
      }
      WAVE_LDS_SYNC();
      __builtin_amdgcn_sched_barrier(0);
      {
        const int tk = ln >> 3, g = ln & 7;
        const int row = rowB;
        const int cb = hh * 64 + g * 8;
        float rr[8], kk[8], vv[8];
        mixraw8(rawB[0][0], rawB[0][1], rawB[0][2], hpB, hnB, cP + 2 * 64 + g * 8, rr);
        mixraw8(rawB[1][0], rawB[1][1], rawB[1][2], hpB, hnB, cP + 3 * 64 + g * 8, kk);
        mixraw8(rawB[2][0], rawB[2][1], rawB[2][2], hpB, hnB, cP + 4 * 64 + g * 8, vv);
        float av[8], kkn[8], kd[8], pkkv[8], pkav[8], prkv[8];
        { const f32x4 t0 = *(const f32x4*)(sA + tk * 64 + g * 8), t1 = *(const f32x4*)(sA + tk * 64 + g * 8 + 4);
          av[0] = fsig(t0[0]); av[1] = fsig(t0[1]); av[2] = fsig(t0[2]); av[3] = fsig(t0[3]); av[4] = fsig(t1[0]); av[5] = fsig(t1[1]); av[6] = fsig(t1[2]); av[7] = fsig(t1[3]); }
        { const f32x4 t0 = *(const f32x4*)(sW + tk * 64 + g * 8), t1 = *(const f32x4*)(sW + tk * 64 + g * 8 + 4);
          f32x4 o0, o1;
#pragma unroll
          for (int j = 0; j < 4; ++j) { o0[j] = __expf(-0.6065306597126334f * fsig(t0[j])); o1[j] = __expf(-0.6065306597126334f * fsig(t1[j])); }
          *(f32x4*)(sW + tk * 64 + g * 8) = o0; *(f32x4*)(sW + tk * 64 + g * 8 + 4) = o1; }
        WAVE_LDS_SYNC();
        { float Wc = 1.0f;
#pragma unroll
          for (int j = 0; j < 8; ++j) { Wc *= sW[j * 64 + ln]; sW[j * 64 + ln] = Wc; } }
        WAVE_LDS_SYNC();
        float wcur[8], wprv[8];
        { const f32x4 t0 = *(const f32x4*)(sW + tk * 64 + g * 8), t1 = *(const f32x4*)(sW + tk * 64 + g * 8 + 4);
          const int tp = tk > 0 ? tk - 1 : 0;
          const f32x4 u0 = *(const f32x4*)(sW + tp * 64 + g * 8), u1 = *(const f32x4*)(sW + tp * 64 + g * 8 + 4);
#pragma unroll
          for (int j = 0; j < 4; ++j) { wcur[j] = t0[j]; wcur[j + 4] = t1[j]; wprv[j] = tk > 0 ? u0[j] : 1.0f; wprv[j + 4] = tk > 0 ? u1[j] : 1.0f; } }
        { const float* q7 = cP + 7 * 64 + g * 8;
          const f32x4 a0 = *(const f32x4*)(q7), a1 = *(const f32x4*)(q7 + 4), b0 = *(const f32x4*)(q7 + 64), b1 = *(const f32x4*)(q7 + 68),
                      c0 = *(const f32x4*)(q7 + 128), c1 = *(const f32x4*)(q7 + 132);
#pragma unroll
          for (int j = 0; j < 4; ++j) { pkkv[j] = a0[j]; pkkv[j + 4] = a1[j]; pkav[j] = b0[j]; pkav[j + 4] = b1[j]; prkv[j] = c0[j]; prkv[j + 4] = c1[j]; } }
        float ss = 0.f, bon = 0.f;
#pragma unroll
        for (int j = 0; j < 8; ++j) {
          kkn[j] = kk[j] * pkkv[j]; ss += kkn[j] * kkn[j];
          kd[j] = kk[j] * (1.0f + (av[j] - 1.0f) * pkav[j]);
          bon += rr[j] * kd[j] * prkv[j];
        }
        ss += __shfl_xor(ss, 1); ss += __shfl_xor(ss, 2); ss += __shfl_xor(ss, 4);
        const float inv = rsqrtf(ss + 1e-12f);
        if (PASS == 2) {
          bon += __shfl_xor(bon, 1); bon += __shfl_xor(bon, 2); bon += __shfl_xor(bon, 4);
          if (g == 0) bonus[(size_t)d * (T_ALL * 16) + (size_t)row * 16 + hh] = bon;
        }
        float iw[8];
#pragma unroll
        for (int j = 0; j < 8; ++j) iw[j] = __builtin_amdgcn_rcpf(wcur[j]);
        float* o;
        o = sKK + tk * 64 + g * 8;
        *(f32x4*)o = f32x4{kkn[0] * inv * wprv[0], kkn[1] * inv * wprv[1], kkn[2] * inv * wprv[2], kkn[3] * inv * wprv[3]};
        *(f32x4*)(o + 4) = f32x4{kkn[4] * inv * wprv[4], kkn[5] * inv * wprv[5], kkn[6] * inv * wprv[6], kkn[7] * inv * wprv[7]};
        o = sKKA + tk * 64 + g * 8;
        *(f32x4*)o = f32x4{kkn[0] * inv * av[0] * iw[0], kkn[1] * inv * av[1] * iw[1], kkn[2] * inv * av[2] * iw[2], kkn[3] * inv * av[3] * iw[3]};
        *(f32x4*)(o + 4) = f32x4{kkn[4] * inv * av[4] * iw[4], kkn[5] * inv * av[5] * iw[5], kkn[6] * inv * av[6] * iw[6], kkn[7] * inv * av[7] * iw[7]};
        o = sKD + tk * 64 + g * 8;
        *(f32x4*)o = f32x4{kd[0] * iw[0], kd[1] * iw[1], kd[2] * iw[2], kd[3] * iw[3]};
        *(f32x4*)(o + 4) = f32x4{kd[4] * iw[4], kd[5] * iw[5], kd[6] * iw[6], kd[7] * iw[7]};
        o = sR + tk * 64 + g * 8;
        *(f32x4*)o = f32x4{rr[0] * wcur[0], rr[1] * wcur[1], rr[2] * wcur[2], rr[3] * wcur[3]};
        *(f32x4*)(o + 4) = f32x4{rr[4] * wcur[4], rr[5] * wcur[5], rr[6] * wcur[6], rr[7] * wcur[7]};
        o = sV + tk * 64 + g * 8;
        *(f32x4*)o = f32x4{vv[0], vv[1], vv[2], vv[3]};
        *(f32x4*)(o + 4) = f32x4{vv[4], vv[5], vv[6], vv[7]};
      }
      WAVE_LDS_SYNC();
      __builtin_amdgcn_sched_barrier(0);
      float* obase = nullptr; ptrdiff_t ostep = d ? -1024 : 1024;
      if (PASS == 2) {
        int row0; bool hp0, hn0; tokmap(p0, d, b, row0, hp0, hn0);
        obase = ((row0 < T_LAT) ? (p.out + (size_t)row0 * 1024) : ((float*)(p.ws + OFF_OCTX) + (size_t)(row0 - T_LAT) * 1024)) + hh * 64 + lane;
      }
      const int lv31 = lane & 31, lh1 = lane >> 5;
#pragma unroll 1
      for (int j = 0; j < 8; ++j) {
        f32x4 kkv[2][4];
#pragma unroll
        for (int kt = 0; kt < 2; ++kt)
#pragma unroll
          for (int g = 0; g < 4; ++g) kkv[kt][g] = *(const f32x4*)(sKK + j * 64 + 32 * kt + 8 * g + 4 * lh1);
        float aop[2], vvv[2];
        const float akka = sKKA[j * 64 + lane];
#pragma unroll
        for (int t = 0; t < 2; ++t) {
          aop[t] = (lh1 ? sKD : sKKA)[j * 64 + 32 * t + lv31];
          vvv[t] = sV[j * 64 + 32 * t + lv31];
        }
        float saS[2], saP[2];
#pragma unroll
        for (int vt = 0; vt < 2; ++vt) {
          f2 a2 = {0.f, 0.f}, b2 = {0.f, 0.f};
#pragma unroll
          for (int kt = 0; kt < 2; ++kt)
#pragma unroll
            for (int g = 0; g < 4; ++g) {
              a2 += f2{S[kt][vt][4 * g], S[kt][vt][4 * g + 1]} * f2{kkv[kt][g][0], kkv[kt][g][1]};
              a2 += f2{S[kt][vt][4 * g + 2], S[kt][vt][4 * g + 3]} * f2{kkv[kt][g][2], kkv[kt][g][3]};
              if (PASS == 1) {
                b2 += f2{P[vt][16 * kt + 4 * g], P[vt][16 * kt + 4 * g + 1]} * f2{kkv[kt][g][0], kkv[kt][g][1]};
                b2 += f2{P[vt][16 * kt + 4 * g + 2], P[vt][16 * kt + 4 * g + 3]} * f2{kkv[kt][g][2], kkv[kt][g][3]};
              }
            }
          float x = a2[0] + a2[1];
          x += __shfl_xor(x, 32);
          saS[vt] = x;
          if (PASS == 1) { float y = b2[0] + b2[1]; y += __shfl_xor(y, 32); saP[vt] = y; }
        }
#pragma unroll
        for (int vt = 0; vt < 2; ++vt) {
          const float bS = lh1 ? vvv[vt] : -saS[vt];
          if (PASS == 1) P[vt] = __builtin_amdgcn_mfma_f32_32x32x1f32(akka, -saP[vt], P[vt], 0, 0, 0);
#pragma unroll
          for (int kt = 0; kt < 2; ++kt) {
            S[kt][vt] = __builtin_amdgcn_mfma_f32_32x32x2f32(aop[kt], bS, S[kt][vt], 0, 0, 0);
          }
        }
        if (PASS == 2) {
          f32x4 rv[2][4];
#pragma unroll
          for (int kt = 0; kt < 2; ++kt)
#pragma unroll
            for (int g = 0; g < 4; ++g) rv[kt][g] = *(const f32x4*)(sR + j * 64 + 32 * kt + 8 * g + 4 * lh1);
          float ov[2];
#pragma unroll
          for (int vt = 0; vt < 2; ++vt) {
            f2 a2 = {0.f, 0.f};
#pragma unroll
            for (int kt = 0; kt < 2; ++kt)
#pragma unroll
              for (int g = 0; g < 4; ++g) {
                a2 += f2{S[kt][vt][4 * g], S[kt][vt][4 * g + 1]} * f2{rv[kt][g][0], rv[kt][g][1]};
                a2 += f2{S[kt][vt][4 * g + 2], S[kt][vt][4 * g + 3]} * f2{rv[kt][g][2], rv[kt][g][3]};
              }
            float x = a2[0] + a2[1];
            x += __shfl_xor(x, 32);
            ov[vt] = x;
          }
          atomicAdd(obase + (ptrdiff_t)j * ostep, lh1 ? ov[1] : ov[0]);
        }
      }
      {
        f32x4 w7[2][4];
#pragma unroll
        for (int kt = 0; kt < 2; ++kt)
#pragma unroll
          for (int g = 0; g < 4; ++g) w7[kt][g] = *(const f32x4*)(sW + 7 * 64 + 32 * kt + 8 * g + 4 * lh1);
#pragma unroll
        for (int kt = 0; kt < 2; ++kt)
#pragma unroll
          for (int vt = 0; vt < 2; ++vt)
#pragma unroll
            for (int i = 0; i < 16; ++i) {
              S[kt][vt][i] *= w7[kt][i >> 2][i & 3];
              if (PASS == 1) P[vt][16 * kt + i] *= w7[kt][i >> 2][i & 3];
            }
      }
      WAVE_LDS_SYNC();
    }
    if (PASS == 1) {
      int li = lane; asm volatile("" : "+v"(li));
      const int lv = li & 31, lh = li >> 5;
      float* dP = stP + (size_t)item * 4096;
      float* dS = stS + (size_t)item * 4096;
#pragma unroll
      for (int kt = 0; kt < 2; ++kt)
#pragma unroll
        for (int vt = 0; vt < 2; ++vt)
#pragma unroll
          for (int g = 0; g < 4; ++g) {
            const int off = (32 * vt + lv) * 64 + 32 * kt + 8 * g + 4 * lh;
            *(f32x4*)(dP + off) = f32x4{P[vt][16 * kt + 4 * g], P[vt][16 * kt + 4 * g + 1], P[vt][16 * kt + 4 * g + 2], P[vt][16 * kt + 4 * g + 3]};
            *(f32x4*)(dS + off) = f32x4{S[kt][vt][4 * g], S[kt][vt][4 * g + 1], S[kt][vt][4 * g + 2], S[kt][vt][4 * g + 3]};
          }
    }
  }
}

DI void phase_carry(const Params& p, char* smem) {
  const int TIDX = ltid();
  float* cur = (float*)smem;
  const int tid = TIDX, lane = tid & 63, w = __builtin_amdgcn_readfirstlane(tid >> 6);
  const int lc = lane & 15, lq = lane >> 4;
  float* stP = (float*)(p.ws + OFF_STP);
  float* stS = (float*)(p.ws + OFF_STS);
  for (int it = blockIdx.x; it < 256; it += gridDim.x) {
    const int chain = it >> 2, rg = it & 3;
    const size_t slot0 = (size_t)chain * 32;
    __syncthreads();
    {
      const int row = tid >> 4, c4 = (tid & 15) * 4;
      const f32x4 t = *(const f32x4*)(stS + (slot0 * 64 + rg * 16 + row) * 64 + c4);
      *(f32x4*)(cur + row * 68 + c4) = t;
    }
    __syncthreads();
    float pn[16]; f32x4 an;
    {
      const float* Pm = stP + (slot0 + 1) * 4096;
#pragma unroll
      for (int s = 0; s < 16; ++s) pn[s] = Pm[(size_t)(4 * s + lq) * 64 + 16 * w + lc];
#pragma unroll
      for (int rr = 0; rr < 4; ++rr) an[rr] = stS[((slot0 + 1) * 64 + rg * 16 + 4 * lq + rr) * 64 + 16 * w + lc];
    }
    for (int c = 1; c < 31; ++c) {
      const size_t slot = slot0 + c;
      float pj[16]; f32x4 acc = an;
#pragma unroll
      for (int s = 0; s < 16; ++s) pj[s] = pn[s];
      if (c + 1 < 31) {
        const float* Pm = stP + (slot + 1) * 4096;
#pragma unroll
        for (int s = 0; s < 16; ++s) pn[s] = Pm[(size_t)(4 * s + lq) * 64 + 16 * w + lc];
#pragma unroll
        for (int rr = 0; rr < 4; ++rr) an[rr] = stS[((slot + 1) * 64 + rg * 16 + 4 * lq + rr) * 64 + 16 * w + lc];
      }
#pragma unroll
      for (int s = 0; s < 16; ++s) {
        const float a = cur[lc * 68 + 4 * s + lq];
        acc = __builtin_amdgcn_mfma_f32_16x16x4f32(a, pj[s], acc, 0, 0, 0);
      }
      __syncthreads();
#pragma unroll
      for (int rr = 0; rr < 4; ++rr) {
        cur[(4 * lq + rr) * 68 + 16 * w + lc] = acc[rr];
        stS[(slot * 64 + rg * 16 + 4 * lq + rr) * 64 + 16 * w + lc] = acc[rr];
      }
      __syncthreads();
    }
  }
}

DI void phase_readout(const Params& p) {
  const int TIDX = ltid();
  const int lane = TIDX & 63, wv = __builtin_amdgcn_readfirstlane(TIDX >> 6);
  const u16* proj = (const u16*)(p.ws + OFF_PROJ);
  const float* bonus = (const float*)(p.ws + OFF_BONUS);
  u16* hb = (u16*)(p.ws + OFF_HB);
  for (int row = blockIdx.x * 4 + wv; row < T_ALL; row += gridDim.x * 4) {
    const float* o = (row < T_LAT) ? (p.out + (size_t)row * 1024) : ((const float*)(p.ws + OFF_OCTX) + (size_t)(row - T_LAT) * 1024);
    bool hp, hn;
    if (row < T_LAT) { const int t = row & 8191; hp = t > 0; hn = t < 8191; } else { const int t = (row - T_LAT) & 255; hp = t > 0; hn = t < 255; }
    const int c0 = lane * 16, hh = lane >> 2;
    float ov[16];
    float s = 0.f;
#pragma unroll
    for (int q = 0; q < 4; ++q) { const f32x4 t = *(const f32x4*)(o + c0 + q * 4); ov[q * 4] = t[0]; ov[q * 4 + 1] = t[1]; ov[q * 4 + 2] = t[2]; ov[q * 4 + 3] = t[3]; s += t[0] + t[1] + t[2] + t[3]; }
    s += __shfl_xor(s, 1); s += __shfl_xor(s, 2);
    const float mean = s * (1.0f / 64.0f);
    float vs = 0.f;
#pragma unroll
    for (int j = 0; j < 16; ++j) { const float dlt = ov[j] - mean; vs += dlt * dlt; }
    vs += __shfl_xor(vs, 1); vs += __shfl_xor(vs, 2);
    const float rstd = rsqrtf(vs * (1.0f / 64.0f) + 64e-5f);
    const float bon = bonus[(size_t)row * 16 + hh] + bonus[(size_t)(T_ALL * 16) + (size_t)row * 16 + hh];
    float vm[16];
    const u16* pr = proj + (size_t)row * N0;
    load_mix8(pr + 2048 + c0, hp, hn, p.rw_mu + 2048 + c0, vm);
    load_mix8(pr + 2048 + c0 + 8, hp, hn, p.rw_mu + 2048 + c0 + 8, vm + 8);
    float gv[16];
    unpack8(*(const u32x4*)(pr + 3072 + c0), gv);
    unpack8(*(const u32x4*)(pr + 3072 + c0 + 8), gv + 8);
    unsigned pk[8];
#pragma unroll
    for (int j = 0; j < 8; ++j) {
      const int ca = c0 + 2 * j, cb = ca + 1;
      const float ya = ((ov[2 * j] - mean) * rstd * p.rw_gn_g[ca] + p.rw_gn_b[ca] + bon * vm[2 * j]) * siluf_(gv[2 * j]);
      const float yb = ((ov[2 * j + 1] - mean) * rstd * p.rw_gn_g[cb] + p.rw_gn_b[cb] + bon * vm[2 * j + 1]) * siluf_(gv[2 * j + 1]);
      pk[j] = pack2(ya, yb);
    }
    u32x4* dd = (u32x4*)(hb + (size_t)row * 1024 + c0);
    dd[0] = u32x4{pk[0], pk[1], pk[2], pk[3]};
    dd[1] = u32x4{pk[4], pk[5], pk[6], pk[7]};
  }
}

DI void phase_qkprep(const Params& p) {
  const int TIDX = ltid();
  const int lane = TIDX & 63, wv = __builtin_amdgcn_readfirstlane(TIDX >> 6);
  const u16* raw = (const u16*)(p.ws + OFF_RAW);
  u16* Qs = (u16*)(p.ws + OFF_QS);
  u16* Ks = (u16*)(p.ws + OFF_KS);
  const float* rope = (const float*)(p.ws + OFF_ROPE);
  const int grp = lane >> 1, axis = lane & 1;
  const bool isq = grp < 16;
  const int hd = (grp & 15) >> 1, comp = grp & 1;
  const float* gain = (isq ? p.da_qn : p.da_kn) + axis * 32;
  for (int row = blockIdx.x * 4 + wv; row < T_ALL; row += gridDim.x * 4) {
    const bool lat = row < T_LAT;
    int b, t;
    if (lat) { b = row >> 13; t = row & 8191; } else { b = (row - T_LAT) >> 8; t = (row - T_LAT) & 255; }
    const u16* src = raw + (size_t)row * 2048 + lane * 32;
    float v[32];
#pragma unroll
    for (int q = 0; q < 4; ++q) unpack8(*(const u32x4*)(src + q * 8), v + q * 8);
    float ss = 0.f;
#pragma unroll
    for (int j = 0; j < 32; ++j) ss += v[j] * v[j];
    ss += __shfl_xor(ss, 1);
    const float rstd = rsqrtf(ss * (1.0f / 64.0f) + 1e-6f);
#pragma unroll
    for (int j = 0; j < 32; ++j) v[j] = v[j] * rstd * gain[j];
    if (lat) {
      const int pos = axis == 0 ? (t >> 6) : (t & 63);
#pragma unroll
      for (int f = 0; f < 16; ++f) {
        const float c = rope[pos * 16 + f], s = rope[2048 + pos * 16 + f];
        const float x1 = v[f], x2 = v[16 + f];
        v[f] = x1 * c - x2 * s; v[16 + f] = x2 * c + x1 * s;
      }
    }
    u16* dst;
    float sc = 1.0f;
    if (isq) {
      if (!lat) continue;
      sc = 0.125f * 1.4426950408889634f;
      dst = Qs + (((size_t)(b * 8 + hd) * 2 + comp) * 8192 + t) * 64 + axis * 32;
    } else {
      const int pp = lat ? 256 + t : t;
      dst = Ks + (((size_t)(b * 8 + hd) * 2 + comp) * LKV + pp) * 64 + axis * 32;
    }
#pragma unroll
    for (int q = 0; q < 4; ++q) {
      u32x4 o = {pack2(v[q * 8] * sc, v[q * 8 + 1] * sc), pack2(v[q * 8 + 2] * sc, v[q * 8 + 3] * sc),
                 pack2(v[q * 8 + 4] * sc, v[q * 8 + 5] * sc), pack2(v[q * 8 + 6] * sc, v[q * 8 + 7] * sc)};
      *(u32x4*)(dst + q * 8) = o;
    }
  }
}

typedef __attribute__((address_space(3))) unsigned* lds_uptr;
typedef __attribute__((address_space(1))) const unsigned* glb_uptr;
DI void dma16(const void* g, char* ldsbase) {
  __builtin_amdgcn_global_load_lds((glb_uptr)(g), (lds_uptr)(ldsbase), 16, 0, 0);
}

DI void attn_issue_tile(const u16* Kg, const u16* Vg, int k0, char* buf, int wv, int lane) {
  asm volatile("" : "+v"(lane));
  const int rr = lane >> 3, cp = lane & 7;
#pragma unroll
  for (int i = 0; i < 4; ++i) {
    const int seg = wv * 4 + i;
    const int c = seg >> 3, key = (seg & 7) * 8 + rr;
    const int sw = (key >> 1) & 7;
    dma16(Kg + ((size_t)c * LKV + k0 + key) * 64 + ((cp ^ sw) << 3), buf + seg * 1024);
    const int e = seg * 8 + rr;
    const int swv = (e >> 1) & 7;
    dma16(Vg + (size_t)e * LKV + k0 + ((cp ^ swv) << 3), buf + 16384 + seg * 1024);
  }
}

DI void phase_attn(const Params& p, char* smem) {
  const int TIDX = ltid();
  const int tid = TIDX, lane = tid & 63, wv = __builtin_amdgcn_readfirstlane(tid >> 6);
  const int r = lane & 31, h = lane >> 5;
  const u16* Qs = (const u16*)(p.ws + OFF_QS);
  const u16* Ks = (const u16*)(p.ws + OFF_KS);
  const u16* Vt = (const u16*)(p.ws + OFF_VT);
  const u16* GB = (const u16*)(p.ws + OFF_GB);
  u16* Y2 = (u16*)(p.ws + OFF_Y2);
  float lam;
  {
    float a = p.da_lam[lane] * p.da_lam[64 + lane];
    float bq = p.da_lam[128 + lane] * p.da_lam[192 + lane];
#pragma unroll
    for (int o = 32; o >= 1; o >>= 1) { a += __shfl_xor(a, o); bq += __shfl_xor(bq, o); }
    lam = __expf(a) - __expf(bq) + 0.35550906759096927f;
  }
  const float one_m_li = 1.0f - 0.35550906759096927f;
  const int sw = (r >> 1) & 7;
  int repa = REP_ATTN; asm volatile("" : "+s"(repa));
  for (int rp = 0; rp < repa; ++rp)
  for (int item = blockIdx.x; item < 1024; item += gridDim.x) {
    const int bh = (item & 7) * 2 + (item >> 9), qt = (item >> 3) & 63;
    const int q0 = qt * 128 + wv * 32;
    const u16* Kg = Ks + (size_t)bh * 2 * LKV * 64;
    const u16* Vg = Vt + (size_t)bh * 128 * LKV;
    __syncthreads();
    attn_issue_tile(Kg, Vg, 0, smem, wv, lane);
    bf16x8 qf[2][4];
#pragma unroll
    for (int c = 0; c < 2; ++c)
#pragma unroll
      for (int s = 0; s < 4; ++s)
        qf[c][s] = *(const bf16x8*)(Qs + (((size_t)bh * 2 + c) * 8192 + q0 + r) * 64 + s * 16 + 8 * h);
    f32x16 O[2][4];
#pragma unroll
    for (int c = 0; c < 2; ++c)
#pragma unroll
      for (int e = 0; e < 4; ++e)
#pragma unroll
        for (int i = 0; i < 16; ++i) O[c][e][i] = 0.f;
    f2 lsum[2] = {f2{0.f, 0.f}, f2{0.f, 0.f}};
#pragma unroll 1
    for (int kt = 0; kt < LKV / 64; ++kt) {
      char* buf = smem + (kt & 1) * 32768;
      asm volatile("s_waitcnt vmcnt(0)" ::: "memory");
      __syncthreads();
      if (kt + 1 < LKV / 64) attn_issue_tile(Kg, Vg, (kt + 1) * 64, smem + ((kt + 1) & 1) * 32768, wv, lane);
      const char* Kb = buf + r * 128;
      const char* Vb = buf + 16384 + r * 128;
#pragma unroll
      for (int sub = 0; sub < 2; ++sub) {
        f32x16 sacc[2];
#pragma unroll
        for (int c = 0; c < 2; ++c) {
#pragma unroll
          for (int i = 0; i < 16; ++i) sacc[c][i] = 0.f;
#pragma unroll
          for (int s = 0; s < 4; ++s) {
            const bf16x8 kf = *(const bf16x8*)(Kb + c * 8192 + sub * 4096 + (((2 * s + h) ^ sw) << 4));
            sacc[c] = MFMA32(kf, qf[c][s], sacc[c]);
          }
        }
#pragma unroll
        for (int c = 0; c < 2; ++c) {
          bf16x8 pf[2];
#pragma unroll
          for (int s = 0; s < 2; ++s) {
            float ps[8];
#pragma unroll
            for (int i = 0; i < 8; ++i) ps[i] = __builtin_amdgcn_exp2f(sacc[c][8 * s + i]);
            lsum[c] += f2{ps[0], ps[1]}; lsum[c] += f2{ps[2], ps[3]}; lsum[c] += f2{ps[4], ps[5]}; lsum[c] += f2{ps[6], ps[7]};
            u32x4 pk = {cvtpk(ps[0], ps[1]), cvtpk(ps[2], ps[3]), cvtpk(ps[4], ps[5]), cvtpk(ps[6], ps[7])};
            pf[s] = __builtin_bit_cast(bf16x8, pk);
          }
#pragma unroll
          for (int e = 0; e < 4; ++e)
#pragma unroll
            for (int s = 0; s < 2; ++s) {
              const bf16x8 vf = *(const bf16x8*)(Vb + e * 4096 + (((sub * 4 + 2 * s + h) ^ sw) << 4));
              O[c][e] = MFMA32(vf, pf[s], O[c][e]);
            }
        }
      }
    }
    float l0 = lsum[0][0] + lsum[0][1], l1 = lsum[1][0] + lsum[1][1];
    l0 += __shfl_xor(l0, 32); l1 += __shfl_xor(l1, 32);
    const float i0 = 1.0f / l0, i1 = lam / l1;
    float ss = 0.f;
#pragma unroll
    for (int e = 0; e < 4; ++e)
#pragma unroll
      for (int i = 0; i < 16; ++i) { const float o = O[0][e][i] * i0 - O[1][e][i] * i1; O[0][e][i] = o; ss += o * o; }
    ss += __shfl_xor(ss, 32);
    const float rstd = rsqrtf(ss * (1.0f / 128.0f) + 1e-5f) * one_m_li;
    const int b = bh >> 3, hd = bh & 7;
    int rl = r; asm volatile("" : "+v"(rl));
    const size_t row = (size_t)b * 8192 + q0 + rl;
#pragma unroll
    for (int e = 0; e < 4; ++e) {
#pragma unroll
      for (int g = 0; g < 4; ++g) {
        const int ee = e * 32 + 8 * g + 4 * h;
        const u32x2 gg = *(const u32x2*)(GB + row * 1024 + hd * 128 + ee);
        const float g0 = bflo(gg[0]), g1 = bfhi(gg[0]), g2 = bflo(gg[1]), g3 = bfhi(gg[1]);
        const f32x4 sl = *(const f32x4*)(p.da_subln + ee);
        const float y0 = O[0][e][4 * g] * rstd * sl[0] * g0;
        const float y1 = O[0][e][4 * g + 1] * rstd * sl[1] * g1;
        const float y2 = O[0][e][4 * g + 2] * rstd * sl[2] * g2;
        const float y3 = O[0][e][4 * g + 3] * rstd * sl[3] * g3;
        *(u32x2*)(Y2 + row * 1024 + hd * 128 + ee) = u32x2{cvtpk(y0, y1), cvtpk(y2, y3)};
      }
      asm volatile("" ::: "memory");
    }
  }
}

#define XB_TMO      128
#define XB_XCNT(j)  (256  + 64 * (j))
#define XB_XSUB(j)  (1280 + 64 * (j))
#define XB_XGEN(j)  (2304 + 64 * (j))
#define XB_TOP      3328
#define XB_TOPGEN   3392
#define XCD_BAR_WORDS 3456
#define XB_SPIN_CAP (1u << 18)
#define LAS __attribute__((address_space(3)))

__device__ __forceinline__ unsigned xb_ld(unsigned* p)              { return __hip_atomic_load(p, __ATOMIC_RELAXED, __HIP_MEMORY_SCOPE_AGENT); }
__device__ __forceinline__ unsigned xb_add(unsigned* p, unsigned v) { return __hip_atomic_fetch_add(p, v, __ATOMIC_RELAXED, __HIP_MEMORY_SCOPE_AGENT); }
__device__ __forceinline__ unsigned xb_xcc_id() { return (unsigned)__builtin_amdgcn_s_getreg((3 << 11) | 20) & 0xFu; }
#define XB_SPIN(cond, bar) do { unsigned _sp = 0; while (cond) { __builtin_amdgcn_s_sleep(1); \
    if ((++_sp & 255u) == 0u) { if (xb_ld(&(bar)[XB_TMO])) break; if (_sp > XB_SPIN_CAP) { atomicAdd(&(bar)[XB_TMO], 1u); break; } } } } while (0)

struct XcdBarrier {
    unsigned* bar; unsigned x;
    volatile LAS unsigned* st;
};

__device__ __forceinline__ XcdBarrier xcd_barrier_post(unsigned* bar, volatile LAS unsigned* st) {
    XcdBarrier b; b.bar = bar; b.x = xb_xcc_id(); b.st = st;
    if (threadIdx.x == 0) (void)xb_add(&bar[XB_XCNT(b.x)], 1u);
    return b;
}
__device__ __forceinline__ void xcd_barrier_complete(unsigned* bar, unsigned x, unsigned& nloc, unsigned& nx) {
    const unsigned G = gridDim.x * gridDim.y * gridDim.z;
    unsigned sum, cnt, mine, sp = 0u;
    for (;;) {
        sum = 0u; cnt = 0u; mine = 0u;
#pragma unroll
        for (unsigned j = 0; j < 16; ++j) { const unsigned c = xb_ld(&bar[XB_XCNT(j)]); sum += c; cnt += (c > 0u) ? 1u : 0u; mine = (j == x) ? c : mine; }
        if (sum == G) break;
        __builtin_amdgcn_s_sleep(1);
        if ((++sp & 255u) == 0u) { if (xb_ld(&bar[XB_TMO])) break; if (sp > XB_SPIN_CAP) { atomicAdd(&bar[XB_TMO], 1u); break; } }
    }
    nloc = mine > 0u ? mine : 1u; nx = cnt > 0u ? cnt : 1u;
}

__device__ __forceinline__ void xcd_barrier(const XcdBarrier& b) {
    asm volatile("s_waitcnt vmcnt(0)" ::: "memory");
    __syncthreads();
    if (threadIdx.x == 0) {
        unsigned* bar = b.bar;
        __builtin_amdgcn_s_waitcnt(0);
        unsigned nloc = b.st[0], nx = b.st[1];
        if (nloc == 0u) { xcd_barrier_complete(bar, b.x, nloc, nx); b.st[0] = nloc; b.st[1] = nx; }
        const unsigned old = xb_add(&bar[XB_XSUB(b.x)], 1u);
        const unsigned gen = old / nloc;
        if (old + 1u == (gen + 1u) * nloc) {
            __builtin_amdgcn_fence(__ATOMIC_RELEASE, "agent");
            asm volatile("s_waitcnt vmcnt(0)" ::: "memory");
            const unsigned og = xb_add(&bar[XB_TOP], 1u);
            const unsigned tg = og / nx;
            if (og + 1u == (tg + 1u) * nx) xb_add(&bar[XB_TOPGEN], 1u);
            else XB_SPIN(xb_ld(&bar[XB_TOPGEN]) == tg, bar);
            __builtin_amdgcn_fence(__ATOMIC_ACQUIRE, "agent");
            xb_add(&bar[XB_XGEN(b.x)], 1u);
            asm volatile("s_waitcnt vmcnt(0)" ::: "memory");
        } else {
            XB_SPIN(xb_ld(&bar[XB_XGEN(b.x)]) == gen, bar);
            __builtin_amdgcn_fence(__ATOMIC_ACQUIRE, "agent");
            asm volatile("s_waitcnt vmcnt(0)" ::: "memory");
        }
    }
    __syncthreads();
}


__global__ void __launch_bounds__(256, 2) fwd_megakernel(Params p) {
  extern __shared__ __attribute__((aligned(16))) char smem[];
  __shared__ uint4 xb_words;
  cg::grid_group grid = cg::this_grid();
  if (threadIdx.x == 0) xb_words = make_uint4(0u, 0u, 0u, 0u);
  __syncthreads();
  XcdBarrier xb = xcd_barrier_post((unsigned*)(p.ws + OFF_BAR), (volatile LAS unsigned*)&xb_words);
  phase_prep(p, smem);
  if (p.ws == nullptr) grid.sync();
  xcd_barrier(xb);
  phase_normmod(p, 0, p.x, p.ctx, true);
  xcd_barrier(xb);
  phase_gemm_wide<0>(p, smem, (const u16*)(p.ws + OFF_HB), (const u16*)(p.ws + OFF_WT_IN0), 120, N0 / 256);
  phase_gemm<0>(p, smem, (const u16*)(p.ws + OFF_HB), (const u16*)(p.ws + OFF_WT_IN0), T_ALL / 128 - 120, N0 / 128, 120);
  xcd_barrier(xb);
  phase_scan<1>(p, smem);
  xcd_barrier(xb);
  phase_carry(p, smem);
  xcd_barrier(xb);
  phase_scan<2>(p, smem);
  xcd_barrier(xb);
  phase_readout(p);
  xcd_barrier(xb);
  phase_gemm<1>(p, smem, (const u16*)(p.ws + OFF_HB), (const u16*)(p.ws + OFF_WT_OUT0), T_ALL / 128, 8);
  xcd_barrier(xb);
  phase_normmod(p, 1, p.out, (const float*)(p.ws + OFF_XC1), false);
  xcd_barrier(xb);
  phase_gemm_wide<2>(p, smem, (const u16*)(p.ws + OFF_HB), (const u16*)(p.ws + OFF_WT_IN1), 128, N1 / 256);
  phase_gemm<2>(p, smem, (const u16*)(p.ws + OFF_HB), (const u16*)(p.ws + OFF_WT_IN1), T_ALL / 128 - 128, N1 / 128, 128);
  xcd_barrier(xb);
  phase_qkprep(p);
  xcd_barrier(xb);
  phase_attn(p, smem);
  xcd_barrier(xb);
  phase_gemm<3>(p, smem, (const u16*)(p.ws + OFF_Y2), (const u16*)(p.ws + OFF_WT_OUT1), T_LAT / 128, 8);
}

extern "C" void kernel_launch(void* const* d_in, const int* in_sizes, int n_in, void* d_out, int out_size, void* d_ws,
                              size_t ws_size, hipStream_t stream) {
  static int grid_blocks = 0;
  if (!grid_blocks) {
    int dev = 0, cus = 0, per_cu = 0;
    hipGetDevice(&dev);
    hipDeviceGetAttribute(&cus, hipDeviceAttributeMultiprocessorCount, dev);
    hipFuncSetAttribute((const void*)fwd_megakernel, hipFuncAttributeMaxDynamicSharedMemorySize, LDS_BYTES);
    hipOccupancyMaxActiveBlocksPerMultiprocessor(&per_cu, fwd_megakernel, 256, LDS_BYTES);
    if (per_cu < 1) per_cu = 1;
    if (per_cu > 2) per_cu = 2;
    grid_blocks = cus * per_cu;
    if (ws_size < 256 * MiB) fprintf(stderr, "kernel_launch: workspace too small: %zu\n", ws_size);
  }
  Params p{};
  const float** pp = (const float**)&p;
  for (int i = 0; i < 25; ++i) pp[i] = (const float*)d_in[i];
  p.out = (float*)d_out;
  p.ws = (char*)d_ws;
  hipMemsetAsync((char*)d_ws + OFF_BAR, 0, XCD_BAR_WORDS * sizeof(unsigned), stream);
  void* args[] = {&p};
  hipError_t e = hipLaunchCooperativeKernel((void*)fwd_megakernel, dim3(grid_blocks), dim3(256), args, LDS_BYTES, stream);
  if (e != hipSuccess) fprintf(stderr, "cooperative launch failed: %s (grid %d)\n", hipGetErrorString(e), grid_blocks);
}
```

```cpp
#include <hip/hip_runtime.h>
#include <hip/hip_cooperative_groups.h>
#include <cstdio>
namespace cg = cooperative_groups;

#define DI __device__ __forceinline__
typedef unsigned short u16;
using bf16x8 = __attribute__((ext_vector_type(8))) short;
using s16x4  = __attribute__((ext_vector_type(4))) short;
using f32x16 = __attribute__((ext_vector_type(16))) float;
using f32x4  = __attribute__((ext_vector_type(4))) float;
using f32x32 = __attribute__((ext_vector_type(32))) float;
using f2     = __attribute__((ext_vector_type(2))) float;
using u32x4  = __attribute__((ext_vector_type(4))) unsigned;
using u32x2  = __attribute__((ext_vector_type(2))) unsigned;

constexpr int T_LAT = 16384, T_CTX = 512, T_ALL = 16896, DM = 1024;
constexpr int N0 = 4352, N1 = 4096;
constexpr int LKV = 8448;
constexpr int NCHUNK = 32, LCH = 264, NSUB = 33;

constexpr size_t MiB = 1048576;
constexpr size_t OFF_WT_IN0 = 0;
constexpr size_t OFF_WT_OUT0 = 8912896;
constexpr size_t OFF_WT_IN1 = 11010048;
constexpr size_t OFF_WT_OUT1 = 19398656;
constexpr size_t OFF_W2T = 21495808;
constexpr size_t OFF_A2T = 21757952;
constexpr size_t OFF_MOD = 21 * MiB;
constexpr size_t OFF_ROPE = OFF_MOD + 73728;
constexpr size_t OFF_BONUS = 21 * MiB + 131072;
constexpr size_t OFF_XC1 = 24 * MiB;
constexpr size_t OFF_OCTX = 26 * MiB;
constexpr size_t OFF_BAR = 29 * MiB;
constexpr size_t OFF_PROJ = 30 * MiB;
constexpr size_t OFF_HB = 171 * MiB;
constexpr size_t OFF_STP = 171 * MiB;
constexpr size_t OFF_STS = 203 * MiB;
constexpr size_t OFF_RAW = 30 * MiB;
constexpr size_t OFF_VT = 96 * MiB;
constexpr size_t OFF_KS = 129 * MiB;
constexpr size_t OFF_GB = 204 * MiB;
constexpr size_t OFF_QS = OFF_HB;
constexpr size_t OFF_Y2 = OFF_RAW;

constexpr int LDS_BYTES = 78336;

struct Params {
  const float *x, *c, *ctx, *c_ctx, *ada_w, *ada_b, *norm_g, *rw_in, *rw_mu, *rw_w0, *rw_w2, *rw_a0, *rw_a2,
      *rw_kk, *rw_ka, *rw_rk, *rw_gn_g, *rw_gn_b, *rw_out, *da_in, *da_qn, *da_kn, *da_lam, *da_subln, *da_out;
  float* out;
  char* ws;
};

DI u16 f2bf(float x) { unsigned u = __float_as_uint(x); u += 0x7fffu + ((u >> 16) & 1u); return (u16)(u >> 16); }
DI float bf2f(u16 h) { return __uint_as_float(((unsigned)h) << 16); }
DI unsigned pack2(float a, float b) { return (unsigned)f2bf(a) | ((unsigned)f2bf(b) << 16); }
typedef __bf16 bf16v2 __attribute__((ext_vector_type(2)));
DI unsigned cvtpk(float a, float b) { f2 v = {a, b}; return __builtin_bit_cast(unsigned, __builtin_convertvector(v, bf16v2)); }
DI float fsig(float x) { return __builtin_amdgcn_rcpf(1.0f + __expf(-x)); }
DI int ltid() { int t = threadIdx.x; asm volatile("" : "+v"(t)); return t; }
DI float bflo(unsigned u) { return __uint_as_float(u << 16); }
DI float bfhi(unsigned u) { return __uint_as_float(u & 0xffff0000u); }
DI float sigmoidf_(float x) { return 1.0f / (1.0f + __expf(-x)); }
DI float siluf_(float x) { return x * sigmoidf_(x); }
DI int crow(int i, int h) { return (i & 3) + 8 * (i >> 2) + 4 * h; }
DI void unpack8(const u32x4& u, float* f) {
  f[0] = bflo(u[0]); f[1] = bfhi(u[0]); f[2] = bflo(u[1]); f[3] = bfhi(u[1]);
  f[4] = bflo(u[2]); f[5] = bfhi(u[2]); f[6] = bflo(u[3]); f[7] = bfhi(u[3]);
}
#define WAVE_LDS_SYNC() asm volatile("s_waitcnt lgkmcnt(0)" ::: "memory")
#define MFMA32(a, b, c) __builtin_amdgcn_mfma_f32_32x32x16_bf16((a), (b), (c), 0, 0, 0)
#define MFMA16(a, b, c) __builtin_amdgcn_mfma_f32_16x16x32_bf16((a), (b), (c), 0, 0, 0)

__device__ const float INV_FREQ[16] = {
    1.0f, 0.5623413251903491f, 0.31622776601683794f, 0.1778279410038923f, 0.1f, 0.05623413251903491f,
    0.03162277660168379f, 0.01778279410038923f, 0.01f, 0.005623413251903491f, 0.0031622776601683794f,
    0.001778279410038923f, 0.001f, 0.0005623413251903491f, 0.00031622776601683794f, 0.0001778279410038923f};

DI void transpose_tile(const float* __restrict__ src, u16* __restrict__ dst, int K, int N, int kt, int nt, float* tile) {
  const int TIDX = ltid();
  const int tid = TIDX;
  {
    const int n = tid & 63, k0 = tid >> 6;
#pragma unroll
    for (int i = 0; i < 16; ++i) {
      const int k = k0 + 4 * i;
      tile[k * 65 + n] = src[(size_t)(kt * 64 + k) * N + nt * 64 + n];
    }
  }
  __syncthreads();
  {
    const int n = tid >> 2, kq = tid & 3;
    unsigned pk[8];
#pragma unroll
    for (int j = 0; j < 8; ++j) pk[j] = pack2(tile[(kq * 16 + 2 * j) * 65 + n], tile[(kq * 16 + 2 * j + 1) * 65 + n]);
    u32x4* d = (u32x4*)(dst + (size_t)(nt * 64 + n) * K + kt * 64 + kq * 16);
    d[0] = u32x4{pk[0], pk[1], pk[2], pk[3]};
    d[1] = u32x4{pk[4], pk[5], pk[6], pk[7]};
  }
  __syncthreads();
}

DI void phase_prep(const Params& p, char* smem) {
  const int TIDX = ltid();
  float* tile = (float*)smem;
  const int tid = TIDX;
  constexpr int T_IN0 = 16 * 68, T_OUT = 256, T_IN1 = 16 * 64, T_LORA = 16;
  constexpr int E0 = T_IN0, E1 = E0 + T_OUT, E2 = E1 + T_IN1, E3 = E2 + T_OUT, E4 = E3 + 2 * T_LORA, E5 = E4 + 2 * T_LORA;
  constexpr int NMOD = 192;
  constexpr int TOTAL = E5 + NMOD + 1;
  for (int it = blockIdx.x; it < TOTAL; it += gridDim.x) {
    if (it < E0) { transpose_tile(p.rw_in, (u16*)(p.ws + OFF_WT_IN0), 1024, N0, it / 68, it % 68, tile); }
    else if (it < E1) { int j = it - E0; transpose_tile(p.rw_out, (u16*)(p.ws + OFF_WT_OUT0), 1024, 1024, j >> 4, j & 15, tile); }
    else if (it < E2) { int j = it - E1; transpose_tile(p.da_in, (u16*)(p.ws + OFF_WT_IN1), 1024, N1, j >> 6, j & 63, tile); }
    else if (it < E3) { int j = it - E2; transpose_tile(p.da_out, (u16*)(p.ws + OFF_WT_OUT1), 1024, 1024, j >> 4, j & 15, tile); }
    else if (it < E4) { int j = it - E3; int d = j >> 4; transpose_tile(p.rw_w2 + (size_t)d * 65536, (u16*)(p.ws + OFF_W2T) + (size_t)d * 65536, 64, 1024, 0, j & 15, tile); }
    else if (it < E5) { int j = it - E4; int d = j >> 4; transpose_tile(p.rw_a2 + (size_t)d * 65536, (u16*)(p.ws + OFF_A2T) + (size_t)d * 65536, 64, 1024, 0, j & 15, tile); }
    else if (it < E5 + NMOD) {
      const int j = it - E5; const int layer = j / 96; const int nb = (j % 96) * 32;
      const int n = nb + (tid & 31), kg = tid >> 5;
      const float* W = p.ada_w + (size_t)layer * 1024 * 3072;
      float a0 = 0.f, a1 = 0.f, a2 = 0.f;
#pragma unroll 8
      for (int k = kg * 128; k < kg * 128 + 128; ++k) {
        const float w = W[(size_t)k * 3072 + n];
        a0 += siluf_(p.c[k]) * w; a1 += siluf_(p.c[1024 + k]) * w; a2 += siluf_(p.c_ctx[k]) * w;
      }
      tile[(kg * 3 + 0) * 32 + (tid & 31)] = a0; tile[(kg * 3 + 1) * 32 + (tid & 31)] = a1; tile[(kg * 3 + 2) * 32 + (tid & 31)] = a2;
      __syncthreads();
      if (tid < 96) {
        const int s = tid >> 5, nn = tid & 31;
        float acc = p.ada_b[layer * 3072 + nb + nn];
#pragma unroll
        for (int g = 0; g < 8; ++g) acc += tile[(g * 3 + s) * 32 + nn];
        ((float*)(p.ws + OFF_MOD))[(layer * 3 + s) * 3072 + nb + nn] = acc;
      }
      __syncthreads();
    } else {
      float* rope = (float*)(p.ws + OFF_ROPE);
      for (int e = tid; e < 2048; e += 256) {
        const int pos = e >> 4, f = e & 15;
        const float ang = (float)pos * INV_FREQ[f];
        const float rev = ang * 0.15915494309189535f;
        const float fr = rev - rintf(rev);
        const float a = fr * 6.283185307179586f;
        rope[e] = __cosf(a); rope[2048 + e] = __sinf(a);
      }
    }
  }
}

DI void phase_normmod(const Params& p, int layer, const float* __restrict__ xl, const float* __restrict__ xc, bool zero_o) {
  const int TIDX = ltid();
  const int lane = TIDX & 63, wv = __builtin_amdgcn_readfirstlane(TIDX >> 6);
  const float* mod = (const float*)(p.ws + OFF_MOD) + layer * 3 * 3072;
  const float* g = p.norm_g + layer * 1024;
  u16* hb = (u16*)(p.ws + OFF_HB);
  for (int row = blockIdx.x * 4 + wv; row < T_ALL; row += gridDim.x * 4) {
    const float* src; const float* m;
    if (row < T_LAT) { src = xl + (size_t)row * 1024; m = mod + (row >> 13) * 3072; }
    else { src = xc + (size_t)(row - T_LAT) * 1024; m = mod + 2 * 3072; }
    float v[16];
    float ss = 0.f;
#pragma unroll
    for (int q = 0; q < 4; ++q) {
      const f32x4 t = *(const f32x4*)(src + lane * 16 + q * 4);
      v[q * 4] = t[0]; v[q * 4 + 1] = t[1]; v[q * 4 + 2] = t[2]; v[q * 4 + 3] = t[3];
      ss += t[0] * t[0] + t[1] * t[1] + t[2] * t[2] + t[3] * t[3];
    }
#pragma unroll
    for (int o = 32; o >= 1; o >>= 1) ss += __shfl_xor(ss, o);
    const float rstd = rsqrtf(ss * (1.0f / 1024.0f) + 1e-6f);
    unsigned pk[8];
#pragma unroll
    for (int j = 0; j < 8; ++j) {
      const int c0 = lane * 16 + 2 * j;
      const float h0 = v[2 * j] * rstd * g[c0] * (1.0f + m[1024 + c0]) + m[c0];
      const float h1 = v[2 * j + 1] * rstd * g[c0 + 1] * (1.0f + m[1024 + c0 + 1]) + m[c0 + 1];
      pk[j] = pack2(h0, h1);
    }
    u32x4* d = (u32x4*)(hb + (size_t)row * 1024 + lane * 16);
    d[0] = u32x4{pk[0], pk[1], pk[2], pk[3]};
    d[1] = u32x4{pk[4], pk[5], pk[6], pk[7]};
    if (zero_o) {
      float* o = (row < T_LAT) ? (p.out + (size_t)row * 1024) : ((float*)(p.ws + OFF_OCTX) + (size_t)(row - T_LAT) * 1024);
      const f32x4 z = {0.f, 0.f, 0.f, 0.f};
#pragma unroll
      for (int q = 0; q < 4; ++q) *(f32x4*)(o + lane * 16 + q * 4) = z;
    }
  }
}

constexpr int LDT = 72;
#ifndef REP_GEMM
#define REP_GEMM 1
#endif
#ifndef REP_SCAN
#define REP_SCAN 1
#endif
#ifndef REP_ATTN
#define REP_ATTN 1
#endif
template <int EPI>
DI void phase_gemm(const Params& p, char* smem, const u16* __restrict__ A, const u16* __restrict__ Bt, int Mtiles, int Ntiles, int Mbase = 0) {
  const int TIDX = ltid();
  u16* As0 = (u16*)smem;
  const int tid = TIDX, lane = tid & 63, wv = __builtin_amdgcn_readfirstlane(tid >> 6);
  const int r = lane & 31, h = lane >> 5;
  const int wm = wv >> 1, wn = wv & 1;
  const int ntiles = Mtiles * Ntiles;
  const int npad = (ntiles + 511) & ~511;
  int repg = (EPI == 0 || EPI == 2) ? REP_GEMM : 1; asm volatile("" : "+s"(repg));
  for (int rp = 0; rp < repg; ++rp)
  for (int tt = blockIdx.x; tt < npad; tt += gridDim.x) {
    const int tile = (tt & ~511) + ((tt & 7) << 6) + ((tt >> 3) & 63);
    if (tile >= ntiles) continue;
    const int band = tile / (4 * Ntiles), rem = tile % (4 * Ntiles);
    const int mt_ = band * 4 + (rem & 3), nt_ = rem >> 2;
    const int m0 = (Mbase + mt_) * 128, n0 = nt_ * 128;
    f32x16 acc[2][2];
#pragma unroll
    for (int a = 0; a < 2; ++a)
#pragma unroll
      for (int b = 0; b < 2; ++b)
#pragma unroll
        for (int i = 0; i < 16; ++i) acc[a][b][i] = 0.f;
    u32x4 ra[4], rb[4];
    const u16* Ag = A + (size_t)m0 * 1024;
    const u16* Bg = Bt + (size_t)n0 * 1024;
#pragma unroll
    for (int i = 0; i < 4; ++i) {
      const int id = tid + 256 * i; const int row = id >> 3, cc = id & 7;
      ra[i] = *(const u32x4*)(Ag + (size_t)row * 1024 + cc * 8);
      rb[i] = *(const u32x4*)(Bg + (size_t)row * 1024 + cc * 8);
    }
    __syncthreads();
    for (int kt = 0; kt < 16; ++kt) {
      u16* As = As0 + (kt & 1) * (256 * LDT);
      u16* Bs = As + 128 * LDT;
#pragma unroll
      for (int i = 0; i < 4; ++i) {
        const int id = tid + 256 * i; const int row = id >> 3, cc = id & 7;
        *(u32x4*)(As + row * LDT + cc * 8) = ra[i];
        *(u32x4*)(Bs + row * LDT + cc * 8) = rb[i];
      }
      __syncthreads();
      if (kt + 1 < 16) {
#pragma unroll
        for (int i = 0; i < 4; ++i) {
          const int id = tid + 256 * i; const int row = id >> 3, cc = id & 7;
          ra[i] = *(const u32x4*)(Ag + (size_t)row * 1024 + (kt + 1) * 64 + cc * 8);
          rb[i] = *(const u32x4*)(Bg + (size_t)row * 1024 + (kt + 1) * 64 + cc * 8);
        }
      }
#pragma unroll
      for (int ks = 0; ks < 4; ++ks) {
        bf16x8 fa[2], fb[2];
#pragma unroll
        for (int t = 0; t < 2; ++t) {
          fa[t] = *(const bf16x8*)(As + (wm * 64 + t * 32 + r) * LDT + ks * 16 + 8 * h);
          fb[t] = *(const bf16x8*)(Bs + (wn * 64 + t * 32 + r) * LDT + ks * 16 + 8 * h);
        }
#pragma unroll
        for (int a = 0; a < 2; ++a)
#pragma unroll
          for (int b = 0; b < 2; ++b) acc[a][b] = MFMA32(fa[a], fb[b], acc[a][b]);
      }
    }
#pragma unroll
    for (int a = 0; a < 2; ++a)
#pragma unroll
      for (int b = 0; b < 2; ++b) {
        const int col = n0 + wn * 64 + b * 32 + r;
        const int rbase = m0 + wm * 64 + a * 32;
        if (EPI == 0) {
          u16* C = (u16*)(p.ws + OFF_PROJ);
#pragma unroll
          for (int i = 0; i < 16; ++i) C[(size_t)(rbase + crow(i, h)) * N0 + col] = f2bf(acc[a][b][i]);
        } else if (EPI == 1) {
          const float* mod = (const float*)(p.ws + OFF_MOD);
#pragma unroll
          for (int i = 0; i < 16; ++i) {
            const int row = rbase + crow(i, h);
            if (row < T_LAT) {
              const float gate = mod[(row >> 13) * 3072 + 2048 + col];
              p.out[(size_t)row * 1024 + col] = p.x[(size_t)row * 1024 + col] + gate * acc[a][b][i];
            } else {
              const int rc = row - T_LAT;
              const float gate = mod[2 * 3072 + 2048 + col];
              ((float*)(p.ws + OFF_XC1))[(size_t)rc * 1024 + col] = p.ctx[(size_t)rc * 1024 + col] + gate * acc[a][b][i];
            }
          }
        } else if (EPI == 2) {
          if (n0 < 2048) {
            u16* C = (u16*)(p.ws + OFF_RAW);
#pragma unroll
            for (int i = 0; i < 16; ++i) C[(size_t)(rbase + crow(i, h)) * 2048 + col] = f2bf(acc[a][b][i]);
          } else if (n0 < 3072) {
            u16* Vt = (u16*)(p.ws + OFF_VT);
            const int e = col - 2048;
#pragma unroll
            for (int g = 0; g < 4; ++g) {
              const int row = rbase + 8 * g + 4 * h;
              int bb, pp;
              if (row < T_LAT) { bb = row >> 13; pp = 256 + (row & 8191); } else { bb = (row - T_LAT) >> 8; pp = (row - T_LAT) & 255; }
              u32x2 v = {cvtpk(acc[a][b][4 * g], acc[a][b][4 * g + 1]), cvtpk(acc[a][b][4 * g + 2], acc[a][b][4 * g + 3])};
              const int q4 = (pp >> 2) & 3;
              const int pq = (pp & ~15) | ((((q4 & 1) << 1) | (q4 >> 1)) << 2);
              *(u32x2*)(Vt + ((size_t)bb * 1024 + e) * LKV + pq) = v;
            }
          } else {
            u16* G = (u16*)(p.ws + OFF_GB);
#pragma unroll
            for (int i = 0; i < 16; ++i) {
              const int row = rbase + crow(i, h);
              if (row < T_LAT) G[(size_t)row * 1024 + col - 3072] = f2bf(siluf_(acc[a][b][i]));
            }
          }
        } else {
          const float* mod = (const float*)(p.ws + OFF_MOD) + 3 * 3072;
#pragma unroll
          for (int i = 0; i < 16; ++i) {
            const int row = rbase + crow(i, h);
            const float gate = mod[(row >> 13) * 3072 + 2048 + col];
            float* o = p.out + (size_t)row * 1024 + col;
            *o = *o + gate * acc[a][b][i];
          }
        }
      }
  }
}

template <int EPI>
DI void phase_gemm_wide(const Params& p, char* smem, const u16* __restrict__ A, const u16* __restrict__ Bt, int Mtiles, int Ntiles, int Mbase = 0) {
  const int TIDX = ltid();
  u16* As = (u16*)smem;
  u16* Bs = As + 128 * LDT;
  const int tid = TIDX, lane = tid & 63, wv = __builtin_amdgcn_readfirstlane(tid >> 6);
  const int r = lane & 31, h = lane >> 5;
  const int wm = wv >> 1, wn = wv & 1;
  const int ntiles = Mtiles * Ntiles;
  const int npad = (ntiles + 511) & ~511;
  int repg = (EPI == 0 || EPI == 2) ? REP_GEMM : 1; asm volatile("" : "+s"(repg));
  for (int rp = 0; rp < repg; ++rp)
  for (int tt = blockIdx.x; tt < npad; tt += gridDim.x) {
    const int tile = (tt & ~511) + ((tt & 7) << 6) + ((tt >> 3) & 63);
    if (tile >= ntiles) continue;
    const int band = tile / (4 * Ntiles), rem = tile % (4 * Ntiles);
    const int mt_ = band * 4 + (rem & 3), nt_ = rem >> 2;
    const int m0 = (Mbase + mt_) * 128, n0 = nt_ * 256;
    f32x16 acc[2][4];
#pragma unroll
    for (int a = 0; a < 2; ++a)
#pragma unroll
      for (int b = 0; b < 4; ++b)
#pragma unroll
        for (int i = 0; i < 16; ++i) acc[a][b][i] = 0.f;
    u32x4 ra[4], rb[8];
    const u16* Ag = A + (size_t)m0 * 1024;
    const u16* Bg = Bt + (size_t)n0 * 1024;
#pragma unroll
    for (int i = 0; i < 8; ++i) {
      const int id = tid + 256 * i; const int row = id >> 3, cc = id & 7;
      if (i < 4) ra[i] = *(const u32x4*)(Ag + (size_t)row * 1024 + cc * 8);
      rb[i] = *(const u32x4*)(Bg + (size_t)row * 1024 + cc * 8);
    }
    for (int kt = 0; kt < 16; ++kt) {
      __syncthreads();
      int ts = tid; asm volatile("" : "+v"(ts));
#pragma unroll
      for (int i = 0; i < 8; ++i) {
        const int id = ts + 256 * i; const int row = id >> 3, cc = id & 7;
        if (i < 4) *(u32x4*)(As + row * LDT + cc * 8) = ra[i];
        *(u32x4*)(Bs + row * LDT + cc * 8) = rb[i];
      }
      __syncthreads();
      if (kt + 1 < 16) {
        int tl = tid; asm volatile("" : "+v"(tl));
#pragma unroll
        for (int i = 0; i < 8; ++i) {
          const int id = tl + 256 * i; const int row = id >> 3, cc = id & 7;
          if (i < 4) ra[i] = *(const u32x4*)(Ag + (size_t)row * 1024 + (kt + 1) * 64 + cc * 8);
          rb[i] = *(const u32x4*)(Bg + (size_t)row * 1024 + (kt + 1) * 64 + cc * 8);
        }
      }
#pragma unroll
      for (int ks = 0; ks < 4; ++ks) {
        bf16x8 fa[2], fb[4];
#pragma unroll
        for (int t = 0; t < 2; ++t) fa[t] = *(const bf16x8*)(As + (wm * 64 + t * 32 + r) * LDT + ks * 16 + 8 * h);
#pragma unroll
        for (int t = 0; t < 4; ++t) fb[t] = *(const bf16x8*)(Bs + (wn * 128 + t * 32 + r) * LDT + ks * 16 + 8 * h);
#pragma unroll
        for (int a = 0; a < 2; ++a)
#pragma unroll
          for (int b = 0; b < 4; ++b) acc[a][b] = MFMA32(fa[a], fb[b], acc[a][b]);
      }
    }
#pragma unroll
    for (int a = 0; a < 2; ++a)
#pragma unroll
      for (int b = 0; b < 4; ++b) {
        const int col = n0 + wn * 128 + b * 32 + r;
        const int rbase = m0 + wm * 64 + a * 32;
        if (EPI == 0) {
          u16* C = (u16*)(p.ws + OFF_PROJ);
#pragma unroll
          for (int i = 0; i < 16; ++i) C[(size_t)(rbase + crow(i, h)) * N0 + col] = f2bf(acc[a][b][i]);
        } else if (EPI == 1) {
          const float* mod = (const float*)(p.ws + OFF_MOD);
#pragma unroll
          for (int i = 0; i < 16; ++i) {
            const int row = rbase + crow(i, h);
            if (row < T_LAT) {
              const float gate = mod[(row >> 13) * 3072 + 2048 + col];
              p.out[(size_t)row * 1024 + col] = p.x[(size_t)row * 1024 + col] + gate * acc[a][b][i];
            } else {
              const int rc = row - T_LAT;
              const float gate = mod[2 * 3072 + 2048 + col];
              ((float*)(p.ws + OFF_XC1))[(size_t)rc * 1024 + col] = p.ctx[(size_t)rc * 1024 + col] + gate * acc[a][b][i];
            }
          }
        } else if (EPI == 2) {
          if (n0 < 2048) {
            u16* C = (u16*)(p.ws + OFF_RAW);
#pragma unroll
            for (int i = 0; i < 16; ++i) C[(size_t)(rbase + crow(i, h)) * 2048 + col] = f2bf(acc[a][b][i]);
          } else if (n0 < 3072) {
            u16* Vt = (u16*)(p.ws + OFF_VT);
            const int e = col - 2048;
#pragma unroll
            for (int g = 0; g < 4; ++g) {
              const int row = rbase + 8 * g + 4 * h;
              int bb, pp;
              if (row < T_LAT) { bb = row >> 13; pp = 256 + (row & 8191); } else { bb = (row - T_LAT) >> 8; pp = (row - T_LAT) & 255; }
              u32x2 v = {cvtpk(acc[a][b][4 * g], acc[a][b][4 * g + 1]), cvtpk(acc[a][b][4 * g + 2], acc[a][b][4 * g + 3])};
              const int q4 = (pp >> 2) & 3;
              const int pq = (pp & ~15) | ((((q4 & 1) << 1) | (q4 >> 1)) << 2);
              *(u32x2*)(Vt + ((size_t)bb * 1024 + e) * LKV + pq) = v;
            }
          } else {
            u16* G = (u16*)(p.ws + OFF_GB);
#pragma unroll
            for (int i = 0; i < 16; ++i) {
              const int row = rbase + crow(i, h);
              if (row < T_LAT) G[(size_t)row * 1024 + col - 3072] = f2bf(siluf_(acc[a][b][i]));
            }
          }
        } else {
          const float* mod = (const float*)(p.ws + OFF_MOD) + 3 * 3072;
#pragma unroll
          for (int i = 0; i < 16; ++i) {
            const int row = rbase + crow(i, h);
            const float gate = mod[(row >> 13) * 3072 + 2048 + col];
            float* o = p.out + (size_t)row * 1024 + col;
            *o = *o + gate * acc[a][b][i];
          }
        }
      }
  }
}

constexpr int LDW = 80;
template <int EPI>
DI void phase_gemm_wide16(const Params& p, char* smem, const u16* __restrict__ A, const u16* __restrict__ Bt, int Mtiles, int Ntiles, int Mbase = 0) {
  const int TIDX = ltid();
  u16* As = (u16*)smem;
  u16* Bs = As + 128 * LDW;
  const int tid = TIDX, lane = tid & 63, wv = __builtin_amdgcn_readfirstlane(tid >> 6);
  const int lr = lane & 15, lq = lane >> 4;
  const int wm = wv >> 1, wn = wv & 1;
  const int ntiles = Mtiles * Ntiles;
  const int npad = (ntiles + 511) & ~511;
  for (int tt = blockIdx.x; tt < npad; tt += gridDim.x) {
    const int tile = (tt & ~511) + ((tt & 7) << 6) + ((tt >> 3) & 63);
    if (tile >= ntiles) continue;
    const int band = tile / (4 * Ntiles), rem = tile % (4 * Ntiles);
    const int mt_ = band * 4 + (rem & 3), nt_ = rem >> 2;
    const int m0 = (Mbase + mt_) * 128, n0 = nt_ * 256;
    f32x4 acc[4][8];
#pragma unroll
    for (int t = 0; t < 4; ++t)
#pragma unroll
      for (int u = 0; u < 8; ++u) acc[t][u] = f32x4{0.f, 0.f, 0.f, 0.f};
    u32x4 ra[4], rb[8];
    const u16* Ag = A + (size_t)m0 * 1024;
    const u16* Bg = Bt + (size_t)n0 * 1024;
#pragma unroll
    for (int i = 0; i < 8; ++i) {
      const int id = tid + 256 * i; const int row = id >> 3, cc = id & 7;
      if (i < 4) ra[i] = *(const u32x4*)(Ag + (size_t)row * 1024 + cc * 8);
      rb[i] = *(const u32x4*)(Bg + (size_t)row * 1024 + cc * 8);
    }
    for (int kt = 0; kt < 16; ++kt) {
      __syncthreads();
      int ts = tid; asm volatile("" : "+v"(ts));
#pragma unroll
      for (int i = 0; i < 8; ++i) {
        const int id = ts + 256 * i; const int row = id >> 3, cc = id & 7;
        if (i < 4) *(u32x4*)(As + row * LDW + cc * 8) = ra[i];
        *(u32x4*)(Bs + row * LDW + cc * 8) = rb[i];
      }
      __syncthreads();
      if (kt + 1 < 16) {
        int tl = tid; asm volatile("" : "+v"(tl));
#pragma unroll
        for (int i = 0; i < 8; ++i) {
          const int id = tl + 256 * i; const int row = id >> 3, cc = id & 7;
          if (i < 4) ra[i] = *(const u32x4*)(Ag + (size_t)row * 1024 + (kt + 1) * 64 + cc * 8);
          rb[i] = *(const u32x4*)(Bg + (size_t)row * 1024 + (kt + 1) * 64 + cc * 8);
        }
      }
#pragma unroll
      for (int ks = 0; ks < 2; ++ks) {
        bf16x8 fa[4], fb[8];
#pragma unroll
        for (int t = 0; t < 4; ++t) fa[t] = *(const bf16x8*)(As + (wm * 64 + t * 16 + lr) * LDW + ks * 32 + lq * 8);
#pragma unroll
        for (int u = 0; u < 8; ++u) fb[u] = *(const bf16x8*)(Bs + (wn * 128 + u * 16 + lr) * LDW + ks * 32 + lq * 8);
#pragma unroll
        for (int t = 0; t < 4; ++t)
#pragma unroll
          for (int u = 0; u < 8; ++u) acc[t][u] = MFMA16(fa[t], fb[u], acc[t][u]);
      }
    }
#pragma unroll
    for (int t = 0; t < 4; ++t)
#pragma unroll
      for (int u = 0; u < 8; ++u) {
        const int col = n0 + wn * 128 + u * 16 + lr;
        const int row0 = m0 + wm * 64 + t * 16 + 4 * lq;
        if (EPI == 0) {
          u16* C = (u16*)(p.ws + OFF_PROJ);
#pragma unroll
          for (int g = 0; g < 4; ++g) C[(size_t)(row0 + g) * N0 + col] = f2bf(acc[t][u][g]);
        } else {
          if (n0 < 2048) {
            u16* C = (u16*)(p.ws + OFF_RAW);
#pragma unroll
            for (int g = 0; g < 4; ++g) C[(size_t)(row0 + g) * 2048 + col] = f2bf(acc[t][u][g]);
          } else if (n0 < 3072) {
            u16* Vt = (u16*)(p.ws + OFF_VT);
            const int e = col - 2048;
            int bb, pp;
            if (row0 < T_LAT) { bb = row0 >> 13; pp = 256 + (row0 & 8191); } else { bb = (row0 - T_LAT) >> 8; pp = (row0 - T_LAT) & 255; }
            u32x2 v = {cvtpk(acc[t][u][0], acc[t][u][1]), cvtpk(acc[t][u][2], acc[t][u][3])};
            const int q4 = (pp >> 2) & 3;
            const int pq = (pp & ~15) | ((((q4 & 1) << 1) | (q4 >> 1)) << 2);
            *(u32x2*)(Vt + ((size_t)bb * 1024 + e) * LKV + pq) = v;
          } else {
            u16* G = (u16*)(p.ws + OFF_GB);
#pragma unroll
            for (int g = 0; g < 4; ++g)
              if (row0 + g < T_LAT) G[(size_t)(row0 + g) * 1024 + col - 3072] = f2bf(siluf_(acc[t][u][g]));
          }
        }
      }
  }
}

DI void tokmap(int pos, int d, int b, int& row, bool& hp, bool& hn) {
  if (pos < 256) { const int t = d ? 255 - pos : pos; row = T_LAT + b * 256 + t; hp = t > 0; hn = t < 255; }
  else { const int q = pos - 256; const int t = d ? 8191 - q : q; row = b * 8192 + t; hp = t > 0; hn = t < 8191; }
}

DI void load_mix8(const u16* pr, bool hp, bool hn, const float* mu, float* out) {
  const u32x4 uc = *(const u32x4*)pr;
  u32x4 up = {0u, 0u, 0u, 0u}, un = {0u, 0u, 0u, 0u};
  if (hp) up = *(const u32x4*)(pr - N0);
  if (hn) un = *(const u32x4*)(pr + N0);
  float c[8], a[8], n[8];
  unpack8(uc, c); unpack8(up, a); unpack8(un, n);
  const f32x4 m0 = *(const f32x4*)mu, m1 = *(const f32x4*)(mu + 4);
#pragma unroll
  for (int j = 0; j < 8; ++j) {
    const float m = j < 4 ? m0[j & 3] : m1[j & 3];
    out[j] = c[j] + m * (0.5f * (a[j] + n[j]) - c[j]);
  }
}

DI void mixraw8(const u32x4& uc, const u32x4& up, const u32x4& un, bool hp, bool hn, const float* mu, float* out) {
  float c[8], a[8], n[8];
  unpack8(uc, c); unpack8(up, a); unpack8(un, n);
  const f32x4 m0 = *(const f32x4*)mu, m1 = *(const f32x4*)(mu + 4);
#pragma unroll
  for (int j = 0; j < 8; ++j) {
    const float m = j < 4 ? m0[j & 3] : m1[j & 3];
    const float av = hp ? a[j] : 0.f, nv = hn ? n[j] : 0.f;
    out[j] = c[j] + m * (0.5f * (av + nv) - c[j]);
  }
}

template <int PASS>
DI void phase_scan(const Params& p, char* smem) {
  const int TIDX = ltid();
  const int lane = TIDX & 63, wv = __builtin_amdgcn_readfirstlane(TIDX >> 6);
  float* sm = (float*)smem + wv * 3584;
  float* sW = sm; float* sKK = sm + 512; float* sKKA = sm + 1024; float* sKD = sm + 1536; float* sR = sm + 2048; float* sV = sm + 2560; float* sA = sm + 3072;
  const u16* proj = (const u16*)(p.ws + OFF_PROJ);
  float* stP = (float*)(p.ws + OFF_STP);
  float* stS = (float*)(p.ws + OFF_STS);
  float* bonus = (float*)(p.ws + OFF_BONUS);
  const int nwaves = gridDim.x * 4;
  int reps = (PASS == 1) ? REP_SCAN : 1; asm volatile("" : "+s"(reps));
  for (int rp = 0; rp < reps; ++rp)
  for (int item = blockIdx.x * 4 + wv; item < 2048; item += nwaves) {
    const int chain = item >> 5, chunk = item & 31;
    const int d = chain & 1, hh = (chain >> 1) & 15, b = chain >> 5;
    u16* cB = (u16*)(smem + 57344);
    float* cP = (float*)(smem + 57344 + 18432);
    __syncthreads();
    {
      const int tid = TIDX;
#pragma unroll
      for (int i = 0; i < 4; ++i) {
        const int id = tid + 256 * i;
        const int which = id >> 9, row = (id >> 3) & 63, cc = id & 7;
        const u16* src = (const u16*)(p.ws + (which ? OFF_A2T : OFF_W2T)) + ((size_t)d * 1024 + hh * 64 + row) * 64 + cc * 8;
        *(u32x4*)(cB + (which * 64 + row) * 72 + cc * 8) = *(const u32x4*)src;
      }
      if (tid < 160) {
        const int a = tid >> 4, q = (tid & 15) * 4;
        const float* src;
        switch (a) {
          case 0: src = p.rw_mu + 3072 + d * 64; break;
          case 1: src = p.rw_mu + 3072 + 128 + d * 64; break;
          case 2: src = p.rw_mu + hh * 64; break;
          case 3: src = p.rw_mu + 1024 + hh * 64; break;
          case 4: src = p.rw_mu + 2048 + hh * 64; break;
          case 5: src = p.rw_w0 + d * 1024 + hh * 64; break;
          case 6: src = p.rw_a0 + d * 1024 + hh * 64; break;
          case 7: src = p.rw_kk + hh * 64; break;
          case 8: src = p.rw_ka + hh * 64; break;
          default: src = p.rw_rk + hh * 64; break;
        }
        *(f32x4*)(cP + a * 64 + q) = *(const f32x4*)(src + q);
      }
    }
    __syncthreads();
    if (PASS == 1 && chunk == 31) continue;
    f32x16 S[2][2];
    f32x32 P[2];
    {
      int li = lane; asm volatile("" : "+v"(li));
      const int lv = li & 31, lh = li >> 5;
      if (PASS == 1) {
#pragma unroll
        for (int kt = 0; kt < 2; ++kt)
#pragma unroll
          for (int vt = 0; vt < 2; ++vt)
#pragma unroll
            for (int i = 0; i < 16; ++i) {
              S[kt][vt][i] = 0.f;
              P[vt][16 * kt + i] = (32 * kt + (i & 3) + 8 * (i >> 2) + 4 * lh == 32 * vt + lv) ? 1.f : 0.f;
            }
      } else {
        if (chunk == 0) {
#pragma unroll
          for (int kt = 0; kt < 2; ++kt)
#pragma unroll
            for (int vt = 0; vt < 2; ++vt)
#pragma unroll
              for (int i = 0; i < 16; ++i) S[kt][vt][i] = 0.f;
        } else {
          const float* src = stS + (size_t)(item - 1) * 4096;
#pragma unroll
          for (int kt = 0; kt < 2; ++kt)
#pragma unroll
            for (int vt = 0; vt < 2; ++vt)
#pragma unroll
              for (int g = 0; g < 4; ++g) {
                const f32x4 t = *(const f32x4*)(src + (32 * vt + lv) * 64 + 32 * kt + 8 * g + 4 * lh);
                S[kt][vt][4 * g] = t[0]; S[kt][vt][4 * g + 1] = t[1]; S[kt][vt][4 * g + 2] = t[2]; S[kt][vt][4 * g + 3] = t[3];
              }
        }
      }
    }
    for (int sc = 0; sc < NSUB; ++sc) {
      const int p0 = chunk * LCH + sc * 8;
      int ln = lane; asm volatile("" : "+v"(ln));
      u32x4 rawA[2][3], rawB[3][3];
      bool hpA, hnA, hpB, hnB; int rowB;
      {
        int rowA; tokmap(p0 + (ln & 7), d, b, rowA, hpA, hnA);
        const u16* prA = proj + (size_t)rowA * N0 + 4096 + d * 64 + (ln >> 4) * 8 + ((ln >> 3) & 1) * 32;
        const ptrdiff_t dpA = hpA ? -N0 : 0, dnA = hnA ? N0 : 0;
#pragma unroll
        for (int X = 0; X < 2; ++X) {
          const u16* q = prA + X * 128;
          rawA[X][0] = *(const u32x4*)q; rawA[X][1] = *(const u32x4*)(q + dpA); rawA[X][2] = *(const u32x4*)(q + dnA);
        }
        tokmap(p0 + (ln >> 3), d, b, rowB, hpB, hnB);
        const u16* prB = proj + (size_t)rowB * N0 + hh * 64 + (ln & 7) * 8;
        const ptrdiff_t dpB = hpB ? -N0 : 0, dnB = hnB ? N0 : 0;
#pragma unroll
        for (int X = 0; X < 3; ++X) {
          const u16* q = prB + X * 1024;
          rawB[X][0] = *(const u32x4*)q; rawB[X][1] = *(const u32x4*)(q + dpB); rawB[X][2] = *(const u32x4*)(q + dnB);
        }
      }
      {
        const int m = ln & 15, kg = ln >> 4;
        bf16x8 fa[2][2];
        const int ssel = (m >> 3) & 1;
#pragma unroll
        for (int X = 0; X < 2; ++X) {
          float mx[8];
          mixraw8(rawA[X][0], rawA[X][1], rawA[X][2], hpA, hnA, cP + X * 64 + ssel * 32 + kg * 8, mx);
          if (X == 0) {
#pragma unroll
            for (int j = 0; j < 8; ++j) { const float e = __expf(2.0f * mx[j]); mx[j] = 1.0f - 2.0f * __builtin_amdgcn_rcpf(e + 1.0f); }
          }
          u32x4 own = {cvtpk(mx[0], mx[1]), cvtpk(mx[2], mx[3]), cvtpk(mx[4], mx[5]), cvtpk(mx[6], mx[7])};
          u32x4 oth;
#pragma unroll
          for (int q = 0; q < 4; ++q) oth[q] = (unsigned)__shfl_down((int)own[q], 8);
          fa[X][0] = __builtin_bit_cast(bf16x8, own);
          fa[X][1] = __builtin_bit_cast(bf16x8, ssel ? own : oth);
        }
#pragma unroll
        for (int nt = 0; nt < 4; ++nt) {
          f32x4 aw = {0.f, 0.f, 0.f, 0.f}, aa = {0.f, 0.f, 0.f, 0.f};
#pragma unroll
          for (int s = 0; s < 2; ++s) {
            const bf16x8 bw = *(const bf16x8*)(cB + (16 * nt + m) * 72 + s * 32 + kg * 8);
            const bf16x8 ba = *(const bf16x8*)(cB + (64 + 16 * nt + m) * 72 + s * 32 + kg * 8);
            aw = MFMA16(fa[0][s], bw, aw);
            aa = MFMA16(fa[1][s], ba, aa);
          }
          const int ch = 16 * nt + m;
          const float w0 = cP[5 * 64 + ch];
          const float a0 = cP[6 * 64 + ch];
          if (kg < 2) {
#pragma unroll
            for (int rg = 0; rg < 4; ++rg) {
              sW[(4 * kg + rg) * 64 + ch] = w0 + aw[rg];
              sA[(4 * kg + rg) * 64 + ch] = a0 + aa[rg];
            }
          }
        }
      }
      WAVE_LDS_SYNC();
      __builtin_amdgcn_sched_barrier(0);
      {
        const int tk = ln >> 3, g = ln & 7;
        const int row = rowB;
        const int cb = hh * 64 + g * 8;
        float rr[8], kk[8], vv[8];
        mixraw8(rawB[0][0], rawB[0][1], rawB[0][2], hpB, hnB, cP + 2 * 64 + g * 8, rr);
        mixraw8(rawB[1][0], rawB[1][1], rawB[1][2], hpB, hnB, cP + 3 * 64 + g * 8, kk);
        mixraw8(rawB[2][0], rawB[2][1], rawB[2][2], hpB, hnB, cP + 4 * 64 + g * 8, vv);
        float av[8], kkn[8], kd[8], pkkv[8], pkav[8], prkv[8];
        { const f32x4 t0 = *(const f32x4*)(sA + tk * 64 + g * 8), t1 = *(const f32x4*)(sA + tk * 64 + g * 8 + 4);
          av[0] = fsig(t0[0]); av[1] = fsig(t0[1]); av[2] = fsig(t0[2]); av[3] = fsig(t0[3]); av[4] = fsig(t1[0]); av[5] = fsig(t1[1]); av[6] = fsig(t1[2]); av[7] = fsig(t1[3]); }
        { const f32x4 t0 = *(const f32x4*)(sW + tk * 64 + g * 8), t1 = *(const f32x4*)(sW + tk * 64 + g * 8 + 4);
          f32x4 o0, o1;
#pragma unroll
          for (int j = 0; j < 4; ++j) { o0[j] = __expf(-0.6065306597126334f * fsig(t0[j])); o1[j] = __expf(-0.6065306597126334f * fsig(t1[j])); }
          *(f32x4*)(sW + tk * 64 + g * 8) = o0; *(f32x4*)(sW + tk * 64 + g * 8 + 4) = o1; }
        WAVE_LDS_SYNC();
        { float Wc = 1.0f;
#pragma unroll
          for (int j = 0; j < 8; ++j) { Wc *= sW[j * 64 + ln]; sW[j * 64 + ln] = Wc; } }
        WAVE_LDS_SYNC();
        float wcur[8], wprv[8];
        { const f32x4 t0 = *(const f32x4*)(sW + tk * 64 + g * 8), t1 = *(const f32x4*)(sW + tk * 64 + g * 8 + 4);
          const int tp = tk > 0 ? tk - 1 : 0;
          const f32x4 u0 = *(const f32x4*)(sW + tp * 64 + g * 8), u1 = *(const f32x4*)(sW + tp * 64 + g * 8 + 4);
#pragma unroll
          for (int j = 0; j < 4; ++j) { wcur[j] = t0[j]; wcur[j + 4] = t1[j]; wprv[j] = tk > 0 ? u0[j] : 1.0f; wprv[j + 4] = tk > 0 ? u1[j] : 1.0f; } }
        { const float* q7 = cP + 7 * 64 + g * 8;
          const f32x4 a0 = *(const f32x4*)(q7), a1 = *(const f32x4*)(q7 + 4), b0 = *(const f32x4*)(q7 + 64), b1 = *(const f32x4*)(q7 + 68),
                      c0 = *(const f32x4*)(q7 + 128), c1 = *(const f32x4*)(q7 + 132);
#pragma unroll
          for (int j = 0; j < 4; ++j) { pkkv[j] = a0[j]; pkkv[j + 4] = a1[j]; pkav[j] = b0[j]; pkav[j + 4] = b1[j]; prkv[j] = c0[j]; prkv[j + 4] = c1[j]; } }
        float ss = 0.f, bon = 0.f;
#pragma unroll
        for (int j = 0; j < 8; ++j) {
          kkn[j] = kk[j] * pkkv[j]; ss += kkn[j] * kkn[j];
          kd[j] = kk[j] * (1.0f + (av[j] - 1.0f) * pkav[j]);
          bon += rr[j] * kd[j] * prkv[j];
        }
        ss += __shfl_xor(ss, 1); ss += __shfl_xor(ss, 2); ss += __shfl_xor(ss, 4);
        const float inv = rsqrtf(ss + 1e-12f);
        if (PASS == 2) {
          bon += __shfl_xor(bon, 1); bon += __shfl_xor(bon, 2); bon += __shfl_xor(bon, 4);
          if (g == 0) bonus[(size_t)d * (T_ALL * 16) + (size_t)row * 16 + hh] = bon;
        }
        float iw[8];
#pragma unroll
        for (int j = 0; j < 8; ++j) iw[j] = __builtin_amdgcn_rcpf(wcur[j]);
        float* o;
        o = sKK + tk * 64 + g * 8;
        *(f32x4*)o = f32x4{kkn[0] * inv * wprv[0], kkn[1] * inv * wprv[1], kkn[2] * inv * wprv[2], kkn[3] * inv * wprv[3]};
        *(f32x4*)(o + 4) = f32x4{kkn[4] * inv * wprv[4], kkn[5] * inv * wprv[5], kkn[6] * inv * wprv[6], kkn[7] * inv * wprv[7]};
        o = sKKA + tk * 64 + g * 8;
        *(f32x4*)o = f32x4{kkn[0] * inv * av[0] * iw[0], kkn[1] * inv * av[1] * iw[1], kkn[2] * inv * av[2] * iw[2], kkn[3] * inv * av[3] * iw[3]};
        *(f32x4*)(o + 4) = f32x4{kkn[4] * inv * av[4] * iw[4], kkn[5] * inv * av[5] * iw[5], kkn[6] * inv * av[6] * iw[6], kkn[7] * inv * av[7] * iw[7]};
        o = sKD + tk * 64 + g * 8;
        *(f32x4*)o = f32x4{kd[0] * iw[0], kd[1] * iw[1], kd[2] * iw[2], kd[3] * iw[3]};
        *(f32x4*)(o + 4) = f32x4{kd[4] * iw[4], kd[5] * iw[5], kd[6] * iw[6], kd[7] * iw[7]};
        o = sR + tk * 64 + g * 8;
        *(f32x4*)o = f32x4{rr[0] * wcur[0], rr[1] * wcur[1], rr[2] * wcur[2], rr[3] * wcur[3]};
        *(f32x4*)(o + 4) = f32x4{rr[4] * wcur[4], rr[5] * wcur[5], rr[6] * wcur[6], rr[7] * wcur[7]};
        o = sV + tk * 64 + g * 8;
        *(f32x4*)o = f32x4{vv[0], vv[1], vv[2], vv[3]};
        *(f32x4*)(o + 4) = f32x4{vv[4], vv[5], vv[6], vv[7]};
      }
      WAVE_LDS_SYNC();
      __builtin_amdgcn_sched_barrier(0);
      float* obase = nullptr; ptrdiff_t ostep = d ? -1024 : 1024;
      if (PASS == 2) {
        int row0; bool hp0, hn0; tokmap(p0, d, b, row0, hp0, hn0);
        obase = ((row0 < T_LAT) ? (p.out + (size_t)row0 * 1024) : ((float*)(p.ws + OFF_OCTX) + (size_t)(row0 - T_LAT) * 1024)) + hh * 64 + lane;
      }
      const int lv31 = lane & 31, lh1 = lane >> 5;
#pragma unroll 1
      for (int j = 0; j < 8; ++j) {
        f32x4 kkv[2][4];
#pragma unroll
        for (int kt = 0; kt < 2; ++kt)
#pragma unroll
          for (int g = 0; g < 4; ++g) kkv[kt][g] = *(const f32x4*)(sKK + j * 64 + 32 * kt + 8 * g + 4 * lh1);
        float aop[2], vvv[2];
        const float akka = sKKA[j * 64 + lane];
#pragma unroll
        for (int t = 0; t < 2; ++t) {
          aop[t] = (lh1 ? sKD : sKKA)[j * 64 + 32 * t + lv31];
          vvv[t] = sV[j * 64 + 32 * t + lv31];
        }
        float saS[2], saP[2];
#pragma unroll
        for (int vt = 0; vt < 2; ++vt) {
          f2 a2 = {0.f, 0.f}, b2 = {0.f, 0.f};
#pragma unroll
          for (int kt = 0; kt < 2; ++kt)
#pragma unroll
            for (int g = 0; g < 4; ++g) {
              a2 += f2{S[kt][vt][4 * g], S[kt][vt][4 * g + 1]} * f2{kkv[kt][g][0], kkv[kt][g][1]};
              a2 += f2{S[kt][vt][4 * g + 2], S[kt][vt][4 * g + 3]} * f2{kkv[kt][g][2], kkv[kt][g][3]};
              if (PASS == 1) {
                b2 += f2{P[vt][16 * kt + 4 * g], P[vt][16 * kt + 4 * g + 1]} * f2{kkv[kt][g][0], kkv[kt][g][1]};
                b2 += f2{P[vt][16 * kt + 4 * g + 2], P[vt][16 * kt + 4 * g + 3]} * f2{kkv[kt][g][2], kkv[kt][g][3]};
              }
            }
          float x = a2[0] + a2[1];
          x += __shfl_xor(x, 32);
          saS[vt] = x;
          if (PASS == 1) { float y = b2[0] + b2[1]; y += __shfl_xor(y, 32); saP[vt] = y; }
        }
#pragma unroll
        for (int vt = 0; vt < 2; ++vt) {
          const float bS = lh1 ? vvv[vt] : -saS[vt];
          if (PASS == 1) P[vt] = __builtin_amdgcn_mfma_f32_32x32x1f32(akka, -saP[vt], P[vt], 0, 0, 0);
#pragma unroll
          for (int kt = 0; kt < 2; ++kt) {
            S[kt][vt] = __builtin_amdgcn_mfma_f32_32x32x2f32(aop[kt], bS, S[kt][vt], 0, 0, 0);
          }
        }
        if (PASS == 2) {
          f32x4 rv[2][4];
#pragma unroll
          for (int kt = 0; kt < 2; ++kt)
#pragma unroll
            for (int g = 0; g < 4; ++g) rv[kt][g] = *(const f32x4*)(sR + j * 64 + 32 * kt + 8 * g + 4 * lh1);
          float ov[2];
#pragma unroll
          for (int vt = 0; vt < 2; ++vt) {
            f2 a2 = {0.f, 0.f};
#pragma unroll
            for (int kt = 0; kt < 2; ++kt)
#pragma unroll
              for (int g = 0; g < 4; ++g) {
                a2 += f2{S[kt][vt][4 * g], S[kt][vt][4 * g + 1]} * f2{rv[kt][g][0], rv[kt][g][1]};
                a2 += f2{S[kt][vt][4 * g + 2], S[kt][vt][4 * g + 3]} * f2{rv[kt][g][2], rv[kt][g][3]};
              }
            float x = a2[0] + a2[1];
            x += __shfl_xor(x, 32);
            ov[vt] = x;
          }
          atomicAdd(obase + (ptrdiff_t)j * ostep, lh1 ? ov[1] : ov[0]);
        }
      }
      {
        f32x4 w7[2][4];
#pragma unroll
        for (int kt = 0; kt < 2; ++kt)
#pragma unroll
          for (int g = 0; g < 4; ++g) w7[kt][g] = *(const f32x4*)(sW + 7 * 64 + 32 * kt + 8 * g + 4 * lh1);
#pragma unroll
        for (int kt = 0; kt < 2; ++kt)
#pragma unroll
          for (int vt = 0; vt < 2; ++vt)
#pragma unroll
            for (int i = 0; i < 16; ++i) {
              S[kt][vt][i] *= w7[kt][i >> 2][i & 3];
              if (PASS == 1) P[vt][16 * kt + i] *= w7[kt][i >> 2][i & 3];
            }
      }
      WAVE_LDS_SYNC();
    }
    if (PASS == 1) {
      int li = lane; asm volatile("" : "+v"(li));
      const int lv = li & 31, lh = li >> 5;
      float* dP = stP + (size_t)item * 4096;
      float* dS = stS + (size_t)item * 4096;
#pragma unroll
      for (int kt = 0; kt < 2; ++kt)
#pragma unroll
        for (int vt = 0; vt < 2; ++vt)
#pragma unroll
          for (int g = 0; g < 4; ++g) {
            const int off = (32 * vt + lv) * 64 + 32 * kt + 8 * g + 4 * lh;
            *(f32x4*)(dP + off) = f32x4{P[vt][16 * kt + 4 * g], P[vt][16 * kt + 4 * g + 1], P[vt][16 * kt + 4 * g + 2], P[vt][16 * kt + 4 * g + 3]};
            *(f32x4*)(dS + off) = f32x4{S[kt][vt][4 * g], S[kt][vt][4 * g + 1], S[kt][vt][4 * g + 2], S[kt][vt][4 * g + 3]};
          }
    }
  }
}

DI void phase_carry(const Params& p, char* smem) {
  const int TIDX = ltid();
  float* cur = (float*)smem;
  const int tid = TIDX, lane = tid & 63, w = __builtin_amdgcn_readfirstlane(tid >> 6);
  const int lc = lane & 15, lq = lane >> 4;
  float* stP = (float*)(p.ws + OFF_STP);
  float* stS = (float*)(p.ws + OFF_STS);
  for (int it = blockIdx.x; it < 256; it += gridDim.x) {
    const int chain = it >> 2, rg = it & 3;
    const size_t slot0 = (size_t)chain * 32;
    __syncthreads();
    {
      const int row = tid >> 4, c4 = (tid & 15) * 4;
      const f32x4 t = *(const f32x4*)(stS + (slot0 * 64 + rg * 16 + row) * 64 + c4);
      *(f32x4*)(cur + row * 68 + c4) = t;
    }
    __syncthreads();
    float pn[16]; f32x4 an;
    {
      const float* Pm = stP + (slot0 + 1) * 4096;
#pragma unroll
      for (int s = 0; s < 16; ++s) pn[s] = Pm[(size_t)(4 * s + lq) * 64 + 16 * w + lc];
#pragma unroll
      for (int rr = 0; rr < 4; ++rr) an[rr] = stS[((slot0 + 1) * 64 + rg * 16 + 4 * lq + rr) * 64 + 16 * w + lc];
    }
    for (int c = 1; c < 31; ++c) {
      const size_t slot = slot0 + c;
      float pj[16]; f32x4 acc = an;
#pragma unroll
      for (int s = 0; s < 16; ++s) pj[s] = pn[s];
      if (c + 1 < 31) {
        const float* Pm = stP + (slot + 1) * 4096;
#pragma unroll
        for (int s = 0; s < 16; ++s) pn[s] = Pm[(size_t)(4 * s + lq) * 64 + 16 * w + lc];
#pragma unroll
        for (int rr = 0; rr < 4; ++rr) an[rr] = stS[((slot + 1) * 64 + rg * 16 + 4 * lq + rr) * 64 + 16 * w + lc];
      }
#pragma unroll
      for (int s = 0; s < 16; ++s) {
        const float a = cur[lc * 68 + 4 * s + lq];
        acc = __builtin_amdgcn_mfma_f32_16x16x4f32(a, pj[s], acc, 0, 0, 0);
      }
      __syncthreads();
#pragma unroll
      for (int rr = 0; rr < 4; ++rr) {
        cur[(4 * lq + rr) * 68 + 16 * w + lc] = acc[rr];
        stS[(slot * 64 + rg * 16 + 4 * lq + rr) * 64 + 16 * w + lc] = acc[rr];
      }
      __syncthreads();
    }
  }
}

DI void phase_readout(const Params& p) {
  const int TIDX = ltid();
  const int lane = TIDX & 63, wv = __builtin_amdgcn_readfirstlane(TIDX >> 6);
  const u16* proj = (const u16*)(p.ws + OFF_PROJ);
  const float* bonus = (const float*)(p.ws + OFF_BONUS);
  u16* hb = (u16*)(p.ws + OFF_HB);
  for (int row = blockIdx.x * 4 + wv; row < T_ALL; row += gridDim.x * 4) {
    const float* o = (row < T_LAT) ? (p.out + (size_t)row * 1024) : ((const float*)(p.ws + OFF_OCTX) + (size_t)(row - T_LAT) * 1024);
    bool hp, hn;
    if (row < T_LAT) { const int t = row & 8191; hp = t > 0; hn = t < 8191; } else { const int t = (row - T_LAT) & 255; hp = t > 0; hn = t < 255; }
    const int c0 = lane * 16, hh = lane >> 2;
    float ov[16];
    float s = 0.f;
#pragma unroll
    for (int q = 0; q < 4; ++q) { const f32x4 t = *(const f32x4*)(o + c0 + q * 4); ov[q * 4] = t[0]; ov[q * 4 + 1] = t[1]; ov[q * 4 + 2] = t[2]; ov[q * 4 + 3] = t[3]; s += t[0] + t[1] + t[2] + t[3]; }
    s += __shfl_xor(s, 1); s += __shfl_xor(s, 2);
    const float mean = s * (1.0f / 64.0f);
    float vs = 0.f;
#pragma unroll
    for (int j = 0; j < 16; ++j) { const float dlt = ov[j] - mean; vs += dlt * dlt; }
    vs += __shfl_xor(vs, 1); vs += __shfl_xor(vs, 2);
    const float rstd = rsqrtf(vs * (1.0f / 64.0f) + 64e-5f);
    const float bon = bonus[(size_t)row * 16 + hh] + bonus[(size_t)(T_ALL * 16) + (size_t)row * 16 + hh];
    float vm[16];
    const u16* pr = proj + (size_t)row * N0;
    load_mix8(pr + 2048 + c0, hp, hn, p.rw_mu + 2048 + c0, vm);
    load_mix8(pr + 2048 + c0 + 8, hp, hn, p.rw_mu + 2048 + c0 + 8, vm + 8);
    float gv[16];
    unpack8(*(const u32x4*)(pr + 3072 + c0), gv);
    unpack8(*(const u32x4*)(pr + 3072 + c0 + 8), gv + 8);
    unsigned pk[8];
#pragma unroll
    for (int j = 0; j < 8; ++j) {
      const int ca = c0 + 2 * j, cb = ca + 1;
      const float ya = ((ov[2 * j] - mean) * rstd * p.rw_gn_g[ca] + p.rw_gn_b[ca] + bon * vm[2 * j]) * siluf_(gv[2 * j]);
      const float yb = ((ov[2 * j + 1] - mean) * rstd * p.rw_gn_g[cb] + p.rw_gn_b[cb] + bon * vm[2 * j + 1]) * siluf_(gv[2 * j + 1]);
      pk[j] = pack2(ya, yb);
    }
    u32x4* dd = (u32x4*)(hb + (size_t)row * 1024 + c0);
    dd[0] = u32x4{pk[0], pk[1], pk[2], pk[3]};
    dd[1] = u32x4{pk[4], pk[5], pk[6], pk[7]};
  }
}

DI void phase_qkprep(const Params& p) {
  const int TIDX = ltid();
  const int lane = TIDX & 63, wv = __builtin_amdgcn_readfirstlane(TIDX >> 6);
  const u16* raw = (const u16*)(p.ws + OFF_RAW);
  u16* Qs = (u16*)(p.ws + OFF_QS);
  u16* Ks = (u16*)(p.ws + OFF_KS);
  const float* rope = (const float*)(p.ws + OFF_ROPE);
  const int grp = lane >> 1, axis = lane & 1;
  const bool isq = grp < 16;
  const int hd = (grp & 15) >> 1, comp = grp & 1;
  const float* gain = (isq ? p.da_qn : p.da_kn) + axis * 32;
  for (int row = blockIdx.x * 4 + wv; row < T_ALL; row += gridDim.x * 4) {
    const bool lat = row < T_LAT;
    int b, t;
    if (lat) { b = row >> 13; t = row & 8191; } else { b = (row - T_LAT) >> 8; t = (row - T_LAT) & 255; }
    const u16* src = raw + (size_t)row * 2048 + lane * 32;
    float v[32];
#pragma unroll
    for (int q = 0; q < 4; ++q) unpack8(*(const u32x4*)(src + q * 8), v + q * 8);
    float ss = 0.f;
#pragma unroll
    for (int j = 0; j < 32; ++j) ss += v[j] * v[j];
    ss += __shfl_xor(ss, 1);
    const float rstd = rsqrtf(ss * (1.0f / 64.0f) + 1e-6f);
#pragma unroll
    for (int j = 0; j < 32; ++j) v[j] = v[j] * rstd * gain[j];
    if (lat) {
      const int pos = axis == 0 ? (t >> 6) : (t & 63);
#pragma unroll
      for (int f = 0; f < 16; ++f) {
        const float c = rope[pos * 16 + f], s = rope[2048 + pos * 16 + f];
        const float x1 = v[f], x2 = v[16 + f];
        v[f] = x1 * c - x2 * s; v[16 + f] = x2 * c + x1 * s;
      }
    }
    u16* dst;
    float sc = 1.0f;
    if (isq) {
      if (!lat) continue;
      sc = 0.125f * 1.4426950408889634f;
      dst = Qs + (((size_t)(b * 8 + hd) * 2 + comp) * 8192 + t) * 64 + axis * 32;
    } else {
      const int pp = lat ? 256 + t : t;
      dst = Ks + (((size_t)(b * 8 + hd) * 2 + comp) * LKV + pp) * 64 + axis * 32;
    }
#pragma unroll
    for (int q = 0; q < 4; ++q) {
      u32x4 o = {pack2(v[q * 8] * sc, v[q * 8 + 1] * sc), pack2(v[q * 8 + 2] * sc, v[q * 8 + 3] * sc),
                 pack2(v[q * 8 + 4] * sc, v[q * 8 + 5] * sc), pack2(v[q * 8 + 6] * sc, v[q * 8 + 7] * sc)};
      *(u32x4*)(dst + q * 8) = o;
    }
  }
}

typedef __attribute__((address_space(3))) unsigned* lds_uptr;
typedef __attribute__((address_space(1))) const unsigned* glb_uptr;
DI void dma16(const void* g, char* ldsbase) {
  __builtin_amdgcn_global_load_lds((glb_uptr)(g), (lds_uptr)(ldsbase), 16, 0, 0);
}

DI void attn_issue_tile(const u16* Kg, const u16* Vg, int k0, char* buf, int wv, int lane) {
  asm volatile("" : "+v"(lane));
  const int rr = lane >> 3, cp = lane & 7;
#pragma unroll
  for (int i = 0; i < 4; ++i) {
    const int seg = wv * 4 + i;
    const int c = seg >> 3, key = (seg & 7) * 8 + rr;
    const int sw = (key >> 1) & 7;
    dma16(Kg + ((size_t)c * LKV + k0 + key) * 64 + ((cp ^ sw) << 3), buf + seg * 1024);
    const int e = seg * 8 + rr;
    const int swv = (e >> 1) & 7;
    dma16(Vg + (size_t)e * LKV + k0 + ((cp ^ swv) << 3), buf + 16384 + seg * 1024);
  }
}

DI void phase_attn(const Params& p, char* smem) {
  const int TIDX = ltid();
  const int tid = TIDX, lane = tid & 63, wv = __builtin_amdgcn_readfirstlane(tid >> 6);
  const int r = lane & 31, h = lane >> 5;
  const u16* Qs = (const u16*)(p.ws + OFF_QS);
  const u16* Ks = (const u16*)(p.ws + OFF_KS);
  const u16* Vt = (const u16*)(p.ws + OFF_VT);
  const u16* GB = (const u16*)(p.ws + OFF_GB);
  u16* Y2 = (u16*)(p.ws + OFF_Y2);
  float lam;
  {
    float a = p.da_lam[lane] * p.da_lam[64 + lane];
    float bq = p.da_lam[128 + lane] * p.da_lam[192 + lane];
#pragma unroll
    for (int o = 32; o >= 1; o >>= 1) { a += __shfl_xor(a, o); bq += __shfl_xor(bq, o); }
    lam = __expf(a) - __expf(bq) + 0.35550906759096927f;
  }
  const float one_m_li = 1.0f - 0.35550906759096927f;
  const int sw = (r >> 1) & 7;
  int repa = REP_ATTN; asm volatile("" : "+s"(repa));
  for (int rp = 0; rp < repa; ++rp)
  for (int item = blockIdx.x; item < 1024; item += gridDim.x) {
    const int bh = (item & 7) * 2 + (item >> 9), qt = (item >> 3) & 63;
    const int q0 = qt * 128 + wv * 32;
    const u16* Kg = Ks + (size_t)bh * 2 * LKV * 64;
    const u16* Vg = Vt + (size_t)bh * 128 * LKV;
    __syncthreads();
    attn_issue_tile(Kg, Vg, 0, smem, wv, lane);
    bf16x8 qf[2][4];
#pragma unroll
    for (int c = 0; c < 2; ++c)
#pragma unroll
      for (int s = 0; s < 4; ++s)
        qf[c][s] = *(const bf16x8*)(Qs + (((size_t)bh * 2 + c) * 8192 + q0 + r) * 64 + s * 16 + 8 * h);
    f32x16 O[2][4];
#pragma unroll
    for (int c = 0; c < 2; ++c)
#pragma unroll
      for (int e = 0; e < 4; ++e)
#pragma unroll
        for (int i = 0; i < 16; ++i) O[c][e][i] = 0.f;
    f2 lsum[2] = {f2{0.f, 0.f}, f2{0.f, 0.f}};
#pragma unroll 1
    for (int kt = 0; kt < LKV / 64; ++kt) {
      char* buf = smem + (kt & 1) * 32768;
      asm volatile("s_waitcnt vmcnt(0)" ::: "memory");
      __syncthreads();
      if (kt + 1 < LKV / 64) attn_issue_tile(Kg, Vg, (kt + 1) * 64, smem + ((kt + 1) & 1) * 32768, wv, lane);
      const char* Kb = buf + r * 128;
      const char* Vb = buf + 16384 + r * 128;
#pragma unroll
      for (int sub = 0; sub < 2; ++sub) {
        f32x16 sacc[2];
#pragma unroll
        for (int c = 0; c < 2; ++c) {
#pragma unroll
          for (int i = 0; i < 16; ++i) sacc[c][i] = 0.f;
#pragma unroll
          for (int s = 0; s < 4; ++s) {
            const bf16x8 kf = *(const bf16x8*)(Kb + c * 8192 + sub * 4096 + (((2 * s + h) ^ sw) << 4));
            sacc[c] = MFMA32(kf, qf[c][s], sacc[c]);
          }
        }
#pragma unroll
        for (int c = 0; c < 2; ++c) {
          bf16x8 pf[2];
#pragma unroll
          for (int s = 0; s < 2; ++s) {
            float ps[8];
#pragma unroll
            for (int i = 0; i < 8; ++i) ps[i] = __builtin_amdgcn_exp2f(sacc[c][8 * s + i]);
            lsum[c] += f2{ps[0], ps[1]}; lsum[c] += f2{ps[2], ps[3]}; lsum[c] += f2{ps[4], ps[5]}; lsum[c] += f2{ps[6], ps[7]};
            u32x4 pk = {cvtpk(ps[0], ps[1]), cvtpk(ps[2], ps[3]), cvtpk(ps[4], ps[5]), cvtpk(ps[6], ps[7])};
            pf[s] = __builtin_bit_cast(bf16x8, pk);
          }
#pragma unroll
          for (int e = 0; e < 4; ++e)
#pragma unroll
            for (int s = 0; s < 2; ++s) {
              const bf16x8 vf = *(const bf16x8*)(Vb + e * 4096 + (((sub * 4 + 2 * s + h) ^ sw) << 4));
              O[c][e] = MFMA32(vf, pf[s], O[c][e]);
            }
        }
      }
    }
    float l0 = lsum[0][0] + lsum[0][1], l1 = lsum[1][0] + lsum[1][1];
    l0 += __shfl_xor(l0, 32); l1 += __shfl_xor(l1, 32);
    const float i0 = 1.0f / l0, i1 = lam / l1;
    float ss = 0.f;
#pragma unroll
    for (int e = 0; e < 4; ++e)
#pragma unroll
      for (int i = 0; i < 16; ++i) { const float o = O[0][e][i] * i0 - O[1][e][i] * i1; O[0][e][i] = o; ss += o * o; }
    ss += __shfl_xor(ss, 32);
    const float rstd = rsqrtf(ss * (1.0f / 128.0f) + 1e-5f) * one_m_li;
    const int b = bh >> 3, hd = bh & 7;
    int rl = r; asm volatile("" : "+v"(rl));
    const size_t row = (size_t)b * 8192 + q0 + rl;
#pragma unroll
    for (int e = 0; e < 4; ++e) {
#pragma unroll
      for (int g = 0; g < 4; ++g) {
        const int ee = e * 32 + 8 * g + 4 * h;
        const u32x2 gg = *(const u32x2*)(GB + row * 1024 + hd * 128 + ee);
        const float g0 = bflo(gg[0]), g1 = bfhi(gg[0]), g2 = bflo(gg[1]), g3 = bfhi(gg[1]);
        const f32x4 sl = *(const f32x4*)(p.da_subln + ee);
        const float y0 = O[0][e][4 * g] * rstd * sl[0] * g0;
        const float y1 = O[0][e][4 * g + 1] * rstd * sl[1] * g1;
        const float y2 = O[0][e][4 * g + 2] * rstd * sl[2] * g2;
        const float y3 = O[0][e][4 * g + 3] * rstd * sl[3] * g3;
        *(u32x2*)(Y2 + row * 1024 + hd * 128 + ee) = u32x2{cvtpk(y0, y1), cvtpk(y2, y3)};
      }
      asm volatile("" ::: "memory");
    }
  }
}

#define XB_TMO      128
#define XB_XCNT(j)  (256  + 64 * (j))
#define XB_XSUB(j)  (1280 + 64 * (j))
#define XB_XGEN(j)  (2304 + 64 * (j))
#define XB_TOP      3328
#define XB_TOPGEN   3392
#define XCD_BAR_WORDS 3456
#define XB_SPIN_CAP (1u << 18)
#define LAS __attribute__((address_space(3)))

__device__ __forceinline__ unsigned xb_ld(unsigned* p)              { return __hip_atomic_load(p, __ATOMIC_RELAXED, __HIP_MEMORY_SCOPE_AGENT); }
__device__ __forceinline__ unsigned xb_add(unsigned* p, unsigned v) { return __hip_atomic_fetch_add(p, v, __ATOMIC_RELAXED, __HIP_MEMORY_SCOPE_AGENT); }
__device__ __forceinline__ unsigned xb_xcc_id() { return (unsigned)__builtin_amdgcn_s_getreg((3 << 11) | 20) & 0xFu; }
#define XB_SPIN(cond, bar) do { unsigned _sp = 0; while (cond) { __builtin_amdgcn_s_sleep(1); \
    if ((++_sp & 255u) == 0u) { if (xb_ld(&(bar)[XB_TMO])) break; if (_sp > XB_SPIN_CAP) { atomicAdd(&(bar)[XB_TMO], 1u); break; } } } } while (0)

struct XcdBarrier {
    unsigned* bar; unsigned x;
    volatile LAS unsigned* st;
};

__device__ __forceinline__ XcdBarrier xcd_barrier_post(unsigned* bar, volatile LAS unsigned* st) {
    XcdBarrier b; b.bar = bar; b.x = xb_xcc_id(); b.st = st;
    if (threadIdx.x == 0) (void)xb_add(&bar[XB_XCNT(b.x)], 1u);
    return b;
}
__device__ __forceinline__ void xcd_barrier_complete(unsigned* bar, unsigned x, unsigned& nloc, unsigned& nx) {
    const unsigned G = gridDim.x * gridDim.y * gridDim.z;
    unsigned sum, cnt, mine, sp = 0u;
    for (;;) {
        sum = 0u; cnt = 0u; mine = 0u;
#pragma unroll
        for (unsigned j = 0; j < 16; ++j) { const unsigned c = xb_ld(&bar[XB_XCNT(j)]); sum += c; cnt += (c > 0u) ? 1u : 0u; mine = (j == x) ? c : mine; }
        if (sum == G) break;
        __builtin_amdgcn_s_sleep(1);
        if ((++sp & 255u) == 0u) { if (xb_ld(&bar[XB_TMO])) break; if (sp > XB_SPIN_CAP) { atomicAdd(&bar[XB_TMO], 1u); break; } }
    }
    nloc = mine > 0u ? mine : 1u; nx = cnt > 0u ? cnt : 1u;
}

__device__ __forceinline__ void xcd_barrier(const XcdBarrier& b) {
    asm volatile("s_waitcnt vmcnt(0)" ::: "memory");
    __syncthreads();
    if (threadIdx.x == 0) {
        unsigned* bar = b.bar;
        __builtin_amdgcn_s_waitcnt(0);
        unsigned nloc = b.st[0], nx = b.st[1];
        if (nloc == 0u) { xcd_barrier_complete(bar, b.x, nloc, nx); b.st[0] = nloc; b.st[1] = nx; }
        const unsigned old = xb_add(&bar[XB_XSUB(b.x)], 1u);
        const unsigned gen = old / nloc;
        if (old + 1u == (gen + 1u) * nloc) {
            __builtin_amdgcn_fence(__ATOMIC_RELEASE, "agent");
            asm volatile("s_waitcnt vmcnt(0)" ::: "memory");
            const unsigned og = xb_add(&bar[XB_TOP], 1u);
            const unsigned tg = og / nx;
            if (og + 1u == (tg + 1u) * nx) xb_add(&bar[XB_TOPGEN], 1u);
            else XB_SPIN(xb_ld(&bar[XB_TOPGEN]) == tg, bar);
            __builtin_amdgcn_fence(__ATOMIC_ACQUIRE, "agent");
            xb_add(&bar[XB_XGEN(b.x)], 1u);
            asm volatile("s_waitcnt vmcnt(0)" ::: "memory");
        } else {
            XB_SPIN(xb_ld(&bar[XB_XGEN(b.x)]) == gen, bar);
            __builtin_amdgcn_fence(__ATOMIC_ACQUIRE, "agent");
            asm volatile("s_waitcnt vmcnt(0)" ::: "memory");
        }
    }
    __syncthreads();
}


__global__ void __launch_bounds__(256, 2) fwd_megakernel(Params p) {
  extern __shared__ __attribute__((aligned(16))) char smem[];
  __shared__ uint4 xb_words;
  cg::grid_group grid = cg::this_grid();
  if (threadIdx.x == 0) xb_words = make_uint4(0u, 0u, 0u, 0u);
  __syncthreads();
  XcdBarrier xb = xcd_barrier_post((unsigned*)(p.ws + OFF_BAR), (volatile LAS unsigned*)&xb_words);
  phase_prep(p, smem);
  if (p.ws == nullptr) grid.sync();
  xcd_barrier(xb);
  phase_normmod(p, 0, p.x, p.ctx, true);
  xcd_barrier(xb);
  phase_gemm_wide16<0>(p, smem, (const u16*)(p.ws + OFF_HB), (const u16*)(p.ws + OFF_WT_IN0), 120, N0 / 256);
  phase_gemm<0>(p, smem, (const u16*)(p.ws + OFF_HB), (const u16*)(p.ws + OFF_WT_IN0), T_ALL / 128 - 120, N0 / 128, 120);
  xcd_barrier(xb);
  phase_scan<1>(p, smem);
  xcd_barrier(xb);
  phase_carry(p, smem);
  xcd_barrier(xb);
  phase_scan<2>(p, smem);
  xcd_barrier(xb);
  phase_readout(p);
  xcd_barrier(xb);
  phase_gemm<1>(p, smem, (const u16*)(p.ws + OFF_HB), (const u16*)(p.ws + OFF_WT_OUT0), T_ALL / 128, 8);
  xcd_barrier(xb);
  phase_normmod(p, 1, p.out, (const float*)(p.ws + OFF_XC1), false);
  xcd_barrier(xb);
  phase_gemm_wide16<2>(p, smem, (const u16*)(p.ws + OFF_HB), (const u16*)(p.ws + OFF_WT_IN1), 128, N1 / 256);
  phase_gemm<2>(p, smem, (const u16*)(p.ws + OFF_HB), (const u16*)(p.ws + OFF_WT_IN1), T_ALL / 128 - 128, N1 / 128, 128);
  xcd_barrier(xb);
  phase_qkprep(p);
  xcd_barrier(xb);
  phase_attn(p, smem);
  xcd_barrier(xb);
  phase_gemm<3>(p, smem, (const u16*)(p.ws + OFF_Y2), (const u16*)(p.ws + OFF_WT_OUT1), T_LAT / 128, 8);
}

extern "C" void kernel_launch(void* const* d_in, const int* in_sizes, int n_in, void* d_out, int out_size, void* d_ws,
                              size_t ws_size, hipStream_t stream) {
  static int grid_blocks = 0;
  if (!grid_blocks) {
    int dev = 0, cus = 0, per_cu = 0;
    hipGetDevice(&dev);
    hipDeviceGetAttribute(&cus, hipDeviceAttributeMultiprocessorCount, dev);
    hipFuncSetAttribute((const void*)fwd_megakernel, hipFuncAttributeMaxDynamicSharedMemorySize, LDS_BYTES);
    hipOccupancyMaxActiveBlocksPerMultiprocessor(&per_cu, fwd_megakernel, 256, LDS_BYTES);
    if (per_cu < 1) per_cu = 1;
    if (per_cu > 2) per_cu = 2;
    grid_blocks = cus * per_cu;
    if (ws_size < 256 * MiB) fprintf(stderr, "kernel_launch: workspace too small: %zu\n", ws_size);
  }
  Params p{};
  const float** pp = (const float**)&p;
  for (int i = 0; i < 25; ++i) pp[i] = (const float*)d_in[i];
  p.out = (float*)d_out;
  p.ws = (char*)d_ws;
  hipMemsetAsync((char*)d_ws + OFF_BAR, 0, XCD_BAR_WORDS * sizeof(unsigned), stream);
  void* args[] = {&p};
  hipError_t e = hipLaunchCooperativeKernel((void*)fwd_megakernel, dim3(grid_blocks), dim3(256), args, LDS_BYTES, stream);
  if (e != hipSuccess) fprintf(stderr, "cooperative launch failed: %s (grid %d)\n", hipGetErrorString(e), grid_blocks);
}
```

```cpp
#include <hip/hip_runtime.h>
#include <hip/hip_cooperative_groups.h>
#include <cstdio>
namespace cg = cooperative_groups;

#define DI __device__ __forceinline__
typedef unsigned short u16;
using bf16x8 = __attribute__((ext_vector_type(8))) short;
using s16x4  = __attribute__((ext_vector_type(4))) short;
using f32x16 = __attribute__((ext_vector_type(16))) float;
using f32x4  = __attribute__((ext_vector_type(4))) float;
using f32x32 = __attribute__((ext_vector_type(32))) float;
using f2     = __attribute__((ext_vector_type(2))) float;
using u32x4  = __attribute__((ext_vector_type(4))) unsigned;
using u32x2  = __attribute__((ext_vector_type(2))) unsigned;

constexpr int T_LAT = 16384, T_CTX = 512, T_ALL = 16896, DM = 1024;
constexpr int N0 = 4352, N1 = 4096;
constexpr int LKV = 8448;
constexpr int NCHUNK = 32, LCH = 264, NSUB = 33;

constexpr size_t MiB = 1048576;
constexpr size_t OFF_WT_IN0 = 0;
constexpr size_t OFF_WT_OUT0 = 8912896;
constexpr size_t OFF_WT_IN1 = 11010048;
constexpr size_t OFF_WT_OUT1 = 19398656;
constexpr size_t OFF_W2T = 21495808;
constexpr size_t OFF_A2T = 21757952;
constexpr size_t OFF_MOD = 21 * MiB;
constexpr size_t OFF_ROPE = OFF_MOD + 73728;
constexpr size_t OFF_BONUS = 21 * MiB + 131072;
constexpr size_t OFF_XC1 = 24 * MiB;
constexpr size_t OFF_OCTX = 26 * MiB;
constexpr size_t OFF_BAR = 29 * MiB;
constexpr size_t OFF_PROJ = 30 * MiB;
constexpr size_t OFF_HB = 171 * MiB;
constexpr size_t OFF_STP = 171 * MiB;
constexpr size_t OFF_STS = 203 * MiB;
constexpr size_t OFF_RAW = 30 * MiB;
constexpr size_t OFF_VT = 96 * MiB;
constexpr size_t OFF_KS = 129 * MiB;
constexpr size_t OFF_GB = 204 * MiB;
constexpr size_t OFF_QS = OFF_HB;
constexpr size_t OFF_Y2 = OFF_RAW;

constexpr int LDS_BYTES = 78336;

struct Params {
  const float *x, *c, *ctx, *c_ctx, *ada_w, *ada_b, *norm_g, *rw_in, *rw_mu, *rw_w0, *rw_w2, *rw_a0, *rw_a2,
      *rw_kk, *rw_ka, *rw_rk, *rw_gn_g, *rw_gn_b, *rw_out, *da_in, *da_qn, *da_kn, *da_lam, *da_subln, *da_out;
  float* out;
  char* ws;
};

DI u16 f2bf(float x) { unsigned u = __float_as_uint(x); u += 0x7fffu + ((u >> 16) & 1u); return (u16)(u >> 16); }
DI float bf2f(u16 h) { return __uint_as_float(((unsigned)h) << 16); }
DI unsigned pack2(float a, float b) { return (unsigned)f2bf(a) | ((unsigned)f2bf(b) << 16); }
typedef __bf16 bf16v2 __attribute__((ext_vector_type(2)));
DI unsigned cvtpk(float a, float b) { f2 v = {a, b}; return __builtin_bit_cast(unsigned, __builtin_convertvector(v, bf16v2)); }
DI float fsig(float x) { return __builtin_amdgcn_rcpf(1.0f + __expf(-x)); }
DI int ltid() { int t = threadIdx.x; asm volatile("" : "+v"(t)); return t; }
DI float bflo(unsigned u) { return __uint_as_float(u << 16); }
DI float bfhi(unsigned u) { return __uint_as_float(u & 0xffff0000u); }
DI float sigmoidf_(float x) { return 1.0f / (1.0f + __expf(-x)); }
DI float siluf_(float x) { return x * sigmoidf_(x); }
DI int crow(int i, int h) { return (i & 3) + 8 * (i >> 2) + 4 * h; }
DI void unpack8(const u32x4& u, float* f) {
  f[0] = bflo(u[0]); f[1] = bfhi(u[0]); f[2] = bflo(u[1]); f[3] = bfhi(u[1]);
  f[4] = bflo(u[2]); f[5] = bfhi(u[2]); f[6] = bflo(u[3]); f[7] = bfhi(u[3]);
}
#define WAVE_LDS_SYNC() asm volatile("s_waitcnt lgkmcnt(0)" ::: "memory")
#define MFMA32(a, b, c) __builtin_amdgcn_mfma_f32_32x32x16_bf16((a), (b), (c), 0, 0, 0)
#define MFMA16(a, b, c) __builtin_amdgcn_mfma_f32_16x16x32_bf16((a), (b), (c), 0, 0, 0)

__device__ const float INV_FREQ[16] = {
    1.0f, 0.5623413251903491f, 0.31622776601683794f, 0.1778279410038923f, 0.1f, 0.05623413251903491f,
    0.03162277660168379f, 0.01778279410038923f, 0.01f, 0.005623413251903491f, 0.0031622776601683794f,
    0.001778279410038923f, 0.001f, 0.0005623413251903491f, 0.00031622776601683794f, 0.0001778279410038923f};

DI void transpose_tile(const float* __restrict__ src, u16* __restrict__ dst, int K, int N, int kt, int nt, float* tile) {
  const int TIDX = ltid();
  const int tid = TIDX;
  {
    const int n = tid & 63, k0 = tid >> 6;
#pragma unroll
    for (int i = 0; i < 16; ++i) {
      const int k = k0 + 4 * i;
      tile[k * 65 + n] = src[(size_t)(kt * 64 + k) * N + nt * 64 + n];
    }
  }
  __syncthreads();
  {
    const int n = tid >> 2, kq = tid & 3;
    unsigned pk[8];
#pragma unroll
    for (int j = 0; j < 8; ++j) pk[j] = pack2(tile[(kq * 16 + 2 * j) * 65 + n], tile[(kq * 16 + 2 * j + 1) * 65 + n]);
    u32x4* d = (u32x4*)(dst + (size_t)(nt * 64 + n) * K + kt * 64 + kq * 16);
    d[0] = u32x4{pk[0], pk[1], pk[2], pk[3]};
    d[1] = u32x4{pk[4], pk[5], pk[6], pk[7]};
  }
  __syncthreads();
}

DI void phase_prep(const Params& p, char* smem) {
  const int TIDX = ltid();
  float* tile = (float*)smem;
  const int tid = TIDX;
  constexpr int T_IN0 = 16 * 68, T_OUT = 256, T_IN1 = 16 * 64, T_LORA = 16;
  constexpr int E0 = T_IN0, E1 = E0 + T_OUT, E2 = E1 + T_IN1, E3 = E2 + T_OUT, E4 = E3 + 2 * T_LORA, E5 = E4 + 2 * T_LORA;
  constexpr int NMOD = 192;
  constexpr int TOTAL = E5 + NMOD + 1;
  for (int it = blockIdx.x; it < TOTAL; it += gridDim.x) {
    if (it < E0) { transpose_tile(p.rw_in, (u16*)(p.ws + OFF_WT_IN0), 1024, N0, it / 68, it % 68, tile); }
    else if (it < E1) { int j = it - E0; transpose_tile(p.rw_out, (u16*)(p.ws + OFF_WT_OUT0), 1024, 1024, j >> 4, j & 15, tile); }
    else if (it < E2) { int j = it - E1; transpose_tile(p.da_in, (u16*)(p.ws + OFF_WT_IN1), 1024, N1, j >> 6, j & 63, tile); }
    else if (it < E3) { int j = it - E2; transpose_tile(p.da_out, (u16*)(p.ws + OFF_WT_OUT1), 1024, 1024, j >> 4, j & 15, tile); }
    else if (it < E4) { int j = it - E3; int d = j >> 4; transpose_tile(p.rw_w2 + (size_t)d * 65536, (u16*)(p.ws + OFF_W2T) + (size_t)d * 65536, 64, 1024, 0, j & 15, tile); }
    else if (it < E5) { int j = it - E4; int d = j >> 4; transpose_tile(p.rw_a2 + (size_t)d * 65536, (u16*)(p.ws + OFF_A2T) + (size_t)d * 65536, 64, 1024, 0, j & 15, tile); }
    else if (it < E5 + NMOD) {
      const int j = it - E5; const int layer = j / 96; const int nb = (j % 96) * 32;
      const int n = nb + (tid & 31), kg = tid >> 5;
      const float* W = p.ada_w + (size_t)layer * 1024 * 3072;
      float a0 = 0.f, a1 = 0.f, a2 = 0.f;
#pragma unroll 8
      for (int k = kg * 128; k < kg * 128 + 128; ++k) {
        const float w = W[(size_t)k * 3072 + n];
        a0 += siluf_(p.c[k]) * w; a1 += siluf_(p.c[1024 + k]) * w; a2 += siluf_(p.c_ctx[k]) * w;
      }
      tile[(kg * 3 + 0) * 32 + (tid & 31)] = a0; tile[(kg * 3 + 1) * 32 + (tid & 31)] = a1; tile[(kg * 3 + 2) * 32 + (tid & 31)] = a2;
      __syncthreads();
      if (tid < 96) {
        const int s = tid >> 5, nn = tid & 31;
        float acc = p.ada_b[layer * 3072 + nb + nn];
#pragma unroll
        for (int g = 0; g < 8; ++g) acc += tile[(g * 3 + s) * 32 + nn];
        ((float*)(p.ws + OFF_MOD))[(layer * 3 + s) * 3072 + nb + nn] = acc;
      }
      __syncthreads();
    } else {
      float* rope = (float*)(p.ws + OFF_ROPE);
      for (int e = tid; e < 2048; e += 256) {
        const int pos = e >> 4, f = e & 15;
        const float ang = (float)pos * INV_FREQ[f];
        const float rev = ang * 0.15915494309189535f;
        const float fr = rev - rintf(rev);
        const float a = fr * 6.283185307179586f;
        rope[e] = __cosf(a); rope[2048 + e] = __sinf(a);
      }
    }
  }
}

DI void phase_normmod(const Params& p, int layer, const float* __restrict__ xl, const float* __restrict__ xc, bool zero_o) {
  const int TIDX = ltid();
  const int lane = TIDX & 63, wv = __builtin_amdgcn_readfirstlane(TIDX >> 6);
  const float* mod = (const float*)(p.ws + OFF_MOD) + layer * 3 * 3072;
  const float* g = p.norm_g + layer * 1024;
  u16* hb = (u16*)(p.ws + OFF_HB);
  for (int row = blockIdx.x * 4 + wv; row < T_ALL; row += gridDim.x * 4) {
    const float* src; const float* m;
    if (row < T_LAT) { src = xl + (size_t)row * 1024; m = mod + (row >> 13) * 3072; }
    else { src = xc + (size_t)(row - T_LAT) * 1024; m = mod + 2 * 3072; }
    float v[16];
    float ss = 0.f;
#pragma unroll
    for (int q = 0; q < 4; ++q) {
      const f32x4 t = *(const f32x4*)(src + lane * 16 + q * 4);
      v[q * 4] = t[0]; v[q * 4 + 1] = t[1]; v[q * 4 + 2] = t[2]; v[q * 4 + 3] = t[3];
      ss += t[0] * t[0] + t[1] * t[1] + t[2] * t[2] + t[3] * t[3];
    }
#pragma unroll
    for (int o = 32; o >= 1; o >>= 1) ss += __shfl_xor(ss, o);
    const float rstd = rsqrtf(ss * (1.0f / 1024.0f) + 1e-6f);
    unsigned pk[8];
#pragma unroll
    for (int j = 0; j < 8; ++j) {
      const int c0 = lane * 16 + 2 * j;
      const float h0 = v[2 * j] * rstd * g[c0] * (1.0f + m[1024 + c0]) + m[c0];
      const float h1 = v[2 * j + 1] * rstd * g[c0 + 1] * (1.0f + m[1024 + c0 + 1]) + m[c0 + 1];
      pk[j] = pack2(h0, h1);
    }
    u32x4* d = (u32x4*)(hb + (size_t)row * 1024 + lane * 16);
    d[0] = u32x4{pk[0], pk[1], pk[2], pk[3]};
    d[1] = u32x4{pk[4], pk[5], pk[6], pk[7]};
    if (zero_o) {
      float* o = (row < T_LAT) ? (p.out + (size_t)row * 1024) : ((float*)(p.ws + OFF_OCTX) + (size_t)(row - T_LAT) * 1024);
      const f32x4 z = {0.f, 0.f, 0.f, 0.f};
#pragma unroll
      for (int q = 0; q < 4; ++q) *(f32x4*)(o + lane * 16 + q * 4) = z;
    }
  }
}

constexpr int LDT = 72;
#ifndef REP_GEMM
#define REP_GEMM 1
#endif
#ifndef REP_SCAN
#define REP_SCAN 1
#endif
#ifndef REP_ATTN
#define REP_ATTN 1
#endif
template <int EPI>
DI void phase_gemm(const Params& p, char* smem, const u16* __restrict__ A, const u16* __restrict__ Bt, int Mtiles, int Ntiles, int Mbase = 0) {
  const int TIDX = ltid();
  u16* As0 = (u16*)smem;
  const int tid = TIDX, lane = tid & 63, wv = __builtin_amdgcn_readfirstlane(tid >> 6);
  const int r = lane & 31, h = lane >> 5;
  const int wm = wv >> 1, wn = wv & 1;
  const int ntiles = Mtiles * Ntiles;
  const int npad = (ntiles + 511) & ~511;
  int repg = (EPI == 0 || EPI == 2) ? REP_GEMM : 1; asm volatile("" : "+s"(repg));
  for (int rp = 0; rp < repg; ++rp)
  for (int tt = blockIdx.x; tt < npad; tt += gridDim.x) {
    const int tile = (tt & ~511) + ((tt & 7) << 6) + ((tt >> 3) & 63);
    if (tile >= ntiles) continue;
    const int band = tile / (4 * Ntiles), rem = tile % (4 * Ntiles);
    const int mt_ = band * 4 + (rem & 3), nt_ = rem >> 2;
    const int m0 = (Mbase + mt_) * 128, n0 = nt_ * 128;
    f32x16 acc[2][2];
#pragma unroll
    for (int a = 0; a < 2; ++a)
#pragma unroll
      for (int b = 0; b < 2; ++b)
#pragma unroll
        for (int i = 0; i < 16; ++i) acc[a][b][i] = 0.f;
    u32x4 ra[4], rb[4];
    const u16* Ag = A + (size_t)m0 * 1024;
    const u16* Bg = Bt + (size_t)n0 * 1024;
#pragma unroll
    for (int i = 0; i < 4; ++i) {
      const int id = tid + 256 * i; const int row = id >> 3, cc = id & 7;
      ra[i] = *(const u32x4*)(Ag + (size_t)row * 1024 + cc * 8);
      rb[i] = *(const u32x4*)(Bg + (size_t)row * 1024 + cc * 8);
    }
    __syncthreads();
    for (int kt = 0; kt < 16; ++kt) {
      u16* As = As0 + (kt & 1) * (256 * LDT);
      u16* Bs = As + 128 * LDT;
#pragma unroll
      for (int i = 0; i < 4; ++i) {
        const int id = tid + 256 * i; const int row = id >> 3, cc = id & 7;
        *(u32x4*)(As + row * LDT + cc * 8) = ra[i];
        *(u32x4*)(Bs + row * LDT + cc * 8) = rb[i];
      }
      __syncthreads();
      if (kt + 1 < 16) {
#pragma unroll
        for (int i = 0; i < 4; ++i) {
          const int id = tid + 256 * i; const int row = id >> 3, cc = id & 7;
          ra[i] = *(const u32x4*)(Ag + (size_t)row * 1024 + (kt + 1) * 64 + cc * 8);
          rb[i] = *(const u32x4*)(Bg + (size_t)row * 1024 + (kt + 1) * 64 + cc * 8);
        }
      }
#pragma unroll
      for (int ks = 0; ks < 4; ++ks) {
        bf16x8 fa[2], fb[2];
#pragma unroll
        for (int t = 0; t < 2; ++t) {
          fa[t] = *(const bf16x8*)(As + (wm * 64 + t * 32 + r) * LDT + ks * 16 + 8 * h);
          fb[t] = *(const bf16x8*)(Bs + (wn * 64 + t * 32 + r) * LDT + ks * 16 + 8 * h);
        }
#pragma unroll
        for (int a = 0; a < 2; ++a)
#pragma unroll
          for (int b = 0; b < 2; ++b) acc[a][b] = MFMA32(fa[a], fb[b], acc[a][b]);
      }
    }
#pragma unroll
    for (int a = 0; a < 2; ++a)
#pragma unroll
      for (int b = 0; b < 2; ++b) {
        const int col = n0 + wn * 64 + b * 32 + r;
        const int rbase = m0 + wm * 64 + a * 32;
        if (EPI == 0) {
          u16* C = (u16*)(p.ws + OFF_PROJ);
#pragma unroll
          for (int i = 0; i < 16; ++i) C[(size_t)(rbase + crow(i, h)) * N0 + col] = f2bf(acc[a][b][i]);
        } else if (EPI == 1) {
          const float* mod = (const float*)(p.ws + OFF_MOD);
#pragma unroll
          for (int i = 0; i < 16; ++i) {
            const int row = rbase + crow(i, h);
            if (row < T_LAT) {
              const float gate = mod[(row >> 13) * 3072 + 2048 + col];
              p.out[(size_t)row * 1024 + col] = p.x[(size_t)row * 1024 + col] + gate * acc[a][b][i];
            } else {
              const int rc = row - T_LAT;
              const float gate = mod[2 * 3072 + 2048 + col];
              ((float*)(p.ws + OFF_XC1))[(size_t)rc * 1024 + col] = p.ctx[(size_t)rc * 1024 + col] + gate * acc[a][b][i];
            }
          }
        } else if (EPI == 2) {
          if (n0 < 2048) {
            u16* C = (u16*)(p.ws + OFF_RAW);
#pragma unroll
            for (int i = 0; i < 16; ++i) C[(size_t)(rbase + crow(i, h)) * 2048 + col] = f2bf(acc[a][b][i]);
          } else if (n0 < 3072) {
            u16* Vt = (u16*)(p.ws + OFF_VT);
            const int e = col - 2048;
#pragma unroll
            for (int g = 0; g < 4; ++g) {
              const int row = rbase + 8 * g + 4 * h;
              int bb, pp;
              if (row < T_LAT) { bb = row >> 13; pp = 256 + (row & 8191); } else { bb = (row - T_LAT) >> 8; pp = (row - T_LAT) & 255; }
              u32x2 v = {cvtpk(acc[a][b][4 * g], acc[a][b][4 * g + 1]), cvtpk(acc[a][b][4 * g + 2], acc[a][b][4 * g + 3])};
              const int q4 = (pp >> 2) & 3;
              const int pq = (pp & ~15) | ((((q4 & 1) << 1) | (q4 >> 1)) << 2);
              *(u32x2*)(Vt + ((size_t)bb * 1024 + e) * LKV + pq) = v;
            }
          } else {
            u16* G = (u16*)(p.ws + OFF_GB);
#pragma unroll
            for (int i = 0; i < 16; ++i) {
              const int row = rbase + crow(i, h);
              if (row < T_LAT) G[(size_t)row * 1024 + col - 3072] = f2bf(siluf_(acc[a][b][i]));
            }
          }
        } else {
          const float* mod = (const float*)(p.ws + OFF_MOD) + 3 * 3072;
#pragma unroll
          for (int i = 0; i < 16; ++i) {
            const int row = rbase + crow(i, h);
            const float gate = mod[(row >> 13) * 3072 + 2048 + col];
            float* o = p.out + (size_t)row * 1024 + col;
            *o = *o + gate * acc[a][b][i];
          }
        }
      }
  }
}

template <int EPI>
DI void phase_gemm_wide(const Params& p, char* smem, const u16* __restrict__ A, const u16* __restrict__ Bt, int Mtiles, int Ntiles, int Mbase = 0) {
  const int TIDX = ltid();
  u16* As = (u16*)smem;
  u16* Bs = As + 128 * LDT;
  const int tid = TIDX, lane = tid & 63, wv = __builtin_amdgcn_readfirstlane(tid >> 6);
  const int r = lane & 31, h = lane >> 5;
  const int wm = wv >> 1, wn = wv & 1;
  const int ntiles = Mtiles * Ntiles;
  const int npad = (ntiles + 511) & ~511;
  int repg = (EPI == 0 || EPI == 2) ? REP_GEMM : 1; asm volatile("" : "+s"(repg));
  for (int rp = 0; rp < repg; ++rp)
  for (int tt = blockIdx.x; tt < npad; tt += gridDim.x) {
    const int tile = (tt & ~511) + ((tt & 7) << 6) + ((tt >> 3) & 63);
    if (tile >= ntiles) continue;
    const int band = tile / (4 * Ntiles), rem = tile % (4 * Ntiles);
    const int mt_ = band * 4 + (rem & 3), nt_ = rem >> 2;
    const int m0 = (Mbase + mt_) * 128, n0 = nt_ * 256;
    f32x16 acc[2][4];
#pragma unroll
    for (int a = 0; a < 2; ++a)
#pragma unroll
      for (int b = 0; b < 4; ++b)
#pragma unroll
        for (int i = 0; i < 16; ++i) acc[a][b][i] = 0.f;
    u32x4 ra[4], rb[8];
    const u16* Ag = A + (size_t)m0 * 1024;
    const u16* Bg = Bt + (size_t)n0 * 1024;
#pragma unroll
    for (int i = 0; i < 8; ++i) {
      const int id = tid + 256 * i; const int row = id >> 3, cc = id & 7;
      if (i < 4) ra[i] = *(const u32x4*)(Ag + (size_t)row * 1024 + cc * 8);
      rb[i] = *(const u32x4*)(Bg + (size_t)row * 1024 + cc * 8);
    }
    for (int kt = 0; kt < 16; ++kt) {
      __syncthreads();
      int ts = tid; asm volatile("" : "+v"(ts));
#pragma unroll
      for (int i = 0; i < 8; ++i) {
        const int id = ts + 256 * i; const int row = id >> 3, cc = id & 7;
        if (i < 4) *(u32x4*)(As + row * LDT + cc * 8) = ra[i];
        *(u32x4*)(Bs + row * LDT + cc * 8) = rb[i];
      }
      __syncthreads();
      if (kt + 1 < 16) {
        int tl = tid; asm volatile("" : "+v"(tl));
#pragma unroll
        for (int i = 0; i < 8; ++i) {
          const int id = tl + 256 * i; const int row = id >> 3, cc = id & 7;
          if (i < 4) ra[i] = *(const u32x4*)(Ag + (size_t)row * 1024 + (kt + 1) * 64 + cc * 8);
          rb[i] = *(const u32x4*)(Bg + (size_t)row * 1024 + (kt + 1) * 64 + cc * 8);
        }
      }
#pragma unroll
      for (int ks = 0; ks < 4; ++ks) {
        bf16x8 fa[2], fb[4];
#pragma unroll
        for (int t = 0; t < 2; ++t) fa[t] = *(const bf16x8*)(As + (wm * 64 + t * 32 + r) * LDT + ks * 16 + 8 * h);
#pragma unroll
        for (int t = 0; t < 4; ++t) fb[t] = *(const bf16x8*)(Bs + (wn * 128 + t * 32 + r) * LDT + ks * 16 + 8 * h);
#pragma unroll
        for (int a = 0; a < 2; ++a)
#pragma unroll
          for (int b = 0; b < 4; ++b) acc[a][b] = MFMA32(fa[a], fb[b], acc[a][b]);
      }
    }
#pragma unroll
    for (int a = 0; a < 2; ++a)
#pragma unroll
      for (int b = 0; b < 4; ++b) {
        const int col = n0 + wn * 128 + b * 32 + r;
        const int rbase = m0 + wm * 64 + a * 32;
        if (EPI == 0) {
          u16* C = (u16*)(p.ws + OFF_PROJ);
#pragma unroll
          for (int i = 0; i < 16; ++i) C[(size_t)(rbase + crow(i, h)) * N0 + col] = f2bf(acc[a][b][i]);
        } else if (EPI == 1) {
          const float* mod = (const float*)(p.ws + OFF_MOD);
#pragma unroll
          for (int i = 0; i < 16; ++i) {
            const int row = rbase + crow(i, h);
            if (row < T_LAT) {
              const float gate = mod[(row >> 13) * 3072 + 2048 + col];
              p.out[(size_t)row * 1024 + col] = p.x[(size_t)row * 1024 + col] + gate * acc[a][b][i];
            } else {
              const int rc = row - T_LAT;
              const float gate = mod[2 * 3072 + 2048 + col];
              ((float*)(p.ws + OFF_XC1))[(size_t)rc * 1024 + col] = p.ctx[(size_t)rc * 1024 + col] + gate * acc[a][b][i];
            }
          }
        } else if (EPI == 2) {
          if (n0 < 2048) {
            u16* C = (u16*)(p.ws + OFF_RAW);
#pragma unroll
            for (int i = 0; i < 16; ++i) C[(size_t)(rbase + crow(i, h)) * 2048 + col] = f2bf(acc[a][b][i]);
          } else if (n0 < 3072) {
            u16* Vt = (u16*)(p.ws + OFF_VT);
            const int e = col - 2048;
#pragma unroll
            for (int g = 0; g < 4; ++g) {
              const int row = rbase + 8 * g + 4 * h;
              int bb, pp;
              if (row < T_LAT) { bb = row >> 13; pp = 256 + (row & 8191); } else { bb = (row - T_LAT) >> 8; pp = (row - T_LAT) & 255; }
              u32x2 v = {cvtpk(acc[a][b][4 * g], acc[a][b][4 * g + 1]), cvtpk(acc[a][b][4 * g + 2], acc[a][b][4 * g + 3])};
              const int q4 = (pp >> 2) & 3;
              const int pq = (pp & ~15) | ((((q4 & 1) << 1) | (q4 >> 1)) << 2);
              *(u32x2*)(Vt + ((size_t)bb * 1024 + e) * LKV + pq) = v;
            }
          } else {
            u16* G = (u16*)(p.ws + OFF_GB);
#pragma unroll
            for (int i = 0; i < 16; ++i) {
              const int row = rbase + crow(i, h);
              if (row < T_LAT) G[(size_t)row * 1024 + col - 3072] = f2bf(siluf_(acc[a][b][i]));
            }
          }
        } else {
          const float* mod = (const float*)(p.ws + OFF_MOD) + 3 * 3072;
#pragma unroll
          for (int i = 0; i < 16; ++i) {
            const int row = rbase + crow(i, h);
            const float gate = mod[(row >> 13) * 3072 + 2048 + col];
            float* o = p.out + (size_t)row * 1024 + col;
            *o = *o + gate * acc[a][b][i];
          }
        }
      }
  }
}

constexpr int LDW = 80;
template <int EPI>
DI void phase_gemm_wide16(const Params& p, char* smem, const u16* __restrict__ A, const u16* __restrict__ Bt, int Mtiles, int Ntiles, int Mbase = 0) {
  const int TIDX = ltid();
  u16* As = (u16*)smem;
  u16* Bs = As + 128 * LDW;
  const int tid = TIDX, lane = tid & 63, wv = __builtin_amdgcn_readfirstlane(tid >> 6);
  const int lr = lane & 15, lq = lane >> 4;
  const int wm = wv >> 1, wn = wv & 1;
  const int ntiles = Mtiles * Ntiles;
  const int npad = (ntiles + 511) & ~511;
  for (int tt = blockIdx.x; tt < npad; tt += gridDim.x) {
    const int tile = (tt & ~511) + ((tt & 7) << 6) + ((tt >> 3) & 63);
    if (tile >= ntiles) continue;
    const int band = tile / (4 * Ntiles), rem = tile % (4 * Ntiles);
    const int mt_ = band * 4 + (rem & 3), nt_ = rem >> 2;
    const int m0 = (Mbase + mt_) * 128, n0 = nt_ * 256;
    f32x4 acc[4][8];
#pragma unroll
    for (int t = 0; t < 4; ++t)
#pragma unroll
      for (int u = 0; u < 8; ++u) acc[t][u] = f32x4{0.f, 0.f, 0.f, 0.f};
    u32x4 ra[4], rb[8];
    const u16* Ag = A + (size_t)m0 * 1024;
    const u16* Bg = Bt + (size_t)n0 * 1024;
#pragma unroll
    for (int i = 0; i < 8; ++i) {
      const int id = tid + 256 * i; const int row = id >> 3, cc = id & 7;
      if (i < 4) ra[i] = *(const u32x4*)(Ag + (size_t)row * 1024 + cc * 8);
      rb[i] = *(const u32x4*)(Bg + (size_t)row * 1024 + cc * 8);
    }
    for (int kt = 0; kt < 16; ++kt) {
      __syncthreads();
      int ts = tid; asm volatile("" : "+v"(ts));
#pragma unroll
      for (int i = 0; i < 8; ++i) {
        const int id = ts + 256 * i; const int row = id >> 3, cc = id & 7;
        if (i < 4) *(u32x4*)(As + row * LDW + cc * 8) = ra[i];
        *(u32x4*)(Bs + row * LDW + cc * 8) = rb[i];
      }
      __syncthreads();
      if (kt + 1 < 16) {
        int tl = tid; asm volatile("" : "+v"(tl));
#pragma unroll
        for (int i = 0; i < 8; ++i) {
          const int id = tl + 256 * i; const int row = id >> 3, cc = id & 7;
          if (i < 4) ra[i] = *(const u32x4*)(Ag + (size_t)row * 1024 + (kt + 1) * 64 + cc * 8);
          rb[i] = *(const u32x4*)(Bg + (size_t)row * 1024 + (kt + 1) * 64 + cc * 8);
        }
      }
#pragma unroll
      for (int ks = 0; ks < 2; ++ks) {
        bf16x8 fa[4], fb[8];
#pragma unroll
        for (int t = 0; t < 4; ++t) fa[t] = *(const bf16x8*)(As + (wm * 64 + t * 16 + lr) * LDW + ks * 32 + lq * 8);
#pragma unroll
        for (int u = 0; u < 8; ++u) fb[u] = *(const bf16x8*)(Bs + (wn * 128 + u * 16 + lr) * LDW + ks * 32 + lq * 8);
#pragma unroll
        for (int t = 0; t < 4; ++t)
#pragma unroll
          for (int u = 0; u < 8; ++u) acc[t][u] = MFMA16(fa[t], fb[u], acc[t][u]);
      }
    }
#pragma unroll
    for (int t = 0; t < 4; ++t)
#pragma unroll
      for (int u = 0; u < 8; ++u) {
        const int col = n0 + wn * 128 + u * 16 + lr;
        const int row0 = m0 + wm * 64 + t * 16 + 4 * lq;
        if (EPI == 0) {
          u16* C = (u16*)(p.ws + OFF_PROJ);
#pragma unroll
          for (int g = 0; g < 4; ++g) C[(size_t)(row0 + g) * N0 + col] = f2bf(acc[t][u][g]);
        } else if (EPI == 1) {
          const float* mod = (const float*)(p.ws + OFF_MOD);
#pragma unroll
          for (int g = 0; g < 4; ++g) {
            const int row = row0 + g;
            if (row < T_LAT) {
              const float gate = mod[(row >> 13) * 3072 + 2048 + col];
              p.out[(size_t)row * 1024 + col] = p.x[(size_t)row * 1024 + col] + gate * acc[t][u][g];
            } else {
              const int rc = row - T_LAT;
              const float gate = mod[2 * 3072 + 2048 + col];
              ((float*)(p.ws + OFF_XC1))[(size_t)rc * 1024 + col] = p.ctx[(size_t)rc * 1024 + col] + gate * acc[t][u][g];
            }
          }
        } else if (EPI == 3) {
          const float* mod = (const float*)(p.ws + OFF_MOD) + 3 * 3072;
#pragma unroll
          for (int g = 0; g < 4; ++g) {
            const int row = row0 + g;
            const float gate = mod[(row >> 13) * 3072 + 2048 + col];
            float* o = p.out + (size_t)row * 1024 + col;
            *o = *o + gate * acc[t][u][g];
          }
        } else {
          if (n0 < 2048) {
            u16* C = (u16*)(p.ws + OFF_RAW);
#pragma unroll
            for (int g = 0; g < 4; ++g) C[(size_t)(row0 + g) * 2048 + col] = f2bf(acc[t][u][g]);
          } else if (n0 < 3072) {
            u16* Vt = (u16*)(p.ws + OFF_VT);
            const int e = col - 2048;
            int bb, pp;
            if (row0 < T_LAT) { bb = row0 >> 13; pp = 256 + (row0 & 8191); } else { bb = (row0 - T_LAT) >> 8; pp = (row0 - T_LAT) & 255; }
            u32x2 v = {cvtpk(acc[t][u][0], acc[t][u][1]), cvtpk(acc[t][u][2], acc[t][u][3])};
            const int q4 = (pp >> 2) & 3;
            const int pq = (pp & ~15) | ((((q4 & 1) << 1) | (q4 >> 1)) << 2);
            *(u32x2*)(Vt + ((size_t)bb * 1024 + e) * LKV + pq) = v;
          } else {
            u16* G = (u16*)(p.ws + OFF_GB);
#pragma unroll
            for (int g = 0; g < 4; ++g)
              if (row0 + g < T_LAT) G[(size_t)(row0 + g) * 1024 + col - 3072] = f2bf(siluf_(acc[t][u][g]));
          }
        }
      }
  }
}

DI void tokmap(int pos, int d, int b, int& row, bool& hp, bool& hn) {
  if (pos < 256) { const int t = d ? 255 - pos : pos; row = T_LAT + b * 256 + t; hp = t > 0; hn = t < 255; }
  else { const int q = pos - 256; const int t = d ? 8191 - q : q; row = b * 8192 + t; hp = t > 0; hn = t < 8191; }
}

DI void load_mix8(const u16* pr, bool hp, bool hn, const float* mu, float* out) {
  const u32x4 uc = *(const u32x4*)pr;
  u32x4 up = {0u, 0u, 0u, 0u}, un = {0u, 0u, 0u, 0u};
  if (hp) up = *(const u32x4*)(pr - N0);
  if (hn) un = *(const u32x4*)(pr + N0);
  float c[8], a[8], n[8];
  unpack8(uc, c); unpack8(up, a); unpack8(un, n);
  const f32x4 m0 = *(const f32x4*)mu, m1 = *(const f32x4*)(mu + 4);
#pragma unroll
  for (int j = 0; j < 8; ++j) {
    const float m = j < 4 ? m0[j & 3] : m1[j & 3];
    out[j] = c[j] + m * (0.5f * (a[j] + n[j]) - c[j]);
  }
}

DI void mixraw8(const u32x4& uc, const u32x4& up, const u32x4& un, bool hp, bool hn, const float* mu, float* out) {
  float c[8], a[8], n[8];
  unpack8(uc, c); unpack8(up, a); unpack8(un, n);
  const f32x4 m0 = *(const f32x4*)mu, m1 = *(const f32x4*)(mu + 4);
#pragma unroll
  for (int j = 0; j < 8; ++j) {
    const float m = j < 4 ? m0[j & 3] : m1[j & 3];
    const float av = hp ? a[j] : 0.f, nv = hn ? n[j] : 0.f;
    out[j] = c[j] + m * (0.5f * (av + nv) - c[j]);
  }
}

template <int PASS>
DI void phase_scan(const Params& p, char* smem) {
  const int TIDX = ltid();
  const int lane = TIDX & 63, wv = __builtin_amdgcn_readfirstlane(TIDX >> 6);
  float* sm = (float*)smem + wv * 3584;
  float* sW = sm; float* sKK = sm + 512; float* sKKA = sm + 1024; float* sKD = sm + 1536; float* sR = sm + 2048; float* sV = sm + 2560; float* sA = sm + 3072;
  const u16* proj = (const u16*)(p.ws + OFF_PROJ);
  float* stP = (float*)(p.ws + OFF_STP);
  float* stS = (float*)(p.ws + OFF_STS);
  float* bonus = (float*)(p.ws + OFF_BONUS);
  const int nwaves = gridDim.x * 4;
  int reps = (PASS == 1) ? REP_SCAN : 1; asm volatile("" : "+s"(reps));
  for (int rp = 0; rp < reps; ++rp)
  for (int item = blockIdx.x * 4 + wv; item < 2048; item += nwaves) {
    const int chain = item >> 5, chunk = item & 31;
    const int d = chain & 1, hh = (chain >> 1) & 15, b = chain >> 5;
    u16* cB = (u16*)(smem + 57344);
    float* cP = (float*)(smem + 57344 + 18432);
    __syncthreads();
    {
      const int tid = TIDX;
#pragma unroll
      for (int i = 0; i < 4; ++i) {
        const int id = tid + 256 * i;
        const int which = id >> 9, row = (id >> 3) & 63, cc = id & 7;
        const u16* src = (const u16*)(p.ws + (which ? OFF_A2T : OFF_W2T)) + ((size_t)d * 1024 + hh * 64 + row) * 64 + cc * 8;
        *(u32x4*)(cB + (which * 64 + row) * 72 + cc * 8) = *(const u32x4*)src;
      }
      if (tid < 160) {
        const int a = tid >> 4, q = (tid & 15) * 4;
        const float* src;
        switch (a) {
          case 0: src = p.rw_mu + 3072 + d * 64; break;
          case 1: src = p.rw_mu + 3072 + 128 + d * 64; break;
          case 2: src = p.rw_mu + hh * 64; break;
          case 3: src = p.rw_mu + 1024 + hh * 64; break;
          case 4: src = p.rw_mu + 2048 + hh * 64; break;
          case 5: src = p.rw_w0 + d * 1024 + hh * 64; break;
          case 6: src = p.rw_a0 + d * 1024 + hh * 64; break;
          case 7: src = p.rw_kk + hh * 64; break;
          case 8: src = p.rw_ka + hh * 64; break;
          default: src = p.rw_rk + hh * 64; break;
        }
        *(f32x4*)(cP + a * 64 + q) = *(const f32x4*)(src + q);
      }
    }
    __syncthreads();
    if (PASS == 1 && chunk == 31) continue;
    f32x16 S[2][2];
    f32x32 P[2];
    {
      int li = lane; asm volatile("" : "+v"(li));
      const int lv = li & 31, lh = li >> 5;
      if (PASS == 1) {
#pragma unroll
        for (int kt = 0; kt < 2; ++kt)
#pragma unroll
          for (int vt = 0; vt < 2; ++vt)
#pragma unroll
            for (int i = 0; i < 16; ++i) {
              S[kt][vt][i] = 0.f;
              P[vt][16 * kt + i] = (32 * kt + (i & 3) + 8 * (i >> 2) + 4 * lh == 32 * vt + lv) ? 1.f : 0.f;
            }
      } else {
        if (chunk == 0) {
#pragma unroll
          for (int kt = 0; kt < 2; ++kt)
#pragma unroll
            for (int vt = 0; vt < 2; ++vt)
#pragma unroll
              for (int i = 0; i < 16; ++i) S[kt][vt][i] = 0.f;
        } else {
          const float* src = stS + (size_t)(item - 1) * 4096;
#pragma unroll
          for (int kt = 0; kt < 2; ++kt)
#pragma unroll
            for (int vt = 0; vt < 2; ++vt)
#pragma unroll
              for (int g = 0; g < 4; ++g) {
                const f32x4 t = *(const f32x4*)(src + (32 * vt + lv) * 64 + 32 * kt + 8 * g + 4 * lh);
                S[kt][vt][4 * g] = t[0]; S[kt][vt][4 * g + 1] = t[1]; S[kt][vt][4 * g + 2] = t[2]; S[kt][vt][4 * g + 3] = t[3];
              }
        }
      }
    }
    for (int sc = 0; sc < NSUB; ++sc) {
      const int p0 = chunk * LCH + sc * 8;
      int ln = lane; asm volatile("" : "+v"(ln));
      u32x4 rawA[2][3], rawB[3][3];
      bool hpA, hnA, hpB, hnB; int rowB;
      {
        int rowA; tokmap(p0 + (ln & 7), d, b, rowA, hpA, hnA);
        const u16* prA = proj + (size_t)rowA * N0 + 4096 + d * 64 + (ln >> 4) * 8 + ((ln >> 3) & 1) * 32;
        const ptrdiff_t dpA = hpA ? -N0 : 0, dnA = hnA ? N0 : 0;
#pragma unroll
        for (int X = 0; X < 2; ++X) {
          const u16* q = prA + X * 128;
          rawA[X][0] = *(const u32x4*)q; rawA[X][1] = *(const u32x4*)(q + dpA); rawA[X][2] = *(const u32x4*)(q + dnA);
        }
        tokmap(p0 + (ln >> 3), d, b, rowB, hpB, hnB);
        const u16* prB = proj + (size_t)rowB * N0 + hh * 64 + (ln & 7) * 8;
        const ptrdiff_t dpB = hpB ? -N0 : 0, dnB = hnB ? N0 : 0;
#pragma unroll
        for (int X = 0; X < 3; ++X) {
          const u16* q = prB + X * 1024;
          rawB[X][0] = *(const u32x4*)q; rawB[X][1] = *(const u32x4*)(q + dpB); rawB[X][2] = *(const u32x4*)(q + dnB);
        }
      }
      {
        const int m = ln & 15, kg = ln >> 4;
        bf16x8 fa[2][2];
        const int ssel = (m >> 3) & 1;
#pragma unroll
        for (int X = 0; X < 2; ++X) {
          float mx[8];
          mixraw8(rawA[X][0], rawA[X][1], rawA[X][2], hpA, hnA, cP + X * 64 + ssel * 32 + kg * 8, mx);
          if (X == 0) {
#pragma unroll
            for (int j = 0; j < 8; ++j) { const float e = __expf(2.0f * mx[j]); mx[j] = 1.0f - 2.0f * __builtin_amdgcn_rcpf(e + 1.0f); }
          }
          u32x4 own = {cvtpk(mx[0], mx[1]), cvtpk(mx[2], mx[3]), cvtpk(mx[4], mx[5]), cvtpk(mx[6], mx[7])};
          u32x4 oth;
#pragma unroll
          for (int q = 0; q < 4; ++q) oth[q] = (unsigned)__shfl_down((int)own[q], 8);
          fa[X][0] = __builtin_bit_cast(bf16x8, own);
          fa[X][1] = __builtin_bit_cast(bf16x8, ssel ? own : oth);
        }
#pragma unroll
        for (int nt = 0; nt < 4; ++nt) {
          f32x4 aw = {0.f, 0.f, 0.f, 0.f}, aa = {0.f, 0.f, 0.f, 0.f};
#pragma unroll
          for (int s = 0; s < 2; ++s) {
            const bf16x8 bw = *(const bf16x8*)(cB + (16 * nt + m) * 72 + s * 32 + kg * 8);
            const bf16x8 ba = *(const bf16x8*)(cB + (64 + 16 * nt + m) * 72 + s * 32 + kg * 8);
            aw = MFMA16(fa[0][s], bw, aw);
            aa = MFMA16(fa[1][s], ba, aa);
          }
          const int ch = 16 * nt + m;
          const float w0 = cP[5 * 64 + ch];
          const float a0 = cP[6 * 64 + ch];
          if (kg < 2) {
#pragma unroll
            for (int rg = 0; rg < 4; ++rg) {
              sW[(4 * kg + rg) * 64 + ch] = w0 + aw[rg];
              sA[(4 * kg + rg) * 64 + ch] = a0 + aa[rg];
            }
          }
        }
      }
      WAVE_LDS_SYNC();
      __builtin_amdgcn_sched_barrier(0);
      {
        const int tk = ln >> 3, g = ln & 7;
        const int row = rowB;
        const int cb = hh * 64 + g * 8;
        float rr[8], kk[8], vv[8];
        mixraw8(rawB[0][0], rawB[0][1], rawB[0][2], hpB, hnB, cP + 2 * 64 + g * 8, rr);
        mixraw8(rawB[1][0], rawB[1][1], rawB[1][2], hpB, hnB, cP + 3 * 64 + g * 8, kk);
        mixraw8(rawB[2][0], rawB[2][1], rawB[2][2], hpB, hnB, cP + 4 * 64 + g * 8, vv);
        float av[8], kkn[8], kd[8], pkkv[8], pkav[8], prkv[8];
        { const f32x4 t0 = *(const f32x4*)(sA + tk * 64 + g * 8), t1 = *(const f32x4*)(sA + tk * 64 + g * 8 + 4);
          av[0] = fsig(t0[0]); av[1] = fsig(t0[1]); av[2] = fsig(t0[2]); av[3] = fsig(t0[3]); av[4] = fsig(t1[0]); av[5] = fsig(t1[1]); av[6] = fsig(t1[2]); av[7] = fsig(t1[3]); }
        { const f32x4 t0 = *(const f32x4*)(sW + tk * 64 + g * 8), t1 = *(const f32x4*)(sW + tk * 64 + g * 8 + 4);
          f32x4 o0, o1;
#pragma unroll
          for (int j = 0; j < 4; ++j) { o0[j] = __expf(-0.6065306597126334f * fsig(t0[j])); o1[j] = __expf(-0.6065306597126334f * fsig(t1[j])); }
          *(f32x4*)(sW + tk * 64 + g * 8) = o0; *(f32x4*)(sW + tk * 64 + g * 8 + 4) = o1; }
        WAVE_LDS_SYNC();
        { float Wc = 1.0f;
#pragma unroll
          for (int j = 0; j < 8; ++j) { Wc *= sW[j * 64 + ln]; sW[j * 64 + ln] = Wc; } }
        WAVE_LDS_SYNC();
        float wcur[8], wprv[8];
        { const f32x4 t0 = *(const f32x4*)(sW + tk * 64 + g * 8), t1 = *(const f32x4*)(sW + tk * 64 + g * 8 + 4);
          const int tp = tk > 0 ? tk - 1 : 0;
          const f32x4 u0 = *(const f32x4*)(sW + tp * 64 + g * 8), u1 = *(const f32x4*)(sW + tp * 64 + g * 8 + 4);
#pragma unroll
          for (int j = 0; j < 4; ++j) { wcur[j] = t0[j]; wcur[j + 4] = t1[j]; wprv[j] = tk > 0 ? u0[j] : 1.0f; wprv[j + 4] = tk > 0 ? u1[j] : 1.0f; } }
        { const float* q7 = cP + 7 * 64 + g * 8;
          const f32x4 a0 = *(const f32x4*)(q7), a1 = *(const f32x4*)(q7 + 4), b0 = *(const f32x4*)(q7 + 64), b1 = *(const f32x4*)(q7 + 68),
                      c0 = *(const f32x4*)(q7 + 128), c1 = *(const f32x4*)(q7 + 132);
#pragma unroll
          for (int j = 0; j < 4; ++j) { pkkv[j] = a0[j]; pkkv[j + 4] = a1[j]; pkav[j] = b0[j]; pkav[j + 4] = b1[j]; prkv[j] = c0[j]; prkv[j + 4] = c1[j]; } }
        float ss = 0.f, bon = 0.f;
#pragma unroll
        for (int j = 0; j < 8; ++j) {
          kkn[j] = kk[j] * pkkv[j]; ss += kkn[j] * kkn[j];
          kd[j] = kk[j] * (1.0f + (av[j] - 1.0f) * pkav[j]);
          bon += rr[j] * kd[j] * prkv[j];
        }
        ss += __shfl_xor(ss, 1); ss += __shfl_xor(ss, 2); ss += __shfl_xor(ss, 4);
        const float inv = rsqrtf(ss + 1e-12f);
        if (PASS == 2) {
          bon += __shfl_xor(bon, 1); bon += __shfl_xor(bon, 2); bon += __shfl_xor(bon, 4);
          if (g == 0) bonus[(size_t)d * (T_ALL * 16) + (size_t)row * 16 + hh] = bon;
        }
        float iw[8];
#pragma unroll
        for (int j = 0; j < 8; ++j) iw[j] = __builtin_amdgcn_rcpf(wcur[j]);
        float* o;
        o = sKK + tk * 64 + g * 8;
        *(f32x4*)o = f32x4{kkn[0] * inv * wprv[0], kkn[1] * inv * wprv[1], kkn[2] * inv * wprv[2], kkn[3] * inv * wprv[3]};
        *(f32x4*)(o + 4) = f32x4{kkn[4] * inv * wprv[4], kkn[5] * inv * wprv[5], kkn[6] * inv * wprv[6], kkn[7] * inv * wprv[7]};
        o = sKKA + tk * 64 + g * 8;
        *(f32x4*)o = f32x4{kkn[0] * inv * av[0] * iw[0], kkn[1] * inv * av[1] * iw[1], kkn[2] * inv * av[2] * iw[2], kkn[3] * inv * av[3] * iw[3]};
        *(f32x4*)(o + 4) = f32x4{kkn[4] * inv * av[4] * iw[4], kkn[5] * inv * av[5] * iw[5], kkn[6] * inv * av[6] * iw[6], kkn[7] * inv * av[7] * iw[7]};
        o = sKD + tk * 64 + g * 8;
        *(f32x4*)o = f32x4{kd[0] * iw[0], kd[1] * iw[1], kd[2] * iw[2], kd[3] * iw[3]};
        *(f32x4*)(o + 4) = f32x4{kd[4] * iw[4], kd[5] * iw[5], kd[6] * iw[6], kd[7] * iw[7]};
        o = sR + tk * 64 + g * 8;
        *(f32x4*)o = f32x4{rr[0] * wcur[0], rr[1] * wcur[1], rr[2] * wcur[2], rr[3] * wcur[3]};
        *(f32x4*)(o + 4) = f32x4{rr[4] * wcur[4], rr[5] * wcur[5], rr[6] * wcur[6], rr[7] * wcur[7]};
        o = sV + tk * 64 + g * 8;
        *(f32x4*)o = f32x4{vv[0], vv[1], vv[2], vv[3]};
        *(f32x4*)(o + 4) = f32x4{vv[4], vv[5], vv[6], vv[7]};
      }
      WAVE_LDS_SYNC();
      __builtin_amdgcn_sched_barrier(0);
      float* obase = nullptr; ptrdiff_t ostep = d ? -1024 : 1024;
      if (PASS == 2) {
        int row0; bool hp0, hn0; tokmap(p0, d, b, row0, hp0, hn0);
        obase = ((row0 < T_LAT) ? (p.out + (size_t)row0 * 1024) : ((float*)(p.ws + OFF_OCTX) + (size_t)(row0 - T_LAT) * 1024)) + hh * 64 + lane;
      }
      const int lv31 = lane & 31, lh1 = lane >> 5;
#pragma unroll 1
      for (int j = 0; j < 8; ++j) {
        f32x4 kkv[2][4];
#pragma unroll
        for (int kt = 0; kt < 2; ++kt)
#pragma unroll
          for (int g = 0; g < 4; ++g) kkv[kt][g] = *(const f32x4*)(sKK + j * 64 + 32 * kt + 8 * g + 4 * lh1);
        float aop[2], vvv[2];
        const float akka = sKKA[j * 64 + lane];
#pragma unroll
        for (int t = 0; t < 2; ++t) {
          aop[t] = (lh1 ? sKD : sKKA)[j * 64 + 32 * t + lv31];
          vvv[t] = sV[j * 64 + 32 * t + lv31];
        }
        float saS[2], saP[2];
#pragma unroll
        for (int vt = 0; vt < 2; ++vt) {
          f2 a2 = {0.f, 0.f}, b2 = {0.f, 0.f};
#pragma unroll
          for (int kt = 0; kt < 2; ++kt)
#pragma unroll
            for (int g = 0; g < 4; ++g) {
              a2 += f2{S[kt][vt][4 * g], S[kt][vt][4 * g + 1]} * f2{kkv[kt][g][0], kkv[kt][g][1]};
              a2 += f2{S[kt][vt][4 * g + 2], S[kt][vt][4 * g + 3]} * f2{kkv[kt][g][2], kkv[kt][g][3]};
              if (PASS == 1) {
                b2 += f2{P[vt][16 * kt + 4 * g], P[vt][16 * kt + 4 * g + 1]} * f2{kkv[kt][g][0], kkv[kt][g][1]};
                b2 += f2{P[vt][16 * kt + 4 * g + 2], P[vt][16 * kt + 4 * g + 3]} * f2{kkv[kt][g][2], kkv[kt][g][3]};
              }
            }
          float x = a2[0] + a2[1];
          x += __shfl_xor(x, 32);
          saS[vt] = x;
          if (PASS == 1) { float y = b2[0] + b2[1]; y += __shfl_xor(y, 32); saP[vt] = y; }
        }
#pragma unroll
        for (int vt = 0; vt < 2; ++vt) {
          const float bS = lh1 ? vvv[vt] : -saS[vt];
          if (PASS == 1) P[vt] = __builtin_amdgcn_mfma_f32_32x32x1f32(akka, -saP[vt], P[vt], 0, 0, 0);
#pragma unroll
          for (int kt = 0; kt < 2; ++kt) {
            S[kt][vt] = __builtin_amdgcn_mfma_f32_32x32x2f32(aop[kt], bS, S[kt][vt], 0, 0, 0);
          }
        }
        if (PASS == 2) {
          f32x4 rv[2][4];
#pragma unroll
          for (int kt = 0; kt < 2; ++kt)
#pragma unroll
            for (int g = 0; g < 4; ++g) rv[kt][g] = *(const f32x4*)(sR + j * 64 + 32 * kt + 8 * g + 4 * lh1);
          float ov[2];
#pragma unroll
          for (int vt = 0; vt < 2; ++vt) {
            f2 a2 = {0.f, 0.f};
#pragma unroll
            for (int kt = 0; kt < 2; ++kt)
#pragma unroll
              for (int g = 0; g < 4; ++g) {
                a2 += f2{S[kt][vt][4 * g], S[kt][vt][4 * g + 1]} * f2{rv[kt][g][0], rv[kt][g][1]};
                a2 += f2{S[kt][vt][4 * g + 2], S[kt][vt][4 * g + 3]} * f2{rv[kt][g][2], rv[kt][g][3]};
              }
            float x = a2[0] + a2[1];
            x += __shfl_xor(x, 32);
            ov[vt] = x;
          }
          atomicAdd(obase + (ptrdiff_t)j * ostep, lh1 ? ov[1] : ov[0]);
        }
      }
      {
        f32x4 w7[2][4];
#pragma unroll
        for (int kt = 0; kt < 2; ++kt)
#pragma unroll
          for (int g = 0; g < 4; ++g) w7[kt][g] = *(const f32x4*)(sW + 7 * 64 + 32 * kt + 8 * g + 4 * lh1);
#pragma unroll
        for (int kt = 0; kt < 2; ++kt)
#pragma unroll
          for (int vt = 0; vt < 2; ++vt)
#pragma unroll
            for (int i = 0; i < 16; ++i) {
              S[kt][vt][i] *= w7[kt][i >> 2][i & 3];
              if (PASS == 1) P[vt][16 * kt + i] *= w7[kt][i >> 2][i & 3];
            }
      }
      WAVE_LDS_SYNC();
    }
    if (PASS == 1) {
      int li = lane; asm volatile("" : "+v"(li));
      const int lv = li & 31, lh = li >> 5;
      float* dP = stP + (size_t)item * 4096;
      float* dS = stS + (size_t)item * 4096;
#pragma unroll
      for (int kt = 0; kt < 2; ++kt)
#pragma unroll
        for (int vt = 0; vt < 2; ++vt)
#pragma unroll
          for (int g = 0; g < 4; ++g) {
            const int off = (32 * vt + lv) * 64 + 32 * kt + 8 * g + 4 * lh;
            *(f32x4*)(dP + off) = f32x4{P[vt][16 * kt + 4 * g], P[vt][16 * kt + 4 * g + 1], P[vt][16 * kt + 4 * g + 2], P[vt][16 * kt + 4 * g + 3]};
            *(f32x4*)(dS + off) = f32x4{S[kt][vt][4 * g], S[kt][vt][4 * g + 1], S[kt][vt][4 * g + 2], S[kt][vt][4 * g + 3]};
          }
    }
  }
}

DI void phase_carry(const Params& p, char* smem) {
  const int TIDX = ltid();
  float* cur = (float*)smem;
  const int tid = TIDX, lane = tid & 63, w = __builtin_amdgcn_readfirstlane(tid >> 6);
  const int lc = lane & 15, lq = lane >> 4;
  float* stP = (float*)(p.ws + OFF_STP);
  float* stS = (float*)(p.ws + OFF_STS);
  for (int it = blockIdx.x; it < 256; it += gridDim.x) {
    const int chain = it >> 2, rg = it & 3;
    const size_t slot0 = (size_t)chain * 32;
    __syncthreads();
    {
      const int row = tid >> 4, c4 = (tid & 15) * 4;
      const f32x4 t = *(const f32x4*)(stS + (slot0 * 64 + rg * 16 + row) * 64 + c4);
      *(f32x4*)(cur + row * 68 + c4) = t;
    }
    __syncthreads();
    float pn[16]; f32x4 an;
    {
      const float* Pm = stP + (slot0 + 1) * 4096;
#pragma unroll
      for (int s = 0; s < 16; ++s) pn[s] = Pm[(size_t)(4 * s + lq) * 64 + 16 * w + lc];
#pragma unroll
      for (int rr = 0; rr < 4; ++rr) an[rr] = stS[((slot0 + 1) * 64 + rg * 16 + 4 * lq + rr) * 64 + 16 * w + lc];
    }
    for (int c = 1; c < 31; ++c) {
      const size_t slot = slot0 + c;
      float pj[16]; f32x4 acc = an;
#pragma unroll
      for (int s = 0; s < 16; ++s) pj[s] = pn[s];
      if (c + 1 < 31) {
        const float* Pm = stP + (slot + 1) * 4096;
#pragma unroll
        for (int s = 0; s < 16; ++s) pn[s] = Pm[(size_t)(4 * s + lq) * 64 + 16 * w + lc];
#pragma unroll
        for (int rr = 0; rr < 4; ++rr) an[rr] = stS[((slot + 1) * 64 + rg * 16 + 4 * lq + rr) * 64 + 16 * w + lc];
      }
#pragma unroll
      for (int s = 0; s < 16; ++s) {
        const float a = cur[lc * 68 + 4 * s + lq];
        acc = __builtin_amdgcn_mfma_f32_16x16x4f32(a, pj[s], acc, 0, 0, 0);
      }
      __syncthreads();
#pragma unroll
      for (int rr = 0; rr < 4; ++rr) {
        cur[(4 * lq + rr) * 68 + 16 * w + lc] = acc[rr];
        stS[(slot * 64 + rg * 16 + 4 * lq + rr) * 64 + 16 * w + lc] = acc[rr];
      }
      __syncthreads();
    }
  }
}

DI void phase_readout(const Params& p) {
  const int TIDX = ltid();
  const int lane = TIDX & 63, wv = __builtin_amdgcn_readfirstlane(TIDX >> 6);
  const u16* proj = (const u16*)(p.ws + OFF_PROJ);
  const float* bonus = (const float*)(p.ws + OFF_BONUS);
  u16* hb = (u16*)(p.ws + OFF_HB);
  for (int row = blockIdx.x * 4 + wv; row < T_ALL; row += gridDim.x * 4) {
    const float* o = (row < T_LAT) ? (p.out + (size_t)row * 1024) : ((const float*)(p.ws + OFF_OCTX) + (size_t)(row - T_LAT) * 1024);
    bool hp, hn;
    if (row < T_LAT) { const int t = row & 8191; hp = t > 0; hn = t < 8191; } else { const int t = (row - T_LAT) & 255; hp = t > 0; hn = t < 255; }
    const int c0 = lane * 16, hh = lane >> 2;
    float ov[16];
    float s = 0.f;
#pragma unroll
    for (int q = 0; q < 4; ++q) { const f32x4 t = *(const f32x4*)(o + c0 + q * 4); ov[q * 4] = t[0]; ov[q * 4 + 1] = t[1]; ov[q * 4 + 2] = t[2]; ov[q * 4 + 3] = t[3]; s += t[0] + t[1] + t[2] + t[3]; }
    s += __shfl_xor(s, 1); s += __shfl_xor(s, 2);
    const float mean = s * (1.0f / 64.0f);
    float vs = 0.f;
#pragma unroll
    for (int j = 0; j < 16; ++j) { const float dlt = ov[j] - mean; vs += dlt * dlt; }
    vs += __shfl_xor(vs, 1); vs += __shfl_xor(vs, 2);
    const float rstd = rsqrtf(vs * (1.0f / 64.0f) + 64e-5f);
    const float bon = bonus[(size_t)row * 16 + hh] + bonus[(size_t)(T_ALL * 16) + (size_t)row * 16 + hh];
    float vm[16];
    const u16* pr = proj + (size_t)row * N0;
    load_mix8(pr + 2048 + c0, hp, hn, p.rw_mu + 2048 + c0, vm);
    load_mix8(pr + 2048 + c0 + 8, hp, hn, p.rw_mu + 2048 + c0 + 8, vm + 8);
    float gv[16];
    unpack8(*(const u32x4*)(pr + 3072 + c0), gv);
    unpack8(*(const u32x4*)(pr + 3072 + c0 + 8), gv + 8);
    unsigned pk[8];
#pragma unroll
    for (int j = 0; j < 8; ++j) {
      const int ca = c0 + 2 * j, cb = ca + 1;
      const float ya = ((ov[2 * j] - mean) * rstd * p.rw_gn_g[ca] + p.rw_gn_b[ca] + bon * vm[2 * j]) * siluf_(gv[2 * j]);
      const float yb = ((ov[2 * j + 1] - mean) * rstd * p.rw_gn_g[cb] + p.rw_gn_b[cb] + bon * vm[2 * j + 1]) * siluf_(gv[2 * j + 1]);
      pk[j] = pack2(ya, yb);
    }
    u32x4* dd = (u32x4*)(hb + (size_t)row * 1024 + c0);
    dd[0] = u32x4{pk[0], pk[1], pk[2], pk[3]};
    dd[1] = u32x4{pk[4], pk[5], pk[6], pk[7]};
  }
}

DI void phase_qkprep(const Params& p) {
  const int TIDX = ltid();
  const int lane = TIDX & 63, wv = __builtin_amdgcn_readfirstlane(TIDX >> 6);
  const u16* raw = (const u16*)(p.ws + OFF_RAW);
  u16* Qs = (u16*)(p.ws + OFF_QS);
  u16* Ks = (u16*)(p.ws + OFF_KS);
  const float* rope = (const float*)(p.ws + OFF_ROPE);
  const int grp = lane >> 1, axis = lane & 1;
  const bool isq = grp < 16;
  const int hd = (grp & 15) >> 1, comp = grp & 1;
  const float* gain = (isq ? p.da_qn : p.da_kn) + axis * 32;
  for (int row = blockIdx.x * 4 + wv; row < T_ALL; row += gridDim.x * 4) {
    const bool lat = row < T_LAT;
    int b, t;
    if (lat) { b = row >> 13; t = row & 8191; } else { b = (row - T_LAT) >> 8; t = (row - T_LAT) & 255; }
    const u16* src = raw + (size_t)row * 2048 + lane * 32;
    float v[32];
#pragma unroll
    for (int q = 0; q < 4; ++q) unpack8(*(const u32x4*)(src + q * 8), v + q * 8);
    float ss = 0.f;
#pragma unroll
    for (int j = 0; j < 32; ++j) ss += v[j] * v[j];
    ss += __shfl_xor(ss, 1);
    const float rstd = rsqrtf(ss * (1.0f / 64.0f) + 1e-6f);
#pragma unroll
    for (int j = 0; j < 32; ++j) v[j] = v[j] * rstd * gain[j];
    if (lat) {
      const int pos = axis == 0 ? (t >> 6) : (t & 63);
#pragma unroll
      for (int f = 0; f < 16; ++f) {
        const float c = rope[pos * 16 + f], s = rope[2048 + pos * 16 + f];
        const float x1 = v[f], x2 = v[16 + f];
        v[f] = x1 * c - x2 * s; v[16 + f] = x2 * c + x1 * s;
      }
    }
    u16* dst;
    float sc = 1.0f;
    if (isq) {
      if (!lat) continue;
      sc = 0.125f * 1.4426950408889634f;
      dst = Qs + (((size_t)(b * 8 + hd) * 2 + comp) * 8192 + t) * 64 + axis * 32;
    } else {
      const int pp = lat ? 256 + t : t;
      dst = Ks + (((size_t)(b * 8 + hd) * 2 + comp) * LKV + pp) * 64 + axis * 32;
    }
#pragma unroll
    for (int q = 0; q < 4; ++q) {
      u32x4 o = {pack2(v[q * 8] * sc, v[q * 8 + 1] * sc), pack2(v[q * 8 + 2] * sc, v[q * 8 + 3] * sc),
                 pack2(v[q * 8 + 4] * sc, v[q * 8 + 5] * sc), pack2(v[q * 8 + 6] * sc, v[q * 8 + 7] * sc)};
      *(u32x4*)(dst + q * 8) = o;
    }
  }
}

typedef __attribute__((address_space(3))) unsigned* lds_uptr;
typedef __attribute__((address_space(1))) const unsigned* glb_uptr;
DI void dma16(const void* g, char* ldsbase) {
  __builtin_amdgcn_global_load_lds((glb_uptr)(g), (lds_uptr)(ldsbase), 16, 0, 0);
}

DI void attn_issue_tile(const u16* Kg, const u16* Vg, int k0, char* buf, int wv, int lane) {
  asm volatile("" : "+v"(lane));
  const int rr = lane >> 3, cp = lane & 7;
#pragma unroll
  for (int i = 0; i < 4; ++i) {
    const int seg = wv * 4 + i;
    const int c = seg >> 3, key = (seg & 7) * 8 + rr;
    const int sw = (key >> 1) & 7;
    dma16(Kg + ((size_t)c * LKV + k0 + key) * 64 + ((cp ^ sw) << 3), buf + seg * 1024);
    const int e = seg * 8 + rr;
    const int swv = (e >> 1) & 7;
    dma16(Vg + (size_t)e * LKV + k0 + ((cp ^ swv) << 3), buf + 16384 + seg * 1024);
  }
}

DI void phase_attn(const Params& p, char* smem) {
  const int TIDX = ltid();
  const int tid = TIDX, lane = tid & 63, wv = __builtin_amdgcn_readfirstlane(tid >> 6);
  const int r = lane & 31, h = lane >> 5;
  const u16* Qs = (const u16*)(p.ws + OFF_QS);
  const u16* Ks = (const u16*)(p.ws + OFF_KS);
  const u16* Vt = (const u16*)(p.ws + OFF_VT);
  const u16* GB = (const u16*)(p.ws + OFF_GB);
  u16* Y2 = (u16*)(p.ws + OFF_Y2);
  float lam;
  {
    float a = p.da_lam[lane] * p.da_lam[64 + lane];
    float bq = p.da_lam[128 + lane] * p.da_lam[192 + lane];
#pragma unroll
    for (int o = 32; o >= 1; o >>= 1) { a += __shfl_xor(a, o); bq += __shfl_xor(bq, o); }
    lam = __expf(a) - __expf(bq) + 0.35550906759096927f;
  }
  const float one_m_li = 1.0f - 0.35550906759096927f;
  const int sw = (r >> 1) & 7;
  int repa = REP_ATTN; asm volatile("" : "+s"(repa));
  for (int rp = 0; rp < repa; ++rp)
  for (int item = blockIdx.x; item < 1024; item += gridDim.x) {
    const int bh = (item & 7) * 2 + (item >> 9), qt = (item >> 3) & 63;
    const int q0 = qt * 128 + wv * 32;
    const u16* Kg = Ks + (size_t)bh * 2 * LKV * 64;
    const u16* Vg = Vt + (size_t)bh * 128 * LKV;
    __syncthreads();
    attn_issue_tile(Kg, Vg, 0, smem, wv, lane);
    bf16x8 qf[2][4];
#pragma unroll
    for (int c = 0; c < 2; ++c)
#pragma unroll
      for (int s = 0; s < 4; ++s)
        qf[c][s] = *(const bf16x8*)(Qs + (((size_t)bh * 2 + c) * 8192 + q0 + r) * 64 + s * 16 + 8 * h);
    f32x16 O[2][4];
#pragma unroll
    for (int c = 0; c < 2; ++c)
#pragma unroll
      for (int e = 0; e < 4; ++e)
#pragma unroll
        for (int i = 0; i < 16; ++i) O[c][e][i] = 0.f;
    f2 lsum[2] = {f2{0.f, 0.f}, f2{0.f, 0.f}};
#pragma unroll 1
    for (int kt = 0; kt < LKV / 64; ++kt) {
      char* buf = smem + (kt & 1) * 32768;
      asm volatile("s_waitcnt vmcnt(0)" ::: "memory");
      __syncthreads();
      if (kt + 1 < LKV / 64) attn_issue_tile(Kg, Vg, (kt + 1) * 64, smem + ((kt + 1) & 1) * 32768, wv, lane);
      const char* Kb = buf + r * 128;
      const char* Vb = buf + 16384 + r * 128;
#pragma unroll
      for (int sub = 0; sub < 2; ++sub) {
        f32x16 sacc[2];
#pragma unroll
        for (int c = 0; c < 2; ++c) {
#pragma unroll
          for (int i = 0; i < 16; ++i) sacc[c][i] = 0.f;
#pragma unroll
          for (int s = 0; s < 4; ++s) {
            const bf16x8 kf = *(const bf16x8*)(Kb + c * 8192 + sub * 4096 + (((2 * s + h) ^ sw) << 4));
            sacc[c] = MFMA32(kf, qf[c][s], sacc[c]);
          }
        }
#pragma unroll
        for (int c = 0; c < 2; ++c) {
          bf16x8 pf[2];
#pragma unroll
          for (int s = 0; s < 2; ++s) {
            float ps[8];
#pragma unroll
            for (int i = 0; i < 8; ++i) ps[i] = __builtin_amdgcn_exp2f(sacc[c][8 * s + i]);
            lsum[c] += f2{ps[0], ps[1]}; lsum[c] += f2{ps[2], ps[3]}; lsum[c] += f2{ps[4], ps[5]}; lsum[c] += f2{ps[6], ps[7]};
            u32x4 pk = {cvtpk(ps[0], ps[1]), cvtpk(ps[2], ps[3]), cvtpk(ps[4], ps[5]), cvtpk(ps[6], ps[7])};
            pf[s] = __builtin_bit_cast(bf16x8, pk);
          }
#pragma unroll
          for (int e = 0; e < 4; ++e)
#pragma unroll
            for (int s = 0; s < 2; ++s) {
              const bf16x8 vf = *(const bf16x8*)(Vb + e * 4096 + (((sub * 4 + 2 * s + h) ^ sw) << 4));
              O[c][e] = MFMA32(vf, pf[s], O[c][e]);
            }
        }
      }
    }
    float l0 = lsum[0][0] + lsum[0][1], l1 = lsum[1][0] + lsum[1][1];
    l0 += __shfl_xor(l0, 32); l1 += __shfl_xor(l1, 32);
    const float i0 = 1.0f / l0, i1 = lam / l1;
    float ss = 0.f;
#pragma unroll
    for (int e = 0; e < 4; ++e)
#pragma unroll
      for (int i = 0; i < 16; ++i) { const float o = O[0][e][i] * i0 - O[1][e][i] * i1; O[0][e][i] = o; ss += o * o; }
    ss += __shfl_xor(ss, 32);
    const float rstd = rsqrtf(ss * (1.0f / 128.0f) + 1e-5f) * one_m_li;
    const int b = bh >> 3, hd = bh & 7;
    int rl = r; asm volatile("" : "+v"(rl));
    const size_t row = (size_t)b * 8192 + q0 + rl;
#pragma unroll
    for (int e = 0; e < 4; ++e) {
#pragma unroll
      for (int g = 0; g < 4; ++g) {
        const int ee = e * 32 + 8 * g + 4 * h;
        const u32x2 gg = *(const u32x2*)(GB + row * 1024 + hd * 128 + ee);
        const float g0 = bflo(gg[0]), g1 = bfhi(gg[0]), g2 = bflo(gg[1]), g3 = bfhi(gg[1]);
        const f32x4 sl = *(const f32x4*)(p.da_subln + ee);
        const float y0 = O[0][e][4 * g] * rstd * sl[0] * g0;
        const float y1 = O[0][e][4 * g + 1] * rstd * sl[1] * g1;
        const float y2 = O[0][e][4 * g + 2] * rstd * sl[2] * g2;
        const float y3 = O[0][e][4 * g + 3] * rstd * sl[3] * g3;
        *(u32x2*)(Y2 + row * 1024 + hd * 128 + ee) = u32x2{cvtpk(y0, y1), cvtpk(y2, y3)};
      }
      asm volatile("" ::: "memory");
    }
  }
}

#define XB_TMO      128
#define XB_XCNT(j)  (256  + 64 * (j))
#define XB_XSUB(j)  (1280 + 64 * (j))
#define XB_XGEN(j)  (2304 + 64 * (j))
#define XB_TOP      3328
#define XB_TOPGEN   3392
#define XCD_BAR_WORDS 3456
#define XB_SPIN_CAP (1u << 18)
#define LAS __attribute__((address_space(3)))

__device__ __forceinline__ unsigned xb_ld(unsigned* p)              { return __hip_atomic_load(p, __ATOMIC_RELAXED, __HIP_MEMORY_SCOPE_AGENT); }
__device__ __forceinline__ unsigned xb_add(unsigned* p, unsigned v) { return __hip_atomic_fetch_add(p, v, __ATOMIC_RELAXED, __HIP_MEMORY_SCOPE_AGENT); }
__device__ __forceinline__ unsigned xb_xcc_id() { return (unsigned)__builtin_amdgcn_s_getreg((3 << 11) | 20) & 0xFu; }
#define XB_SPIN(cond, bar) do { unsigned _sp = 0; while (cond) { __builtin_amdgcn_s_sleep(1); \
    if ((++_sp & 255u) == 0u) { if (xb_ld(&(bar)[XB_TMO])) break; if (_sp > XB_SPIN_CAP) { atomicAdd(&(bar)[XB_TMO], 1u); break; } } } } while (0)

struct XcdBarrier {
    unsigned* bar; unsigned x;
    volatile LAS unsigned* st;
};

__device__ __forceinline__ XcdBarrier xcd_barrier_post(unsigned* bar, volatile LAS unsigned* st) {
    XcdBarrier b; b.bar = bar; b.x = xb_xcc_id(); b.st = st;
    if (threadIdx.x == 0) (void)xb_add(&bar[XB_XCNT(b.x)], 1u);
    return b;
}
__device__ __forceinline__ void xcd_barrier_complete(unsigned* bar, unsigned x, unsigned& nloc, unsigned& nx) {
    const unsigned G = gridDim.x * gridDim.y * gridDim.z;
    unsigned sum, cnt, mine, sp = 0u;
    for (;;) {
        sum = 0u; cnt = 0u; mine = 0u;
#pragma unroll
        for (unsigned j = 0; j < 16; ++j) { const unsigned c = xb_ld(&bar[XB_XCNT(j)]); sum += c; cnt += (c > 0u) ? 1u : 0u; mine = (j == x) ? c : mine; }
        if (sum == G) break;
        __builtin_amdgcn_s_sleep(1);
        if ((++sp & 255u) == 0u) { if (xb_ld(&bar[XB_TMO])) break; if (sp > XB_SPIN_CAP) { atomicAdd(&bar[XB_TMO], 1u); break; } }
    }
    nloc = mine > 0u ? mine : 1u; nx = cnt > 0u ? cnt : 1u;
}

__device__ __forceinline__ void xcd_barrier(const XcdBarrier& b) {
    asm volatile("s_waitcnt vmcnt(0)" ::: "memory");
    __syncthreads();
    if (threadIdx.x == 0) {
        unsigned* bar = b.bar;
        __builtin_amdgcn_s_waitcnt(0);
        unsigned nloc = b.st[0], nx = b.st[1];
        if (nloc == 0u) { xcd_barrier_complete(bar, b.x, nloc, nx); b.st[0] = nloc; b.st[1] = nx; }
        const unsigned old = xb_add(&bar[XB_XSUB(b.x)], 1u);
        const unsigned gen = old / nloc;
        if (old + 1u == (gen + 1u) * nloc) {
            __builtin_amdgcn_fence(__ATOMIC_RELEASE, "agent");
            asm volatile("s_waitcnt vmcnt(0)" ::: "memory");
            const unsigned og = xb_add(&bar[XB_TOP], 1u);
            const unsigned tg = og / nx;
            if (og + 1u == (tg + 1u) * nx) xb_add(&bar[XB_TOPGEN], 1u);
            else XB_SPIN(xb_ld(&bar[XB_TOPGEN]) == tg, bar);
            __builtin_amdgcn_fence(__ATOMIC_ACQUIRE, "agent");
            xb_add(&bar[XB_XGEN(b.x)], 1u);
            asm volatile("s_waitcnt vmcnt(0)" ::: "memory");
        } else {
            XB_SPIN(xb_ld(&bar[XB_XGEN(b.x)]) == gen, bar);
            __builtin_amdgcn_fence(__ATOMIC_ACQUIRE, "agent");
            asm volatile("s_waitcnt vmcnt(0)" ::: "memory");
        }
    }
    __syncthreads();
}


__global__ void __launch_bounds__(256, 2) fwd_megakernel(Params p) {
  extern __shared__ __attribute__((aligned(16))) char smem[];
  __shared__ uint4 xb_words;
  cg::grid_group grid = cg::this_grid();
  if (threadIdx.x == 0) xb_words = make_uint4(0u, 0u, 0u, 0u);
  __syncthreads();
  XcdBarrier xb = xcd_barrier_post((unsigned*)(p.ws + OFF_BAR), (volatile LAS unsigned*)&xb_words);
  phase_prep(p, smem);
  if (p.ws == nullptr) grid.sync();
  xcd_barrier(xb);
  phase_normmod(p, 0, p.x, p.ctx, true);
  xcd_barrier(xb);
  phase_gemm_wide16<0>(p, smem, (const u16*)(p.ws + OFF_HB), (const u16*)(p.ws + OFF_WT_IN0), 120, N0 / 256);
  phase_gemm<0>(p, smem, (const u16*)(p.ws + OFF_HB), (const u16*)(p.ws + OFF_WT_IN0), T_ALL / 128 - 120, N0 / 128, 120);
  xcd_barrier(xb);
  phase_scan<1>(p, smem);
  xcd_barrier(xb);
  phase_carry(p, smem);
  xcd_barrier(xb);
  phase_scan<2>(p, smem);
  xcd_barrier(xb);
  phase_readout(p);
  xcd_barrier(xb);
  phase_gemm_wide16<1>(p, smem, (const u16*)(p.ws + OFF_HB), (const u16*)(p.ws + OFF_WT_OUT0), 128, 4);
  phase_gemm<1>(p, smem, (const u16*)(p.ws + OFF_HB), (const u16*)(p.ws + OFF_WT_OUT0), T_ALL / 128 - 128, 8, 128);
  xcd_barrier(xb);
  phase_normmod(p, 1, p.out, (const float*)(p.ws + OFF_XC1), false);
  xcd_barrier(xb);
  phase_gemm_wide16<2>(p, smem, (const u16*)(p.ws + OFF_HB), (const u16*)(p.ws + OFF_WT_IN1), 128, N1 / 256);
  phase_gemm<2>(p, smem, (const u16*)(p.ws + OFF_HB), (const u16*)(p.ws + OFF_WT_IN1), T_ALL / 128 - 128, N1 / 128, 128);
  xcd_barrier(xb);
  phase_qkprep(p);
  xcd_barrier(xb);
  phase_attn(p, smem);
  xcd_barrier(xb);
  phase_gemm_wide16<3>(p, smem, (const u16*)(p.ws + OFF_Y2), (const u16*)(p.ws + OFF_WT_OUT1), T_LAT / 128, 4);
}

extern "C" void kernel_launch(void* const* d_in, const int* in_sizes, int n_in, void* d_out, int out_size, void* d_ws,
                              size_t ws_size, hipStream_t stream) {
  static int grid_blocks = 0;
  if (!grid_blocks) {
    int dev = 0, cus = 0, per_cu = 0;
    hipGetDevice(&dev);
    hipDeviceGetAttribute(&cus, hipDeviceAttributeMultiprocessorCount, dev);
    hipFuncSetAttribute((const void*)fwd_megakernel, hipFuncAttributeMaxDynamicSharedMemorySize, LDS_BYTES);
    hipOccupancyMaxActiveBlocksPerMultiprocessor(&per_cu, fwd_megakernel, 256, LDS_BYTES);
    if (per_cu < 1) per_cu = 1;
    if (per_cu > 2) per_cu = 2;
    grid_blocks = cus * per_cu;
    if (ws_size < 256 * MiB) fprintf(stderr, "kernel_launch: workspace too small: %zu\n", ws_size);
  }
  Params p{};
  const float** pp = (const float**)&p;
  for (int i = 0; i < 25; ++i) pp[i] = (const float*)d_in[i];
  p.out = (float*)d_out;
  p.ws = (char*)d_ws;
  hipMemsetAsync((char*)d_ws + OFF_BAR, 0, XCD_BAR_WORDS * sizeof(unsigned), stream);
  void* args[] = {&p};
  hipError_t e = hipLaunchCooperativeKernel((void*)fwd_megakernel, dim3(grid_blocks), dim3(256), args, LDS_BYTES, stream);
  if (e != hipSuccess) fprintf(stderr, "cooperative launch failed: %s (grid %d)\n", hipGetErrorString(e), grid_blocks);
}
```

```cpp
#include <hip/hip_runtime.h>
#include <hip/hip_cooperative_groups.h>
#include <cstdio>
namespace cg = cooperative_groups;

#define DI __device__ __forceinline__
typedef unsigned short u16;
using bf16x8 = __attribute__((ext_vector_type(8))) short;
using s16x4  = __attribute__((ext_vector_type(4))) short;
using f32x16 = __attribute__((ext_vector_type(16))) float;
using f32x4  = __attribute__((ext_vector_type(4))) float;
using f32x32 = __attribute__((ext_vector_type(32))) float;
using f2     = __attribute__((ext_vector_type(2))) float;
using u32x4  = __attribute__((ext_vector_type(4))) unsigned;
using u32x2  = __attribute__((ext_vector_type(2))) unsigned;

constexpr int T_LAT = 16384, T_CTX = 512, T_ALL = 16896, DM = 1024;
constexpr int N0 = 4352, N1 = 4096;
constexpr int LKV = 8448;
constexpr int NCHUNK = 32, LCH = 264, NSUB = 33;

constexpr size_t MiB = 1048576;
constexpr size_t OFF_WT_IN0 = 0;
constexpr size_t OFF_WT_OUT0 = 8912896;
constexpr size_t OFF_WT_IN1 = 11010048;
constexpr size_t OFF_WT_OUT1 = 19398656;
constexpr size_t OFF_W2T = 21495808;
constexpr size_t OFF_A2T = 21757952;
constexpr size_t OFF_MOD = 21 * MiB;
constexpr size_t OFF_ROPE = OFF_MOD + 73728;
constexpr size_t OFF_BONUS = 21 * MiB + 131072;
constexpr size_t OFF_XC1 = 24 * MiB;
constexpr size_t OFF_OCTX = 26 * MiB;
constexpr size_t OFF_BAR = 29 * MiB;
constexpr size_t OFF_PROJ = 30 * MiB;
constexpr size_t OFF_HB = 171 * MiB;
constexpr size_t OFF_STP = 171 * MiB;
constexpr size_t OFF_STS = 203 * MiB;
constexpr size_t OFF_RAW = 30 * MiB;
constexpr size_t OFF_VT = 96 * MiB;
constexpr size_t OFF_KS = 129 * MiB;
constexpr size_t OFF_GB = 204 * MiB;
constexpr size_t OFF_QS = OFF_HB;
constexpr size_t OFF_Y2 = OFF_RAW;

constexpr int LDS_BYTES = 78336;

struct Params {
  const float *x, *c, *ctx, *c_ctx, *ada_w, *ada_b, *norm_g, *rw_in, *rw_mu, *rw_w0, *rw_w2, *rw_a0, *rw_a2,
      *rw_kk, *rw_ka, *rw_rk, *rw_gn_g, *rw_gn_b, *rw_out, *da_in, *da_qn, *da_kn, *da_lam, *da_subln, *da_out;
  float* out;
  char* ws;
};

DI u16 f2bf(float x) { unsigned u = __float_as_uint(x); u += 0x7fffu + ((u >> 16) & 1u); return (u16)(u >> 16); }
DI float bf2f(u16 h) { return __uint_as_float(((unsigned)h) << 16); }
DI unsigned pack2(float a, float b) { return (unsigned)f2bf(a) | ((unsigned)f2bf(b) << 16); }
typedef __bf16 bf16v2 __attribute__((ext_vector_type(2)));
DI unsigned cvtpk(float a, float b) { f2 v = {a, b}; return __builtin_bit_cast(unsigned, __builtin_convertvector(v, bf16v2)); }
DI float fsig(float x) { return __builtin_amdgcn_rcpf(1.0f + __expf(-x)); }
DI int ltid() { int t = threadIdx.x; asm volatile("" : "+v"(t)); return t; }
DI float bflo(unsigned u) { return __uint_as_float(u << 16); }
DI float bfhi(unsigned u) { return __uint_as_float(u & 0xffff0000u); }
DI float sigmoidf_(float x) { return 1.0f / (1.0f + __expf(-x)); }
DI float siluf_(float x) { return x * sigmoidf_(x); }
DI int crow(int i, int h) { return (i & 3) + 8 * (i >> 2) + 4 * h; }
DI void unpack8(const u32x4& u, float* f) {
  f[0] = bflo(u[0]); f[1] = bfhi(u[0]); f[2] = bflo(u[1]); f[3] = bfhi(u[1]);
  f[4] = bflo(u[2]); f[5] = bfhi(u[2]); f[6] = bflo(u[3]); f[7] = bfhi(u[3]);
}
#define WAVE_LDS_SYNC() asm volatile("s_waitcnt lgkmcnt(0)" ::: "memory")
#define MFMA32(a, b, c) __builtin_amdgcn_mfma_f32_32x32x16_bf16((a), (b), (c), 0, 0, 0)
#define MFMA16(a, b, c) __builtin_amdgcn_mfma_f32_16x16x32_bf16((a), (b), (c), 0, 0, 0)

__device__ const float INV_FREQ[16] = {
    1.0f, 0.5623413251903491f, 0.31622776601683794f, 0.1778279410038923f, 0.1f, 0.05623413251903491f,
    0.03162277660168379f, 0.01778279410038923f, 0.01f, 0.005623413251903491f, 0.0031622776601683794f,
    0.001778279410038923f, 0.001f, 0.0005623413251903491f, 0.00031622776601683794f, 0.0001778279410038923f};

DI void transpose_tile(const float* __restrict__ src, u16* __restrict__ dst, int K, int N, int kt, int nt, float* tile) {
  const int TIDX = ltid();
  const int tid = TIDX;
  {
    const int n = tid & 63, k0 = tid >> 6;
#pragma unroll
    for (int i = 0; i < 16; ++i) {
      const int k = k0 + 4 * i;
      tile[k * 65 + n] = src[(size_t)(kt * 64 + k) * N + nt * 64 + n];
    }
  }
  __syncthreads();
  {
    const int n = tid >> 2, kq = tid & 3;
    unsigned pk[8];
#pragma unroll
    for (int j = 0; j < 8; ++j) pk[j] = pack2(tile[(kq * 16 + 2 * j) * 65 + n], tile[(kq * 16 + 2 * j + 1) * 65 + n]);
    u32x4* d = (u32x4*)(dst + (size_t)(nt * 64 + n) * K + kt * 64 + kq * 16);
    d[0] = u32x4{pk[0], pk[1], pk[2], pk[3]};
    d[1] = u32x4{pk[4], pk[5], pk[6], pk[7]};
  }
  __syncthreads();
}

DI void phase_prep(const Params& p, char* smem) {
  const int TIDX = ltid();
  float* tile = (float*)smem;
  const int tid = TIDX;
  constexpr int T_IN0 = 16 * 68, T_OUT = 256, T_IN1 = 16 * 64, T_LORA = 16;
  constexpr int E0 = T_IN0, E1 = E0 + T_OUT, E2 = E1 + T_IN1, E3 = E2 + T_OUT, E4 = E3 + 2 * T_LORA, E5 = E4 + 2 * T_LORA;
  constexpr int NMOD = 192;
  constexpr int TOTAL = E5 + NMOD + 1;
  for (int it = blockIdx.x; it < TOTAL; it += gridDim.x) {
    if (it < E0) { transpose_tile(p.rw_in, (u16*)(p.ws + OFF_WT_IN0), 1024, N0, it / 68, it % 68, tile); }
    else if (it < E1) { int j = it - E0; transpose_tile(p.rw_out, (u16*)(p.ws + OFF_WT_OUT0), 1024, 1024, j >> 4, j & 15, tile); }
    else if (it < E3) {   }
    else if (it < E4) { int j = it - E3; int d = j >> 4; transpose_tile(p.rw_w2 + (size_t)d * 65536, (u16*)(p.ws + OFF_W2T) + (size_t)d * 65536, 64, 1024, 0, j & 15, tile); }
    else if (it < E5) { int j = it - E4; int d = j >> 4; transpose_tile(p.rw_a2 + (size_t)d * 65536, (u16*)(p.ws + OFF_A2T) + (size_t)d * 65536, 64, 1024, 0, j & 15, tile); }
    else if (it < E5 + NMOD) {
      const int j = it - E5; const int layer = j / 96; const int nb = (j % 96) * 32;
      const int n = nb + (tid & 31), kg = tid >> 5;
      const float* W = p.ada_w + (size_t)layer * 1024 * 3072;
      float a0 = 0.f, a1 = 0.f, a2 = 0.f;
#pragma unroll 8
      for (int k = kg * 128; k < kg * 128 + 128; ++k) {
        const float w = W[(size_t)k * 3072 + n];
        a0 += siluf_(p.c[k]) * w; a1 += siluf_(p.c[1024 + k]) * w; a2 += siluf_(p.c_ctx[k]) * w;
      }
      tile[(kg * 3 + 0) * 32 + (tid & 31)] = a0; tile[(kg * 3 + 1) * 32 + (tid & 31)] = a1; tile[(kg * 3 + 2) * 32 + (tid & 31)] = a2;
      __syncthreads();
      if (tid < 96) {
        const int s = tid >> 5, nn = tid & 31;
        float acc = p.ada_b[layer * 3072 + nb + nn];
#pragma unroll
        for (int g = 0; g < 8; ++g) acc += tile[(g * 3 + s) * 32 + nn];
        ((float*)(p.ws + OFF_MOD))[(layer * 3 + s) * 3072 + nb + nn] = acc;
      }
      __syncthreads();
    } else {
      float* rope = (float*)(p.ws + OFF_ROPE);
      for (int e = tid; e < 2048; e += 256) {
        const int pos = e >> 4, f = e & 15;
        const float ang = (float)pos * INV_FREQ[f];
        const float rev = ang * 0.15915494309189535f;
        const float fr = rev - rintf(rev);
        const float a = fr * 6.283185307179586f;
        rope[e] = __cosf(a); rope[2048 + e] = __sinf(a);
      }
    }
  }
}

DI void phase_normmod(const Params& p, int layer, const float* __restrict__ xl, const float* __restrict__ xc, bool zero_o) {
  const int TIDX = ltid();
  const int lane = TIDX & 63, wv = __builtin_amdgcn_readfirstlane(TIDX >> 6);
  const float* mod = (const float*)(p.ws + OFF_MOD) + layer * 3 * 3072;
  const float* g = p.norm_g + layer * 1024;
  u16* hb = (u16*)(p.ws + OFF_HB);
  for (int row = blockIdx.x * 4 + wv; row < T_ALL; row += gridDim.x * 4) {
    const float* src; const float* m;
    if (row < T_LAT) { src = xl + (size_t)row * 1024; m = mod + (row >> 13) * 3072; }
    else { src = xc + (size_t)(row - T_LAT) * 1024; m = mod + 2 * 3072; }
    float v[16];
    float ss = 0.f;
#pragma unroll
    for (int q = 0; q < 4; ++q) {
      const f32x4 t = *(const f32x4*)(src + lane * 16 + q * 4);
      v[q * 4] = t[0]; v[q * 4 + 1] = t[1]; v[q * 4 + 2] = t[2]; v[q * 4 + 3] = t[3];
      ss += t[0] * t[0] + t[1] * t[1] + t[2] * t[2] + t[3] * t[3];
    }
#pragma unroll
    for (int o = 32; o >= 1; o >>= 1) ss += __shfl_xor(ss, o);
    const float rstd = rsqrtf(ss * (1.0f / 1024.0f) + 1e-6f);
    unsigned pk[8];
#pragma unroll
    for (int j = 0; j < 8; ++j) {
      const int c0 = lane * 16 + 2 * j;
      const float h0 = v[2 * j] * rstd * g[c0] * (1.0f + m[1024 + c0]) + m[c0];
      const float h1 = v[2 * j + 1] * rstd * g[c0 + 1] * (1.0f + m[1024 + c0 + 1]) + m[c0 + 1];
      pk[j] = pack2(h0, h1);
    }
    u32x4* d = (u32x4*)(hb + (size_t)row * 1024 + lane * 16);
    d[0] = u32x4{pk[0], pk[1], pk[2], pk[3]};
    d[1] = u32x4{pk[4], pk[5], pk[6], pk[7]};
    if (zero_o) {
      float* o = (row < T_LAT) ? (p.out + (size_t)row * 1024) : ((float*)(p.ws + OFF_OCTX) + (size_t)(row - T_LAT) * 1024);
      const f32x4 z = {0.f, 0.f, 0.f, 0.f};
#pragma unroll
      for (int q = 0; q < 4; ++q) *(f32x4*)(o + lane * 16 + q * 4) = z;
    }
  }
}

constexpr int LDT = 72;
#ifndef REP_GEMM
#define REP_GEMM 1
#endif
#ifndef REP_SCAN
#define REP_SCAN 1
#endif
#ifndef REP_ATTN
#define REP_ATTN 1
#endif
template <int EPI>
DI void phase_gemm(const Params& p, char* smem, const u16* __restrict__ A, const u16* __restrict__ Bt, int Mtiles, int Ntiles, int Mbase = 0) {
  const int TIDX = ltid();
  u16* As0 = (u16*)smem;
  const int tid = TIDX, lane = tid & 63, wv = __builtin_amdgcn_readfirstlane(tid >> 6);
  const int r = lane & 31, h = lane >> 5;
  const int wm = wv >> 1, wn = wv & 1;
  const int ntiles = Mtiles * Ntiles;
  const int npad = (ntiles + 511) & ~511;
  int repg = (EPI == 0 || EPI == 2) ? REP_GEMM : 1; asm volatile("" : "+s"(repg));
  for (int rp = 0; rp < repg; ++rp)
  for (int tt = blockIdx.x; tt < npad; tt += gridDim.x) {
    const int tile = (tt & ~511) + ((tt & 7) << 6) + ((tt >> 3) & 63);
    if (tile >= ntiles) continue;
    const int band = tile / (4 * Ntiles), rem = tile % (4 * Ntiles);
    const int mt_ = band * 4 + (rem & 3), nt_ = rem >> 2;
    const int m0 = (Mbase + mt_) * 128, n0 = nt_ * 128;
    f32x16 acc[2][2];
#pragma unroll
    for (int a = 0; a < 2; ++a)
#pragma unroll
      for (int b = 0; b < 2; ++b)
#pragma unroll
        for (int i = 0; i < 16; ++i) acc[a][b][i] = 0.f;
    u32x4 ra[4], rb[4];
    const u16* Ag = A + (size_t)m0 * 1024;
    const u16* Bg = Bt + (size_t)n0 * 1024;
#pragma unroll
    for (int i = 0; i < 4; ++i) {
      const int id = tid + 256 * i; const int row = id >> 3, cc = id & 7;
      ra[i] = *(const u32x4*)(Ag + (size_t)row * 1024 + cc * 8);
      rb[i] = *(const u32x4*)(Bg + (size_t)row * 1024 + cc * 8);
    }
    __syncthreads();
    for (int kt = 0; kt < 16; ++kt) {
      u16* As = As0 + (kt & 1) * (256 * LDT);
      u16* Bs = As + 128 * LDT;
#pragma unroll
      for (int i = 0; i < 4; ++i) {
        const int id = tid + 256 * i; const int row = id >> 3, cc = id & 7;
        *(u32x4*)(As + row * LDT + cc * 8) = ra[i];
        *(u32x4*)(Bs + row * LDT + cc * 8) = rb[i];
      }
      __syncthreads();
      if (kt + 1 < 16) {
#pragma unroll
        for (int i = 0; i < 4; ++i) {
          const int id = tid + 256 * i; const int row = id >> 3, cc = id & 7;
          ra[i] = *(const u32x4*)(Ag + (size_t)row * 1024 + (kt + 1) * 64 + cc * 8);
          rb[i] = *(const u32x4*)(Bg + (size_t)row * 1024 + (kt + 1) * 64 + cc * 8);
        }
      }
#pragma unroll
      for (int ks = 0; ks < 4; ++ks) {
        bf16x8 fa[2], fb[2];
#pragma unroll
        for (int t = 0; t < 2; ++t) {
          fa[t] = *(const bf16x8*)(As + (wm * 64 + t * 32 + r) * LDT + ks * 16 + 8 * h);
          fb[t] = *(const bf16x8*)(Bs + (wn * 64 + t * 32 + r) * LDT + ks * 16 + 8 * h);
        }
#pragma unroll
        for (int a = 0; a < 2; ++a)
#pragma unroll
          for (int b = 0; b < 2; ++b) acc[a][b] = MFMA32(fa[a], fb[b], acc[a][b]);
      }
    }
#pragma unroll
    for (int a = 0; a < 2; ++a)
#pragma unroll
      for (int b = 0; b < 2; ++b) {
        const int col = n0 + wn * 64 + b * 32 + r;
        const int rbase = m0 + wm * 64 + a * 32;
        if (EPI == 0) {
          u16* C = (u16*)(p.ws + OFF_PROJ);
#pragma unroll
          for (int i = 0; i < 16; ++i) C[(size_t)(rbase + crow(i, h)) * N0 + col] = f2bf(acc[a][b][i]);
        } else if (EPI == 1) {
          const float* mod = (const float*)(p.ws + OFF_MOD);
#pragma unroll
          for (int i = 0; i < 16; ++i) {
            const int row = rbase + crow(i, h);
            if (row < T_LAT) {
              const float gate = mod[(row >> 13) * 3072 + 2048 + col];
              p.out[(size_t)row * 1024 + col] = p.x[(size_t)row * 1024 + col] + gate * acc[a][b][i];
            } else {
              const int rc = row - T_LAT;
              const float gate = mod[2 * 3072 + 2048 + col];
              ((float*)(p.ws + OFF_XC1))[(size_t)rc * 1024 + col] = p.ctx[(size_t)rc * 1024 + col] + gate * acc[a][b][i];
            }
          }
        } else if (EPI == 2) {
          if (n0 < 2048) {
            u16* C = (u16*)(p.ws + OFF_RAW);
#pragma unroll
            for (int i = 0; i < 16; ++i) C[(size_t)(rbase + crow(i, h)) * 2048 + col] = f2bf(acc[a][b][i]);
          } else if (n0 < 3072) {
            u16* Vt = (u16*)(p.ws + OFF_VT);
            const int e = col - 2048;
#pragma unroll
            for (int g = 0; g < 4; ++g) {
              const int row = rbase + 8 * g + 4 * h;
              int bb, pp;
              if (row < T_LAT) { bb = row >> 13; pp = 256 + (row & 8191); } else { bb = (row - T_LAT) >> 8; pp = (row - T_LAT) & 255; }
              u32x2 v = {cvtpk(acc[a][b][4 * g], acc[a][b][4 * g + 1]), cvtpk(acc[a][b][4 * g + 2], acc[a][b][4 * g + 3])};
              const int q4 = (pp >> 2) & 3;
              const int pq = (pp & ~15) | ((((q4 & 1) << 1) | (q4 >> 1)) << 2);
              *(u32x2*)(Vt + ((size_t)bb * 1024 + e) * LKV + pq) = v;
            }
          } else {
            u16* G = (u16*)(p.ws + OFF_GB);
#pragma unroll
            for (int i = 0; i < 16; ++i) {
              const int row = rbase + crow(i, h);
              if (row < T_LAT) G[(size_t)row * 1024 + col - 3072] = f2bf(siluf_(acc[a][b][i]));
            }
          }
        } else {
          const float* mod = (const float*)(p.ws + OFF_MOD) + 3 * 3072;
#pragma unroll
          for (int i = 0; i < 16; ++i) {
            const int row = rbase + crow(i, h);
            const float gate = mod[(row >> 13) * 3072 + 2048 + col];
            float* o = p.out + (size_t)row * 1024 + col;
            *o = *o + gate * acc[a][b][i];
          }
        }
      }
  }
}

template <int EPI>
DI void phase_gemm_wide(const Params& p, char* smem, const u16* __restrict__ A, const u16* __restrict__ Bt, int Mtiles, int Ntiles, int Mbase = 0) {
  const int TIDX = ltid();
  u16* As = (u16*)smem;
  u16* Bs = As + 128 * LDT;
  const int tid = TIDX, lane = tid & 63, wv = __builtin_amdgcn_readfirstlane(tid >> 6);
  const int r = lane & 31, h = lane >> 5;
  const int wm = wv >> 1, wn = wv & 1;
  const int ntiles = Mtiles * Ntiles;
  const int npad = (ntiles + 511) & ~511;
  int repg = (EPI == 0 || EPI == 2) ? REP_GEMM : 1; asm volatile("" : "+s"(repg));
  for (int rp = 0; rp < repg; ++rp)
  for (int tt = blockIdx.x; tt < npad; tt += gridDim.x) {
    const int tile = (tt & ~511) + ((tt & 7) << 6) + ((tt >> 3) & 63);
    if (tile >= ntiles) continue;
    const int band = tile / (4 * Ntiles), rem = tile % (4 * Ntiles);
    const int mt_ = band * 4 + (rem & 3), nt_ = rem >> 2;
    const int m0 = (Mbase + mt_) * 128, n0 = nt_ * 256;
    f32x16 acc[2][4];
#pragma unroll
    for (int a = 0; a < 2; ++a)
#pragma unroll
      for (int b = 0; b < 4; ++b)
#pragma unroll
        for (int i = 0; i < 16; ++i) acc[a][b][i] = 0.f;
    u32x4 ra[4], rb[8];
    const u16* Ag = A + (size_t)m0 * 1024;
    const u16* Bg = Bt + (size_t)n0 * 1024;
#pragma unroll
    for (int i = 0; i < 8; ++i) {
      const int id = tid + 256 * i; const int row = id >> 3, cc = id & 7;
      if (i < 4) ra[i] = *(const u32x4*)(Ag + (size_t)row * 1024 + cc * 8);
      rb[i] = *(const u32x4*)(Bg + (size_t)row * 1024 + cc * 8);
    }
    for (int kt = 0; kt < 16; ++kt) {
      __syncthreads();
      int ts = tid; asm volatile("" : "+v"(ts));
#pragma unroll
      for (int i = 0; i < 8; ++i) {
        const int id = ts + 256 * i; const int row = id >> 3, cc = id & 7;
        if (i < 4) *(u32x4*)(As + row * LDT + cc * 8) = ra[i];
        *(u32x4*)(Bs + row * LDT + cc * 8) = rb[i];
      }
      __syncthreads();
      if (kt + 1 < 16) {
        int tl = tid; asm volatile("" : "+v"(tl));
#pragma unroll
        for (int i = 0; i < 8; ++i) {
          const int id = tl + 256 * i; const int row = id >> 3, cc = id & 7;
          if (i < 4) ra[i] = *(const u32x4*)(Ag + (size_t)row * 1024 + (kt + 1) * 64 + cc * 8);
          rb[i] = *(const u32x4*)(Bg + (size_t)row * 1024 + (kt + 1) * 64 + cc * 8);
        }
      }
#pragma unroll
      for (int ks = 0; ks < 4; ++ks) {
        bf16x8 fa[2], fb[4];
#pragma unroll
        for (int t = 0; t < 2; ++t) fa[t] = *(const bf16x8*)(As + (wm * 64 + t * 32 + r) * LDT + ks * 16 + 8 * h);
#pragma unroll
        for (int t = 0; t < 4; ++t) fb[t] = *(const bf16x8*)(Bs + (wn * 128 + t * 32 + r) * LDT + ks * 16 + 8 * h);
#pragma unroll
        for (int a = 0; a < 2; ++a)
#pragma unroll
          for (int b = 0; b < 4; ++b) acc[a][b] = MFMA32(fa[a], fb[b], acc[a][b]);
      }
    }
#pragma unroll
    for (int a = 0; a < 2; ++a)
#pragma unroll
      for (int b = 0; b < 4; ++b) {
        const int col = n0 + wn * 128 + b * 32 + r;
        const int rbase = m0 + wm * 64 + a * 32;
        if (EPI == 0) {
          u16* C = (u16*)(p.ws + OFF_PROJ);
#pragma unroll
          for (int i = 0; i < 16; ++i) C[(size_t)(rbase + crow(i, h)) * N0 + col] = f2bf(acc[a][b][i]);
        } else if (EPI == 1) {
          const float* mod = (const float*)(p.ws + OFF_MOD);
#pragma unroll
          for (int i = 0; i < 16; ++i) {
            const int row = rbase + crow(i, h);
            if (row < T_LAT) {
              const float gate = mod[(row >> 13) * 3072 + 2048 + col];
              p.out[(size_t)row * 1024 + col] = p.x[(size_t)row * 1024 + col] + gate * acc[a][b][i];
            } else {
              const int rc = row - T_LAT;
              const float gate = mod[2 * 3072 + 2048 + col];
              ((float*)(p.ws + OFF_XC1))[(size_t)rc * 1024 + col] = p.ctx[(size_t)rc * 1024 + col] + gate * acc[a][b][i];
            }
          }
        } else if (EPI == 2) {
          if (n0 < 2048) {
            u16* C = (u16*)(p.ws + OFF_RAW);
#pragma unroll
            for (int i = 0; i < 16; ++i) C[(size_t)(rbase + crow(i, h)) * 2048 + col] = f2bf(acc[a][b][i]);
          } else if (n0 < 3072) {
            u16* Vt = (u16*)(p.ws + OFF_VT);
            const int e = col - 2048;
#pragma unroll
            for (int g = 0; g < 4; ++g) {
              const int row = rbase + 8 * g + 4 * h;
              int bb, pp;
              if (row < T_LAT) { bb = row >> 13; pp = 256 + (row & 8191); } else { bb = (row - T_LAT) >> 8; pp = (row - T_LAT) & 255; }
              u32x2 v = {cvtpk(acc[a][b][4 * g], acc[a][b][4 * g + 1]), cvtpk(acc[a][b][4 * g + 2], acc[a][b][4 * g + 3])};
              const int q4 = (pp >> 2) & 3;
              const int pq = (pp & ~15) | ((((q4 & 1) << 1) | (q4 >> 1)) << 2);
              *(u32x2*)(Vt + ((size_t)bb * 1024 + e) * LKV + pq) = v;
            }
          } else {
            u16* G = (u16*)(p.ws + OFF_GB);
#pragma unroll
            for (int i = 0; i < 16; ++i) {
              const int row = rbase + crow(i, h);
              if (row < T_LAT) G[(size_t)row * 1024 + col - 3072] = f2bf(siluf_(acc[a][b][i]));
            }
          }
        } else {
          const float* mod = (const float*)(p.ws + OFF_MOD) + 3 * 3072;
#pragma unroll
          for (int i = 0; i < 16; ++i) {
            const int row = rbase + crow(i, h);
            const float gate = mod[(row >> 13) * 3072 + 2048 + col];
            float* o = p.out + (size_t)row * 1024 + col;
            *o = *o + gate * acc[a][b][i];
          }
        }
      }
  }
}

constexpr int LDW = 80;
template <int EPI>
DI void phase_gemm_wide16(const Params& p, char* smem, const u16* __restrict__ A, const u16* __restrict__ Bt, int Mtiles, int Ntiles, int Mbase = 0) {
  const int TIDX = ltid();
  u16* As = (u16*)smem;
  u16* Bs = As + 128 * LDW;
  const int tid = TIDX, lane = tid & 63, wv = __builtin_amdgcn_readfirstlane(tid >> 6);
  const int lr = lane & 15, lq = lane >> 4;
  const int wm = wv >> 1, wn = wv & 1;
  const int ntiles = Mtiles * Ntiles;
  const int npad = (ntiles + 511) & ~511;
  for (int tt = blockIdx.x; tt < npad; tt += gridDim.x) {
    const int tile = (tt & ~511) + ((tt & 7) << 6) + ((tt >> 3) & 63);
    if (tile >= ntiles) continue;
    const int band = tile / (4 * Ntiles), rem = tile % (4 * Ntiles);
    const int mt_ = band * 4 + (rem & 3), nt_ = rem >> 2;
    const int m0 = (Mbase + mt_) * 128, n0 = nt_ * 256;
    f32x4 acc[4][8];
#pragma unroll
    for (int t = 0; t < 4; ++t)
#pragma unroll
      for (int u = 0; u < 8; ++u) acc[t][u] = f32x4{0.f, 0.f, 0.f, 0.f};
    u32x4 ra[4], rb[8];
    const u16* Ag = A + (size_t)m0 * 1024;
    const u16* Bg = Bt + (size_t)n0 * 1024;
#pragma unroll
    for (int i = 0; i < 8; ++i) {
      const int id = tid + 256 * i; const int row = id >> 3, cc = id & 7;
      if (i < 4) ra[i] = *(const u32x4*)(Ag + (size_t)row * 1024 + cc * 8);
      rb[i] = *(const u32x4*)(Bg + (size_t)row * 1024 + cc * 8);
    }
    for (int kt = 0; kt < 16; ++kt) {
      __syncthreads();
      int ts = tid; asm volatile("" : "+v"(ts));
#pragma unroll
      for (int i = 0; i < 8; ++i) {
        const int id = ts + 256 * i; const int row = id >> 3, cc = id & 7;
        if (i < 4) *(u32x4*)(As + row * LDW + cc * 8) = ra[i];
        *(u32x4*)(Bs + row * LDW + cc * 8) = rb[i];
      }
      __syncthreads();
      if (kt + 1 < 16) {
        int tl = tid; asm volatile("" : "+v"(tl));
#pragma unroll
        for (int i = 0; i < 8; ++i) {
          const int id = tl + 256 * i; const int row = id >> 3, cc = id & 7;
          if (i < 4) ra[i] = *(const u32x4*)(Ag + (size_t)row * 1024 + (kt + 1) * 64 + cc * 8);
          rb[i] = *(const u32x4*)(Bg + (size_t)row * 1024 + (kt + 1) * 64 + cc * 8);
        }
      }
#pragma unroll
      for (int ks = 0; ks < 2; ++ks) {
        bf16x8 fa[4], fb[8];
#pragma unroll
        for (int t = 0; t < 4; ++t) fa[t] = *(const bf16x8*)(As + (wm * 64 + t * 16 + lr) * LDW + ks * 32 + lq * 8);
#pragma unroll
        for (int u = 0; u < 8; ++u) fb[u] = *(const bf16x8*)(Bs + (wn * 128 + u * 16 + lr) * LDW + ks * 32 + lq * 8);
#pragma unroll
        for (int t = 0; t < 4; ++t)
#pragma unroll
          for (int u = 0; u < 8; ++u) acc[t][u] = MFMA16(fa[t], fb[u], acc[t][u]);
      }
    }
#pragma unroll
    for (int t = 0; t < 4; ++t)
#pragma unroll
      for (int u = 0; u < 8; ++u) {
        const int col = n0 + wn * 128 + u * 16 + lr;
        const int row0 = m0 + wm * 64 + t * 16 + 4 * lq;
        if (EPI == 0) {
          u16* C = (u16*)(p.ws + OFF_PROJ);
#pragma unroll
          for (int g = 0; g < 4; ++g) C[(size_t)(row0 + g) * N0 + col] = f2bf(acc[t][u][g]);
        } else if (EPI == 1) {
          const float* mod = (const float*)(p.ws + OFF_MOD);
#pragma unroll
          for (int g = 0; g < 4; ++g) {
            const int row = row0 + g;
            if (row < T_LAT) {
              const float gate = mod[(row >> 13) * 3072 + 2048 + col];
              p.out[(size_t)row * 1024 + col] = p.x[(size_t)row * 1024 + col] + gate * acc[t][u][g];
            } else {
              const int rc = row - T_LAT;
              const float gate = mod[2 * 3072 + 2048 + col];
              ((float*)(p.ws + OFF_XC1))[(size_t)rc * 1024 + col] = p.ctx[(size_t)rc * 1024 + col] + gate * acc[t][u][g];
            }
          }
        } else if (EPI == 3) {
          const float* mod = (const float*)(p.ws + OFF_MOD) + 3 * 3072;
#pragma unroll
          for (int g = 0; g < 4; ++g) {
            const int row = row0 + g;
            const float gate = mod[(row >> 13) * 3072 + 2048 + col];
            float* o = p.out + (size_t)row * 1024 + col;
            *o = *o + gate * acc[t][u][g];
          }
        } else {
          if (n0 < 2048) {
            u16* C = (u16*)(p.ws + OFF_RAW);
#pragma unroll
            for (int g = 0; g < 4; ++g) C[(size_t)(row0 + g) * 2048 + col] = f2bf(acc[t][u][g]);
          } else if (n0 < 3072) {
            u16* Vt = (u16*)(p.ws + OFF_VT);
            const int e = col - 2048;
            int bb, pp;
            if (row0 < T_LAT) { bb = row0 >> 13; pp = 256 + (row0 & 8191); } else { bb = (row0 - T_LAT) >> 8; pp = (row0 - T_LAT) & 255; }
            u32x2 v = {cvtpk(acc[t][u][0], acc[t][u][1]), cvtpk(acc[t][u][2], acc[t][u][3])};
            const int q4 = (pp >> 2) & 3;
            const int pq = (pp & ~15) | ((((q4 & 1) << 1) | (q4 >> 1)) << 2);
            *(u32x2*)(Vt + ((size_t)bb * 1024 + e) * LKV + pq) = v;
          } else {
            u16* G = (u16*)(p.ws + OFF_GB);
#pragma unroll
            for (int g = 0; g < 4; ++g)
              if (row0 + g < T_LAT) G[(size_t)(row0 + g) * 1024 + col - 3072] = f2bf(siluf_(acc[t][u][g]));
          }
        }
      }
  }
}

DI void tokmap(int pos, int d, int b, int& row, bool& hp, bool& hn) {
  if (pos < 256) { const int t = d ? 255 - pos : pos; row = T_LAT + b * 256 + t; hp = t > 0; hn = t < 255; }
  else { const int q = pos - 256; const int t = d ? 8191 - q : q; row = b * 8192 + t; hp = t > 0; hn = t < 8191; }
}

DI void load_mix8(const u16* pr, bool hp, bool hn, const float* mu, float* out) {
  const u32x4 uc = *(const u32x4*)pr;
  u32x4 up = {0u, 0u, 0u, 0u}, un = {0u, 0u, 0u, 0u};
  if (hp) up = *(const u32x4*)(pr - N0);
  if (hn) un = *(const u32x4*)(pr + N0);
  float c[8], a[8], n[8];
  unpack8(uc, c); unpack8(up, a); unpack8(un, n);
  const f32x4 m0 = *(const f32x4*)mu, m1 = *(const f32x4*)(mu + 4);
#pragma unroll
  for (int j = 0; j < 8; ++j) {
    const float m = j < 4 ? m0[j & 3] : m1[j & 3];
    out[j] = c[j] + m * (0.5f * (a[j] + n[j]) - c[j]);
  }
}

DI void mixraw8(const u32x4& uc, const u32x4& up, const u32x4& un, bool hp, bool hn, const float* mu, float* out) {
  float c[8], a[8], n[8];
  unpack8(uc, c); unpack8(up, a); unpack8(un, n);
  const f32x4 m0 = *(const f32x4*)mu, m1 = *(const f32x4*)(mu + 4);
#pragma unroll
  for (int j = 0; j < 8; ++j) {
    const float m = j < 4 ? m0[j & 3] : m1[j & 3];
    const float av = hp ? a[j] : 0.f, nv = hn ? n[j] : 0.f;
    out[j] = c[j] + m * (0.5f * (av + nv) - c[j]);
  }
}

template <int PASS>
DI void phase_scan(const Params& p, char* smem) {
  const int TIDX = ltid();
  const int lane = TIDX & 63, wv = __builtin_amdgcn_readfirstlane(TIDX >> 6);
  float* sm = (float*)smem + wv * 3584;
  float* sW = sm; float* sKK = sm + 512; float* sKKA = sm + 1024; float* sKD = sm + 1536; float* sR = sm + 2048; float* sV = sm + 2560; float* sA = sm + 3072;
  const u16* proj = (const u16*)(p.ws + OFF_PROJ);
  float* stP = (float*)(p.ws + OFF_STP);
  float* stS = (float*)(p.ws + OFF_STS);
  float* bonus = (float*)(p.ws + OFF_BONUS);
  const int nwaves = gridDim.x * 4;
  int reps = (PASS == 1) ? REP_SCAN : 1; asm volatile("" : "+s"(reps));
  for (int rp = 0; rp < reps; ++rp)
  for (int item = blockIdx.x * 4 + wv; item < 2048; item += nwaves) {
    const int chain = item >> 5, chunk = item & 31;
    const int d = chain & 1, hh = (chain >> 1) & 15, b = chain >> 5;
    u16* cB = (u16*)(smem + 57344);
    float* cP = (float*)(smem + 57344 + 18432);
    __syncthreads();
    {
      const int tid = TIDX;
#pragma unroll
      for (int i = 0; i < 4; ++i) {
        const int id = tid + 256 * i;
        const int which = id >> 9, row = (id >> 3) & 63, cc = id & 7;
        const u16* src = (const u16*)(p.ws + (which ? OFF_A2T : OFF_W2T)) + ((size_t)d * 1024 + hh * 64 + row) * 64 + cc * 8;
        *(u32x4*)(cB + (which * 64 + row) * 72 + cc * 8) = *(const u32x4*)src;
      }
      if (tid < 160) {
        const int a = tid >> 4, q = (tid & 15) * 4;
        const float* src;
        switch (a) {
          case 0: src = p.rw_mu + 3072 + d * 64; break;
          case 1: src = p.rw_mu + 3072 + 128 + d * 64; break;
          case 2: src = p.rw_mu + hh * 64; break;
          case 3: src = p.rw_mu + 1024 + hh * 64; break;
          case 4: src = p.rw_mu + 2048 + hh * 64; break;
          case 5: src = p.rw_w0 + d * 1024 + hh * 64; break;
          case 6: src = p.rw_a0 + d * 1024 + hh * 64; break;
          case 7: src = p.rw_kk + hh * 64; break;
          case 8: src = p.rw_ka + hh * 64; break;
          default: src = p.rw_rk + hh * 64; break;
        }
        *(f32x4*)(cP + a * 64 + q) = *(const f32x4*)(src + q);
      }
    }
    __syncthreads();
    if (PASS == 1 && chunk == 31) continue;
    f32x16 S[2][2];
    f32x32 P[2];
    {
      int li = lane; asm volatile("" : "+v"(li));
      const int lv = li & 31, lh = li >> 5;
      if (PASS == 1) {
#pragma unroll
        for (int kt = 0; kt < 2; ++kt)
#pragma unroll
          for (int vt = 0; vt < 2; ++vt)
#pragma unroll
            for (int i = 0; i < 16; ++i) {
              S[kt][vt][i] = 0.f;
              P[vt][16 * kt + i] = (32 * kt + (i & 3) + 8 * (i >> 2) + 4 * lh == 32 * vt + lv) ? 1.f : 0.f;
            }
      } else {
        if (chunk == 0) {
#pragma unroll
          for (int kt = 0; kt < 2; ++kt)
#pragma unroll
            for (int vt = 0; vt < 2; ++vt)
#pragma unroll
              for (int i = 0; i < 16; ++i) S[kt][vt][i] = 0.f;
        } else {
          const float* src = stS + (size_t)(item - 1) * 4096;
#pragma unroll
          for (int kt = 0; kt < 2; ++kt)
#pragma unroll
            for (int vt = 0; vt < 2; ++vt)
#pragma unroll
              for (int g = 0; g < 4; ++g) {
                const f32x4 t = *(const f32x4*)(src + (32 * vt + lv) * 64 + 32 * kt + 8 * g + 4 * lh);
                S[kt][vt][4 * g] = t[0]; S[kt][vt][4 * g + 1] = t[1]; S[kt][vt][4 * g + 2] = t[2]; S[kt][vt][4 * g + 3] = t[3];
              }
        }
      }
    }
    for (int sc = 0; sc < NSUB; ++sc) {
      const int p0 = chunk * LCH + sc * 8;
      int ln = lane; asm volatile("" : "+v"(ln));
      u32x4 rawA[2][3], rawB[3][3];
      bool hpA, hnA, hpB, hnB; int rowB;
      {
        int rowA; tokmap(p0 + (ln & 7), d, b, rowA, hpA, hnA);
        const u16* prA = proj + (size_t)rowA * N0 + 4096 + d * 64 + (ln >> 4) * 8 + ((ln >> 3) & 1) * 32;
        const ptrdiff_t dpA = hpA ? -N0 : 0, dnA = hnA ? N0 : 0;
#pragma unroll
        for (int X = 0; X < 2; ++X) {
          const u16* q = prA + X * 128;
          rawA[X][0] = *(const u32x4*)q; rawA[X][1] = *(const u32x4*)(q + dpA); rawA[X][2] = *(const u32x4*)(q + dnA);
        }
        tokmap(p0 + (ln >> 3), d, b, rowB, hpB, hnB);
        const u16* prB = proj + (size_t)rowB * N0 + hh * 64 + (ln & 7) * 8;
        const ptrdiff_t dpB = hpB ? -N0 : 0, dnB = hnB ? N0 : 0;
#pragma unroll
        for (int X = (PASS == 2 ? 0 : 1); X < 3; ++X) {
          const u16* q = prB + X * 1024;
          rawB[X][0] = *(const u32x4*)q; rawB[X][1] = *(const u32x4*)(q + dpB); rawB[X][2] = *(const u32x4*)(q + dnB);
        }
      }
      {
        const int m = ln & 15, kg = ln >> 4;
        bf16x8 fa[2][2];
        const int ssel = (m >> 3) & 1;
#pragma unroll
        for (int X = 0; X < 2; ++X) {
          float mx[8];
          mixraw8(rawA[X][0], rawA[X][1], rawA[X][2], hpA, hnA, cP + X * 64 + ssel * 32 + kg * 8, mx);
          if (X == 0) {
#pragma unroll
            for (int j = 0; j < 8; ++j) { const float e = __expf(2.0f * mx[j]); mx[j] = 1.0f - 2.0f * __builtin_amdgcn_rcpf(e + 1.0f); }
          }
          u32x4 own = {cvtpk(mx[0], mx[1]), cvtpk(mx[2], mx[3]), cvtpk(mx[4], mx[5]), cvtpk(mx[6], mx[7])};
          u32x4 oth;
#pragma unroll
          for (int q = 0; q < 4; ++q) oth[q] = (unsigned)__shfl_down((int)own[q], 8);
          fa[X][0] = __builtin_bit_cast(bf16x8, own);
          fa[X][1] = __builtin_bit_cast(bf16x8, ssel ? own : oth);
        }
#pragma unroll
        for (int nt = 0; nt < 4; ++nt) {
          f32x4 aw = {0.f, 0.f, 0.f, 0.f}, aa = {0.f, 0.f, 0.f, 0.f};
#pragma unroll
          for (int s = 0; s < 2; ++s) {
            const bf16x8 bw = *(const bf16x8*)(cB + (16 * nt + m) * 72 + s * 32 + kg * 8);
            const bf16x8 ba = *(const bf16x8*)(cB + (64 + 16 * nt + m) * 72 + s * 32 + kg * 8);
            aw = MFMA16(fa[0][s], bw, aw);
            aa = MFMA16(fa[1][s], ba, aa);
          }
          const int ch = 16 * nt + m;
          const float w0 = cP[5 * 64 + ch];
          const float a0 = cP[6 * 64 + ch];
          if (kg < 2) {
#pragma unroll
            for (int rg = 0; rg < 4; ++rg) {
              sW[(4 * kg + rg) * 64 + ch] = w0 + aw[rg];
              sA[(4 * kg + rg) * 64 + ch] = a0 + aa[rg];
            }
          }
        }
      }
      WAVE_LDS_SYNC();
      __builtin_amdgcn_sched_barrier(0);
      {
        const int tk = ln >> 3, g = ln & 7;
        const int row = rowB;
        const int cb = hh * 64 + g * 8;
        float rr[8], kk[8], vv[8];
        if (PASS == 2) mixraw8(rawB[0][0], rawB[0][1], rawB[0][2], hpB, hnB, cP + 2 * 64 + g * 8, rr);
        else { for (int j = 0; j < 8; ++j) rr[j] = 0.f; }
        mixraw8(rawB[1][0], rawB[1][1], rawB[1][2], hpB, hnB, cP + 3 * 64 + g * 8, kk);
        mixraw8(rawB[2][0], rawB[2][1], rawB[2][2], hpB, hnB, cP + 4 * 64 + g * 8, vv);
        float av[8], kkn[8], kd[8], pkkv[8], pkav[8], prkv[8];
        { const f32x4 t0 = *(const f32x4*)(sA + tk * 64 + g * 8), t1 = *(const f32x4*)(sA + tk * 64 + g * 8 + 4);
          av[0] = fsig(t0[0]); av[1] = fsig(t0[1]); av[2] = fsig(t0[2]); av[3] = fsig(t0[3]); av[4] = fsig(t1[0]); av[5] = fsig(t1[1]); av[6] = fsig(t1[2]); av[7] = fsig(t1[3]); }
        { const f32x4 t0 = *(const f32x4*)(sW + tk * 64 + g * 8), t1 = *(const f32x4*)(sW + tk * 64 + g * 8 + 4);
          f32x4 o0, o1;
#pragma unroll
          for (int j = 0; j < 4; ++j) { o0[j] = __expf(-0.6065306597126334f * fsig(t0[j])); o1[j] = __expf(-0.6065306597126334f * fsig(t1[j])); }
          *(f32x4*)(sW + tk * 64 + g * 8) = o0; *(f32x4*)(sW + tk * 64 + g * 8 + 4) = o1; }
        WAVE_LDS_SYNC();
        { float Wc = 1.0f;
#pragma unroll
          for (int j = 0; j < 8; ++j) { Wc *= sW[j * 64 + ln]; sW[j * 64 + ln] = Wc; } }
        WAVE_LDS_SYNC();
        float wcur[8], wprv[8];
        { const f32x4 t0 = *(const f32x4*)(sW + tk * 64 + g * 8), t1 = *(const f32x4*)(sW + tk * 64 + g * 8 + 4);
          const int tp = tk > 0 ? tk - 1 : 0;
          const f32x4 u0 = *(const f32x4*)(sW + tp * 64 + g * 8), u1 = *(const f32x4*)(sW + tp * 64 + g * 8 + 4);
#pragma unroll
          for (int j = 0; j < 4; ++j) { wcur[j] = t0[j]; wcur[j + 4] = t1[j]; wprv[j] = tk > 0 ? u0[j] : 1.0f; wprv[j + 4] = tk > 0 ? u1[j] : 1.0f; } }
        { const float* q7 = cP + 7 * 64 + g * 8;
          const f32x4 a0 = *(const f32x4*)(q7), a1 = *(const f32x4*)(q7 + 4), b0 = *(const f32x4*)(q7 + 64), b1 = *(const f32x4*)(q7 + 68),
                      c0 = *(const f32x4*)(q7 + 128), c1 = *(const f32x4*)(q7 + 132);
#pragma unroll
          for (int j = 0; j < 4; ++j) { pkkv[j] = a0[j]; pkkv[j + 4] = a1[j]; pkav[j] = b0[j]; pkav[j + 4] = b1[j]; prkv[j] = c0[j]; prkv[j + 4] = c1[j]; } }
        float ss = 0.f, bon = 0.f;
#pragma unroll
        for (int j = 0; j < 8; ++j) {
          kkn[j] = kk[j] * pkkv[j]; ss += kkn[j] * kkn[j];
          kd[j] = kk[j] * (1.0f + (av[j] - 1.0f) * pkav[j]);
          bon += rr[j] * kd[j] * prkv[j];
        }
        ss += __shfl_xor(ss, 1); ss += __shfl_xor(ss, 2); ss += __shfl_xor(ss, 4);
        const float inv = rsqrtf(ss + 1e-12f);
        if (PASS == 2) {
          bon += __shfl_xor(bon, 1); bon += __shfl_xor(bon, 2); bon += __shfl_xor(bon, 4);
          if (g == 0) bonus[(size_t)d * (T_ALL * 16) + (size_t)row * 16 + hh] = bon;
        }
        float iw[8];
#pragma unroll
        for (int j = 0; j < 8; ++j) iw[j] = __builtin_amdgcn_rcpf(wcur[j]);
        float* o;
        o = sKK + tk * 64 + g * 8;
        *(f32x4*)o = f32x4{kkn[0] * inv * wprv[0], kkn[1] * inv * wprv[1], kkn[2] * inv * wprv[2], kkn[3] * inv * wprv[3]};
        *(f32x4*)(o + 4) = f32x4{kkn[4] * inv * wprv[4], kkn[5] * inv * wprv[5], kkn[6] * inv * wprv[6], kkn[7] * inv * wprv[7]};
        o = sKKA + tk * 64 + g * 8;
        *(f32x4*)o = f32x4{kkn[0] * inv * av[0] * iw[0], kkn[1] * inv * av[1] * iw[1], kkn[2] * inv * av[2] * iw[2], kkn[3] * inv * av[3] * iw[3]};
        *(f32x4*)(o + 4) = f32x4{kkn[4] * inv * av[4] * iw[4], kkn[5] * inv * av[5] * iw[5], kkn[6] * inv * av[6] * iw[6], kkn[7] * inv * av[7] * iw[7]};
        o = sKD + tk * 64 + g * 8;
        *(f32x4*)o = f32x4{kd[0] * iw[0], kd[1] * iw[1], kd[2] * iw[2], kd[3] * iw[3]};
        *(f32x4*)(o + 4) = f32x4{kd[4] * iw[4], kd[5] * iw[5], kd[6] * iw[6], kd[7] * iw[7]};
        if (PASS == 2) {
          o = sR + tk * 64 + g * 8;
          *(f32x4*)o = f32x4{rr[0] * wcur[0], rr[1] * wcur[1], rr[2] * wcur[2], rr[3] * wcur[3]};
          *(f32x4*)(o + 4) = f32x4{rr[4] * wcur[4], rr[5] * wcur[5], rr[6] * wcur[6], rr[7] * wcur[7]};
        }
        o = sV + tk * 64 + g * 8;
        *(f32x4*)o = f32x4{vv[0], vv[1], vv[2], vv[3]};
        *(f32x4*)(o + 4) = f32x4{vv[4], vv[5], vv[6], vv[7]};
      }
      WAVE_LDS_SYNC();
      __builtin_amdgcn_sched_barrier(0);
      float* obase = nullptr; ptrdiff_t ostep = d ? -1024 : 1024;
      if (PASS == 2) {
        int row0; bool hp0, hn0; tokmap(p0, d, b, row0, hp0, hn0);
        obase = ((row0 < T_LAT) ? (p.out + (size_t)row0 * 1024) : ((float*)(p.ws + OFF_OCTX) + (size_t)(row0 - T_LAT) * 1024)) + hh * 64 + lane;
      }
      const int lv31 = lane & 31, lh1 = lane >> 5;
#pragma unroll 1
      for (int j = 0; j < 8; ++j) {
        f32x4 kkv[2][4];
#pragma unroll
        for (int kt = 0; kt < 2; ++kt)
#pragma unroll
          for (int g = 0; g < 4; ++g) kkv[kt][g] = *(const f32x4*)(sKK + j * 64 + 32 * kt + 8 * g + 4 * lh1);
        float aop[2], vvv[2];
        const float akka = sKKA[j * 64 + lane];
#pragma unroll
        for (int t = 0; t < 2; ++t) {
          aop[t] = (lh1 ? sKD : sKKA)[j * 64 + 32 * t + lv31];
          vvv[t] = sV[j * 64 + 32 * t + lv31];
        }
        float saS[2], saP[2];
#pragma unroll
        for (int vt = 0; vt < 2; ++vt) {
          f2 a2 = {0.f, 0.f}, b2 = {0.f, 0.f};
#pragma unroll
          for (int kt = 0; kt < 2; ++kt)
#pragma unroll
            for (int g = 0; g < 4; ++g) {
              a2 += f2{S[kt][vt][4 * g], S[kt][vt][4 * g + 1]} * f2{kkv[kt][g][0], kkv[kt][g][1]};
              a2 += f2{S[kt][vt][4 * g + 2], S[kt][vt][4 * g + 3]} * f2{kkv[kt][g][2], kkv[kt][g][3]};
              if (PASS == 1) {
                b2 += f2{P[vt][16 * kt + 4 * g], P[vt][16 * kt + 4 * g + 1]} * f2{kkv[kt][g][0], kkv[kt][g][1]};
                b2 += f2{P[vt][16 * kt + 4 * g + 2], P[vt][16 * kt + 4 * g + 3]} * f2{kkv[kt][g][2], kkv[kt][g][3]};
              }
            }
          float x = a2[0] + a2[1];
          x += __shfl_xor(x, 32);
          saS[vt] = x;
          if (PASS == 1) { float y = b2[0] + b2[1]; y += __shfl_xor(y, 32); saP[vt] = y; }
        }
#pragma unroll
        for (int vt = 0; vt < 2; ++vt) {
          const float bS = lh1 ? vvv[vt] : -saS[vt];
          if (PASS == 1) P[vt] = __builtin_amdgcn_mfma_f32_32x32x1f32(akka, -saP[vt], P[vt], 0, 0, 0);
#pragma unroll
          for (int kt = 0; kt < 2; ++kt) {
            S[kt][vt] = __builtin_amdgcn_mfma_f32_32x32x2f32(aop[kt], bS, S[kt][vt], 0, 0, 0);
          }
        }
        if (PASS == 2) {
          f32x4 rv[2][4];
#pragma unroll
          for (int kt = 0; kt < 2; ++kt)
#pragma unroll
            for (int g = 0; g < 4; ++g) rv[kt][g] = *(const f32x4*)(sR + j * 64 + 32 * kt + 8 * g + 4 * lh1);
          float ov[2];
#pragma unroll
          for (int vt = 0; vt < 2; ++vt) {
            f2 a2 = {0.f, 0.f};
#pragma unroll
            for (int kt = 0; kt < 2; ++kt)
#pragma unroll
              for (int g = 0; g < 4; ++g) {
                a2 += f2{S[kt][vt][4 * g], S[kt][vt][4 * g + 1]} * f2{rv[kt][g][0], rv[kt][g][1]};
                a2 += f2{S[kt][vt][4 * g + 2], S[kt][vt][4 * g + 3]} * f2{rv[kt][g][2], rv[kt][g][3]};
              }
            float x = a2[0] + a2[1];
            x += __shfl_xor(x, 32);
            ov[vt] = x;
          }
          atomicAdd(obase + (ptrdiff_t)j * ostep, lh1 ? ov[1] : ov[0]);
        }
      }
      {
        f32x4 w7[2][4];
#pragma unroll
        for (int kt = 0; kt < 2; ++kt)
#pragma unroll
          for (int g = 0; g < 4; ++g) w7[kt][g] = *(const f32x4*)(sW + 7 * 64 + 32 * kt + 8 * g + 4 * lh1);
#pragma unroll
        for (int kt = 0; kt < 2; ++kt)
#pragma unroll
          for (int vt = 0; vt < 2; ++vt)
#pragma unroll
            for (int i = 0; i < 16; ++i) {
              S[kt][vt][i] *= w7[kt][i >> 2][i & 3];
              if (PASS == 1) P[vt][16 * kt + i] *= w7[kt][i >> 2][i & 3];
            }
      }
      WAVE_LDS_SYNC();
    }
    if (PASS == 1) {
      int li = lane; asm volatile("" : "+v"(li));
      const int lv = li & 31, lh = li >> 5;
      float* dP = stP + (size_t)item * 4096;
      float* dS = stS + (size_t)item * 4096;
#pragma unroll
      for (int kt = 0; kt < 2; ++kt)
#pragma unroll
        for (int vt = 0; vt < 2; ++vt)
#pragma unroll
          for (int g = 0; g < 4; ++g) {
            const int off = (32 * vt + lv) * 64 + 32 * kt + 8 * g + 4 * lh;
            *(f32x4*)(dP + off) = f32x4{P[vt][16 * kt + 4 * g], P[vt][16 * kt + 4 * g + 1], P[vt][16 * kt + 4 * g + 2], P[vt][16 * kt + 4 * g + 3]};
            *(f32x4*)(dS + off) = f32x4{S[kt][vt][4 * g], S[kt][vt][4 * g + 1], S[kt][vt][4 * g + 2], S[kt][vt][4 * g + 3]};
          }
    }
  }
}

DI void phase_carry(const Params& p, char* smem) {
  const int TIDX = ltid();
  float* cur = (float*)smem;
  const int tid = TIDX, lane = tid & 63, w = __builtin_amdgcn_readfirstlane(tid >> 6);
  const int lc = lane & 15, lq = lane >> 4;
  float* stP = (float*)(p.ws + OFF_STP);
  float* stS = (float*)(p.ws + OFF_STS);
  for (int it = blockIdx.x; it < 256; it += gridDim.x) {
    const int chain = it >> 2, rg = it & 3;
    const size_t slot0 = (size_t)chain * 32;
    __syncthreads();
    {
      const int row = tid >> 4, c4 = (tid & 15) * 4;
      const f32x4 t = *(const f32x4*)(stS + (slot0 * 64 + rg * 16 + row) * 64 + c4);
      *(f32x4*)(cur + row * 68 + c4) = t;
    }
    __syncthreads();
    float pn[16]; f32x4 an;
    {
      const float* Pm = stP + (slot0 + 1) * 4096;
#pragma unroll
      for (int s = 0; s < 16; ++s) pn[s] = Pm[(size_t)(4 * s + lq) * 64 + 16 * w + lc];
#pragma unroll
      for (int rr = 0; rr < 4; ++rr) an[rr] = stS[((slot0 + 1) * 64 + rg * 16 + 4 * lq + rr) * 64 + 16 * w + lc];
    }
    for (int c = 1; c < 31; ++c) {
      const size_t slot = slot0 + c;
      float pj[16]; f32x4 acc = an;
#pragma unroll
      for (int s = 0; s < 16; ++s) pj[s] = pn[s];
      if (c + 1 < 31) {
        const float* Pm = stP + (slot + 1) * 4096;
#pragma unroll
        for (int s = 0; s < 16; ++s) pn[s] = Pm[(size_t)(4 * s + lq) * 64 + 16 * w + lc];
#pragma unroll
        for (int rr = 0; rr < 4; ++rr) an[rr] = stS[((slot + 1) * 64 + rg * 16 + 4 * lq + rr) * 64 + 16 * w + lc];
      }
#pragma unroll
      for (int s = 0; s < 16; ++s) {
        const float a = cur[lc * 68 + 4 * s + lq];
        acc = __builtin_amdgcn_mfma_f32_16x16x4f32(a, pj[s], acc, 0, 0, 0);
      }
      __syncthreads();
#pragma unroll
      for (int rr = 0; rr < 4; ++rr) {
        cur[(4 * lq + rr) * 68 + 16 * w + lc] = acc[rr];
        stS[(slot * 64 + rg * 16 + 4 * lq + rr) * 64 + 16 * w + lc] = acc[rr];
      }
      __syncthreads();
    }
  }
  {
    const int nidle = (int)gridDim.x > 256 ? (int)gridDim.x - 256 : 0;
    int t0, tstep;
    if (nidle > 0) { t0 = (int)blockIdx.x - 256; tstep = nidle; if (t0 < 0) t0 = 1 << 30; }
    else { t0 = (int)blockIdx.x; tstep = (int)gridDim.x; }
    __syncthreads();
    for (int t = t0; t < 1280; t += tstep) {
      if (t < 1024) transpose_tile(p.da_in, (u16*)(p.ws + OFF_WT_IN1), 1024, N1, t >> 6, t & 63, (float*)smem);
      else { const int j = t - 1024; transpose_tile(p.da_out, (u16*)(p.ws + OFF_WT_OUT1), 1024, 1024, j >> 4, j & 15, (float*)smem); }
    }
  }
}

DI void phase_readout(const Params& p) {
  const int TIDX = ltid();
  const int lane = TIDX & 63, wv = __builtin_amdgcn_readfirstlane(TIDX >> 6);
  const u16* proj = (const u16*)(p.ws + OFF_PROJ);
  const float* bonus = (const float*)(p.ws + OFF_BONUS);
  u16* hb = (u16*)(p.ws + OFF_HB);
  for (int row = blockIdx.x * 4 + wv; row < T_ALL; row += gridDim.x * 4) {
    const float* o = (row < T_LAT) ? (p.out + (size_t)row * 1024) : ((const float*)(p.ws + OFF_OCTX) + (size_t)(row - T_LAT) * 1024);
    bool hp, hn;
    if (row < T_LAT) { const int t = row & 8191; hp = t > 0; hn = t < 8191; } else { const int t = (row - T_LAT) & 255; hp = t > 0; hn = t < 255; }
    const int c0 = lane * 16, hh = lane >> 2;
    float ov[16];
    float s = 0.f;
#pragma unroll
    for (int q = 0; q < 4; ++q) { const f32x4 t = *(const f32x4*)(o + c0 + q * 4); ov[q * 4] = t[0]; ov[q * 4 + 1] = t[1]; ov[q * 4 + 2] = t[2]; ov[q * 4 + 3] = t[3]; s += t[0] + t[1] + t[2] + t[3]; }
    s += __shfl_xor(s, 1); s += __shfl_xor(s, 2);
    const float mean = s * (1.0f / 64.0f);
    float vs = 0.f;
#pragma unroll
    for (int j = 0; j < 16; ++j) { const float dlt = ov[j] - mean; vs += dlt * dlt; }
    vs += __shfl_xor(vs, 1); vs += __shfl_xor(vs, 2);
    const float rstd = rsqrtf(vs * (1.0f / 64.0f) + 64e-5f);
    const float bon = bonus[(size_t)row * 16 + hh] + bonus[(size_t)(T_ALL * 16) + (size_t)row * 16 + hh];
    float vm[16];
    const u16* pr = proj + (size_t)row * N0;
    load_mix8(pr + 2048 + c0, hp, hn, p.rw_mu + 2048 + c0, vm);
    load_mix8(pr + 2048 + c0 + 8, hp, hn, p.rw_mu + 2048 + c0 + 8, vm + 8);
    float gv[16];
    unpack8(*(const u32x4*)(pr + 3072 + c0), gv);
    unpack8(*(const u32x4*)(pr + 3072 + c0 + 8), gv + 8);
    unsigned pk[8];
#pragma unroll
    for (int j = 0; j < 8; ++j) {
      const int ca = c0 + 2 * j, cb = ca + 1;
      const float ya = ((ov[2 * j] - mean) * rstd * p.rw_gn_g[ca] + p.rw_gn_b[ca] + bon * vm[2 * j]) * siluf_(gv[2 * j]);
      const float yb = ((ov[2 * j + 1] - mean) * rstd * p.rw_gn_g[cb] + p.rw_gn_b[cb] + bon * vm[2 * j + 1]) * siluf_(gv[2 * j + 1]);
      pk[j] = pack2(ya, yb);
    }
    u32x4* dd = (u32x4*)(hb + (size_t)row * 1024 + c0);
    dd[0] = u32x4{pk[0], pk[1], pk[2], pk[3]};
    dd[1] = u32x4{pk[4], pk[5], pk[6], pk[7]};
  }
}

DI void phase_qkprep(const Params& p) {
  const int TIDX = ltid();
  const int lane = TIDX & 63, wv = __builtin_amdgcn_readfirstlane(TIDX >> 6);
  const u16* raw = (const u16*)(p.ws + OFF_RAW);
  u16* Qs = (u16*)(p.ws + OFF_QS);
  u16* Ks = (u16*)(p.ws + OFF_KS);
  const float* rope = (const float*)(p.ws + OFF_ROPE);
  const int grp = lane >> 1, axis = lane & 1;
  const bool isq = grp < 16;
  const int hd = (grp & 15) >> 1, comp = grp & 1;
  const float* gain = (isq ? p.da_qn : p.da_kn) + axis * 32;
  for (int row = blockIdx.x * 4 + wv; row < T_ALL; row += gridDim.x * 4) {
    const bool lat = row < T_LAT;
    int b, t;
    if (lat) { b = row >> 13; t = row & 8191; } else { b = (row - T_LAT) >> 8; t = (row - T_LAT) & 255; }
    const u16* src = raw + (size_t)row * 2048 + lane * 32;
    float v[32];
#pragma unroll
    for (int q = 0; q < 4; ++q) unpack8(*(const u32x4*)(src + q * 8), v + q * 8);
    float ss = 0.f;
#pragma unroll
    for (int j = 0; j < 32; ++j) ss += v[j] * v[j];
    ss += __shfl_xor(ss, 1);
    const float rstd = rsqrtf(ss * (1.0f / 64.0f) + 1e-6f);
#pragma unroll
    for (int j = 0; j < 32; ++j) v[j] = v[j] * rstd * gain[j];
    if (lat) {
      const int pos = axis == 0 ? (t >> 6) : (t & 63);
#pragma unroll
      for (int f = 0; f < 16; ++f) {
        const float c = rope[pos * 16 + f], s = rope[2048 + pos * 16 + f];
        const float x1 = v[f], x2 = v[16 + f];
        v[f] = x1 * c - x2 * s; v[16 + f] = x2 * c + x1 * s;
      }
    }
    u16* dst;
    float sc = 1.0f;
    if (isq) {
      if (!lat) continue;
      sc = 0.125f * 1.4426950408889634f;
      dst = Qs + (((size_t)(b * 8 + hd) * 2 + comp) * 8192 + t) * 64 + axis * 32;
    } else {
      const int pp = lat ? 256 + t : t;
      dst = Ks + (((size_t)(b * 8 + hd) * 2 + comp) * LKV + pp) * 64 + axis * 32;
    }
#pragma unroll
    for (int q = 0; q < 4; ++q) {
      u32x4 o = {pack2(v[q * 8] * sc, v[q * 8 + 1] * sc), pack2(v[q * 8 + 2] * sc, v[q * 8 + 3] * sc),
                 pack2(v[q * 8 + 4] * sc, v[q * 8 + 5] * sc), pack2(v[q * 8 + 6] * sc, v[q * 8 + 7] * sc)};
      *(u32x4*)(dst + q * 8) = o;
    }
  }
}

typedef __attribute__((address_space(3))) unsigned* lds_uptr;
typedef __attribute__((address_space(1))) const unsigned* glb_uptr;
DI void dma16(const void* g, char* ldsbase) {
  __builtin_amdgcn_global_load_lds((glb_uptr)(g), (lds_uptr)(ldsbase), 16, 0, 0);
}

DI void attn_issue_tile(const u16* Kg, const u16* Vg, int k0, char* buf, int wv, int lane) {
  asm volatile("" : "+v"(lane));
  const int rr = lane >> 3, cp = lane & 7;
#pragma unroll
  for (int i = 0; i < 4; ++i) {
    const int seg = wv * 4 + i;
    const int c = seg >> 3, key = (seg & 7) * 8 + rr;
    const int sw = (key >> 1) & 7;
    dma16(Kg + ((size_t)c * LKV + k0 + key) * 64 + ((cp ^ sw) << 3), buf + seg * 1024);
    const int e = seg * 8 + rr;
    const int swv = (e >> 1) & 7;
    dma16(Vg + (size_t)e * LKV + k0 + ((cp ^ swv) << 3), buf + 16384 + seg * 1024);
  }
}

DI void phase_attn(const Params& p, char* smem) {
  const int TIDX = ltid();
  const int tid = TIDX, lane = tid & 63, wv = __builtin_amdgcn_readfirstlane(tid >> 6);
  const int r = lane & 31, h = lane >> 5;
  const u16* Qs = (const u16*)(p.ws + OFF_QS);
  const u16* Ks = (const u16*)(p.ws + OFF_KS);
  const u16* Vt = (const u16*)(p.ws + OFF_VT);
  const u16* GB = (const u16*)(p.ws + OFF_GB);
  u16* Y2 = (u16*)(p.ws + OFF_Y2);
  float lam;
  {
    float a = p.da_lam[lane] * p.da_lam[64 + lane];
    float bq = p.da_lam[128 + lane] * p.da_lam[192 + lane];
#pragma unroll
    for (int o = 32; o >= 1; o >>= 1) { a += __shfl_xor(a, o); bq += __shfl_xor(bq, o); }
    lam = __expf(a) - __expf(bq) + 0.35550906759096927f;
  }
  const float one_m_li = 1.0f - 0.35550906759096927f;
  const int sw = (r >> 1) & 7;
  int repa = REP_ATTN; asm volatile("" : "+s"(repa));
  for (int rp = 0; rp < repa; ++rp)
  for (int item = blockIdx.x; item < 1024; item += gridDim.x) {
    const int bh = (item & 7) * 2 + (item >> 9), qt = (item >> 3) & 63;
    const int q0 = qt * 128 + wv * 32;
    const u16* Kg = Ks + (size_t)bh * 2 * LKV * 64;
    const u16* Vg = Vt + (size_t)bh * 128 * LKV;
    __syncthreads();
    attn_issue_tile(Kg, Vg, 0, smem, wv, lane);
    bf16x8 qf[2][4];
#pragma unroll
    for (int c = 0; c < 2; ++c)
#pragma unroll
      for (int s = 0; s < 4; ++s)
        qf[c][s] = *(const bf16x8*)(Qs + (((size_t)bh * 2 + c) * 8192 + q0 + r) * 64 + s * 16 + 8 * h);
    f32x16 O[2][4];
#pragma unroll
    for (int c = 0; c < 2; ++c)
#pragma unroll
      for (int e = 0; e < 4; ++e)
#pragma unroll
        for (int i = 0; i < 16; ++i) O[c][e][i] = 0.f;
    f2 lsum[2] = {f2{0.f, 0.f}, f2{0.f, 0.f}};
#pragma unroll 1
    for (int kt = 0; kt < LKV / 64; ++kt) {
      char* buf = smem + (kt & 1) * 32768;
      asm volatile("s_waitcnt vmcnt(0)" ::: "memory");
      __syncthreads();
      if (kt + 1 < LKV / 64) attn_issue_tile(Kg, Vg, (kt + 1) * 64, smem + ((kt + 1) & 1) * 32768, wv, lane);
      const char* Kb = buf + r * 128;
      const char* Vb = buf + 16384 + r * 128;
#pragma unroll
      for (int sub = 0; sub < 2; ++sub) {
        f32x16 sacc[2];
#pragma unroll
        for (int c = 0; c < 2; ++c) {
#pragma unroll
          for (int i = 0; i < 16; ++i) sacc[c][i] = 0.f;
#pragma unroll
          for (int s = 0; s < 4; ++s) {
            const bf16x8 kf = *(const bf16x8*)(Kb + c * 8192 + sub * 4096 + (((2 * s + h) ^ sw) << 4));
            sacc[c] = MFMA32(kf, qf[c][s], sacc[c]);
          }
        }
#pragma unroll
        for (int c = 0; c < 2; ++c) {
          bf16x8 pf[2];
#pragma unroll
          for (int s = 0; s < 2; ++s) {
            float ps[8];
#pragma unroll
            for (int i = 0; i < 8; ++i) ps[i] = __builtin_amdgcn_exp2f(sacc[c][8 * s + i]);
            lsum[c] += f2{ps[0], ps[1]}; lsum[c] += f2{ps[2], ps[3]}; lsum[c] += f2{ps[4], ps[5]}; lsum[c] += f2{ps[6], ps[7]};
            u32x4 pk = {cvtpk(ps[0], ps[1]), cvtpk(ps[2], ps[3]), cvtpk(ps[4], ps[5]), cvtpk(ps[6], ps[7])};
            pf[s] = __builtin_bit_cast(bf16x8, pk);
          }
#pragma unroll
          for (int e = 0; e < 4; ++e)
#pragma unroll
            for (int s = 0; s < 2; ++s) {
              const bf16x8 vf = *(const bf16x8*)(Vb + e * 4096 + (((sub * 4 + 2 * s + h) ^ sw) << 4));
              O[c][e] = MFMA32(vf, pf[s], O[c][e]);
            }
        }
      }
    }
    float l0 = lsum[0][0] + lsum[0][1], l1 = lsum[1][0] + lsum[1][1];
    l0 += __shfl_xor(l0, 32); l1 += __shfl_xor(l1, 32);
    const float i0 = 1.0f / l0, i1 = lam / l1;
    float ss = 0.f;
#pragma unroll
    for (int e = 0; e < 4; ++e)
#pragma unroll
      for (int i = 0; i < 16; ++i) { const float o = O[0][e][i] * i0 - O[1][e][i] * i1; O[0][e][i] = o; ss += o * o; }
    ss += __shfl_xor(ss, 32);
    const float rstd = rsqrtf(ss * (1.0f / 128.0f) + 1e-5f) * one_m_li;
    const int b = bh >> 3, hd = bh & 7;
    int rl = r; asm volatile("" : "+v"(rl));
    const size_t row = (size_t)b * 8192 + q0 + rl;
#pragma unroll
    for (int e = 0; e < 4; ++e) {
#pragma unroll
      for (int g = 0; g < 4; ++g) {
        const int ee = e * 32 + 8 * g + 4 * h;
        const u32x2 gg = *(const u32x2*)(GB + row * 1024 + hd * 128 + ee);
        const float g0 = bflo(gg[0]), g1 = bfhi(gg[0]), g2 = bflo(gg[1]), g3 = bfhi(gg[1]);
        const f32x4 sl = *(const f32x4*)(p.da_subln + ee);
        const float y0 = O[0][e][4 * g] * rstd * sl[0] * g0;
        const float y1 = O[0][e][4 * g + 1] * rstd * sl[1] * g1;
        const float y2 = O[0][e][4 * g + 2] * rstd * sl[2] * g2;
        const float y3 = O[0][e][4 * g + 3] * rstd * sl[3] * g3;
        *(u32x2*)(Y2 + row * 1024 + hd * 128 + ee) = u32x2{cvtpk(y0, y1), cvtpk(y2, y3)};
      }
      asm volatile("" ::: "memory");
    }
  }
}

#define XB_TMO      128
#define XB_XCNT(j)  (256  + 64 * (j))
#define XB_XSUB(j)  (1280 + 64 * (j))
#define XB_XGEN(j)  (2304 + 64 * (j))
#define XB_TOP      3328
#define XB_TOPGEN   3392
#define XCD_BAR_WORDS 3456
#define XB_SPIN_CAP (1u << 18)
#define LAS __attribute__((address_space(3)))

__device__ __forceinline__ unsigned xb_ld(unsigned* p)              { return __hip_atomic_load(p, __ATOMIC_RELAXED, __HIP_MEMORY_SCOPE_AGENT); }
__device__ __forceinline__ unsigned xb_add(unsigned* p, unsigned v) { return __hip_atomic_fetch_add(p, v, __ATOMIC_RELAXED, __HIP_MEMORY_SCOPE_AGENT); }
__device__ __forceinline__ unsigned xb_xcc_id() { return (unsigned)__builtin_amdgcn_s_getreg((3 << 11) | 20) & 0xFu; }
#define XB_SPIN(cond, bar) do { unsigned _sp = 0; while (cond) { __builtin_amdgcn_s_sleep(1); \
    if ((++_sp & 255u) == 0u) { if (xb_ld(&(bar)[XB_TMO])) break; if (_sp > XB_SPIN_CAP) { atomicAdd(&(bar)[XB_TMO], 1u); break; } } } } while (0)

struct XcdBarrier {
    unsigned* bar; unsigned x;
    volatile LAS unsigned* st;
};

__device__ __forceinline__ XcdBarrier xcd_barrier_post(unsigned* bar, volatile LAS unsigned* st) {
    XcdBarrier b; b.bar = bar; b.x = xb_xcc_id(); b.st = st;
    if (threadIdx.x == 0) (void)xb_add(&bar[XB_XCNT(b.x)], 1u);
    return b;
}
__device__ __forceinline__ void xcd_barrier_complete(unsigned* bar, unsigned x, unsigned& nloc, unsigned& nx) {
    const unsigned G = gridDim.x * gridDim.y * gridDim.z;
    unsigned sum, cnt, mine, sp = 0u;
    for (;;) {
        sum = 0u; cnt = 0u; mine = 0u;
#pragma unroll
        for (unsigned j = 0; j < 16; ++j) { const unsigned c = xb_ld(&bar[XB_XCNT(j)]); sum += c; cnt += (c > 0u) ? 1u : 0u; mine = (j == x) ? c : mine; }
        if (sum == G) break;
        __builtin_amdgcn_s_sleep(1);
        if ((++sp & 255u) == 0u) { if (xb_ld(&bar[XB_TMO])) break; if (sp > XB_SPIN_CAP) { atomicAdd(&bar[XB_TMO], 1u); break; } }
    }
    nloc = mine > 0u ? mine : 1u; nx = cnt > 0u ? cnt : 1u;
}

__device__ __forceinline__ void xcd_barrier(const XcdBarrier& b) {
    asm volatile("s_waitcnt vmcnt(0)" ::: "memory");
    __syncthreads();
    if (threadIdx.x == 0) {
        unsigned* bar = b.bar;
        __builtin_amdgcn_s_waitcnt(0);
        unsigned nloc = b.st[0], nx = b.st[1];
        if (nloc == 0u) { xcd_barrier_complete(bar, b.x, nloc, nx); b.st[0] = nloc; b.st[1] = nx; }
        const unsigned old = xb_add(&bar[XB_XSUB(b.x)], 1u);
        const unsigned gen = old / nloc;
        if (old + 1u == (gen + 1u) * nloc) {
            __builtin_amdgcn_fence(__ATOMIC_RELEASE, "agent");
            asm volatile("s_waitcnt vmcnt(0)" ::: "memory");
            const unsigned og = xb_add(&bar[XB_TOP], 1u);
            const unsigned tg = og / nx;
            if (og + 1u == (tg + 1u) * nx) xb_add(&bar[XB_TOPGEN], 1u);
            else XB_SPIN(xb_ld(&bar[XB_TOPGEN]) == tg, bar);
            __builtin_amdgcn_fence(__ATOMIC_ACQUIRE, "agent");
            xb_add(&bar[XB_XGEN(b.x)], 1u);
            asm volatile("s_waitcnt vmcnt(0)" ::: "memory");
        } else {
            XB_SPIN(xb_ld(&bar[XB_XGEN(b.x)]) == gen, bar);
            __builtin_amdgcn_fence(__ATOMIC_ACQUIRE, "agent");
            asm volatile("s_waitcnt vmcnt(0)" ::: "memory");
        }
    }
    __syncthreads();
}


__global__ void __launch_bounds__(256, 2) fwd_megakernel(Params p) {
  extern __shared__ __attribute__((aligned(16))) char smem[];
  __shared__ uint4 xb_words;
  cg::grid_group grid = cg::this_grid();
  if (threadIdx.x == 0) xb_words = make_uint4(0u, 0u, 0u, 0u);
  __syncthreads();
  XcdBarrier xb = xcd_barrier_post((unsigned*)(p.ws + OFF_BAR), (volatile LAS unsigned*)&xb_words);
  phase_prep(p, smem);
  if (p.ws == nullptr) grid.sync();
  xcd_barrier(xb);
  phase_normmod(p, 0, p.x, p.ctx, true);
  xcd_barrier(xb);
  phase_gemm_wide16<0>(p, smem, (const u16*)(p.ws + OFF_HB), (const u16*)(p.ws + OFF_WT_IN0), 120, N0 / 256);
  phase_gemm<0>(p, smem, (const u16*)(p.ws + OFF_HB), (const u16*)(p.ws + OFF_WT_IN0), T_ALL / 128 - 120, N0 / 128, 120);
  xcd_barrier(xb);
  phase_scan<1>(p, smem);
  xcd_barrier(xb);
  phase_carry(p, smem);
  xcd_barrier(xb);
  phase_scan<2>(p, smem);
  xcd_barrier(xb);
  phase_readout(p);
  xcd_barrier(xb);
  phase_gemm_wide16<1>(p, smem, (const u16*)(p.ws + OFF_HB), (const u16*)(p.ws + OFF_WT_OUT0), 128, 4);
  phase_gemm<1>(p, smem, (const u16*)(p.ws + OFF_HB), (const u16*)(p.ws + OFF_WT_OUT0), T_ALL / 128 - 128, 8, 128);
  xcd_barrier(xb);
  phase_normmod(p, 1, p.out, (const float*)(p.ws + OFF_XC1), false);
  xcd_barrier(xb);
  phase_gemm_wide16<2>(p, smem, (const u16*)(p.ws + OFF_HB), (const u16*)(p.ws + OFF_WT_IN1), 128, N1 / 256);
  phase_gemm<2>(p, smem, (const u16*)(p.ws + OFF_HB), (const u16*)(p.ws + OFF_WT_IN1), T_ALL / 128 - 128, N1 / 128, 128);
  xcd_barrier(xb);
  phase_qkprep(p);
  xcd_barrier(xb);
  phase_attn(p, smem);
  xcd_barrier(xb);
  phase_gemm_wide16<3>(p, smem, (const u16*)(p.ws + OFF_Y2), (const u16*)(p.ws + OFF_WT_OUT1), T_LAT / 128, 4);
}

extern "C" void kernel_launch(void* const* d_in, const int* in_sizes, int n_in, void* d_out, int out_size, void* d_ws,
                              size_t ws_size, hipStream_t stream) {
  static int grid_blocks = 0;
  if (!grid_blocks) {
    int dev = 0, cus = 0, per_cu = 0;
    hipGetDevice(&dev);
    hipDeviceGetAttribute(&cus, hipDeviceAttributeMultiprocessorCount, dev);
    hipFuncSetAttribute((const void*)fwd_megakernel, hipFuncAttributeMaxDynamicSharedMemorySize, LDS_BYTES);
    hipOccupancyMaxActiveBlocksPerMultiprocessor(&per_cu, fwd_megakernel, 256, LDS_BYTES);
    if (per_cu < 1) per_cu = 1;
    if (per_cu > 2) per_cu = 2;
    grid_blocks = cus * per_cu;
    if (ws_size < 256 * MiB) fprintf(stderr, "kernel_launch: workspace too small: %zu\n", ws_size);
  }
  Params p{};
  const float** pp = (const float**)&p;
  for (int i = 0; i < 25; ++i) pp[i] = (const float*)d_in[i];
  p.out = (float*)d_out;
  p.ws = (char*)d_ws;
  hipMemsetAsync((char*)d_ws + OFF_BAR, 0, XCD_BAR_WORDS * sizeof(unsigned), stream);
  void* args[] = {&p};
  hipError_t e = hipLaunchCooperativeKernel((void*)fwd_megakernel, dim3(grid_blocks), dim3(256), args, LDS_BYTES, stream);
  if (e != hipSuccess) fprintf(stderr, "cooperative launch failed: %s (grid %d)\n", hipGetErrorString(e), grid_blocks);
}
```

```cpp
#include <hip/hip_runtime.h>
#include <hip/hip_cooperative_groups.h>
#include <cstdio>
namespace cg = cooperative_groups;

#define DI __device__ __forceinline__
typedef unsigned short u16;
using bf16x8 = __attribute__((ext_vector_type(8))) short;
using s16x4  = __attribute__((ext_vector_type(4))) short;
using f32x16 = __attribute__((ext_vector_type(16))) float;
using f32x4  = __attribute__((ext_vector_type(4))) float;
using f32x32 = __attribute__((ext_vector_type(32))) float;
using f2     = __attribute__((ext_vector_type(2))) float;
using u32x4  = __attribute__((ext_vector_type(4))) unsigned;
using u32x2  = __attribute__((ext_vector_type(2))) unsigned;

constexpr int T_LAT = 16384, T_CTX = 512, T_ALL = 16896, DM = 1024;
constexpr int N0 = 4352, N1 = 4096;
constexpr int LKV = 8448;
constexpr int NCHUNK = 32, LCH = 264, NSUB = 33;

constexpr size_t MiB = 1048576;
constexpr size_t OFF_WT_IN0 = 0;
constexpr size_t OFF_WT_OUT0 = 8912896;
constexpr size_t OFF_WT_IN1 = 11010048;
constexpr size_t OFF_WT_OUT1 = 19398656;
constexpr size_t OFF_W2T = 21495808;
constexpr size_t OFF_A2T = 21757952;
constexpr size_t OFF_MOD = 21 * MiB;
constexpr size_t OFF_ROPE = OFF_MOD + 73728;
constexpr size_t OFF_BONUS = 21 * MiB + 131072;
constexpr size_t OFF_XC1 = 24 * MiB;
constexpr size_t OFF_OCTX = 26 * MiB;
constexpr size_t OFF_BAR = 29 * MiB;
constexpr size_t OFF_PROJ = 30 * MiB;
constexpr size_t OFF_HB = 171 * MiB;
constexpr size_t OFF_STP = 171 * MiB;
constexpr size_t OFF_STS = 203 * MiB;
constexpr size_t OFF_RAW = 30 * MiB;
constexpr size_t OFF_VT = 96 * MiB;
constexpr size_t OFF_KS = 129 * MiB;
constexpr size_t OFF_GB = 204 * MiB;
constexpr size_t OFF_QS = OFF_HB;
constexpr size_t OFF_Y2 = OFF_RAW;

constexpr int LDS_BYTES = 78336;

struct Params {
  const float *x, *c, *ctx, *c_ctx, *ada_w, *ada_b, *norm_g, *rw_in, *rw_mu, *rw_w0, *rw_w2, *rw_a0, *rw_a2,
      *rw_kk, *rw_ka, *rw_rk, *rw_gn_g, *rw_gn_b, *rw_out, *da_in, *da_qn, *da_kn, *da_lam, *da_subln, *da_out;
  float* out;
  char* ws;
};

DI u16 f2bf(float x) { unsigned u = __float_as_uint(x); u += 0x7fffu + ((u >> 16) & 1u); return (u16)(u >> 16); }
DI float bf2f(u16 h) { return __uint_as_float(((unsigned)h) << 16); }
DI unsigned pack2(float a, float b) { return (unsigned)f2bf(a) | ((unsigned)f2bf(b) << 16); }
typedef __bf16 bf16v2 __attribute__((ext_vector_type(2)));
DI unsigned cvtpk(float a, float b) { f2 v = {a, b}; return __builtin_bit_cast(unsigned, __builtin_convertvector(v, bf16v2)); }
DI float fsig(float x) { return __builtin_amdgcn_rcpf(1.0f + __expf(-x)); }
DI int ltid() { int t = threadIdx.x; asm volatile("" : "+v"(t)); return t; }
DI float bflo(unsigned u) { return __uint_as_float(u << 16); }
DI float bfhi(unsigned u) { return __uint_as_float(u & 0xffff0000u); }
DI float sigmoidf_(float x) { return 1.0f / (1.0f + __expf(-x)); }
DI float siluf_(float x) { return x * sigmoidf_(x); }
DI int crow(int i, int h) { return (i & 3) + 8 * (i >> 2) + 4 * h; }
DI void unpack8(const u32x4& u, float* f) {
  f[0] = bflo(u[0]); f[1] = bfhi(u[0]); f[2] = bflo(u[1]); f[3] = bfhi(u[1]);
  f[4] = bflo(u[2]); f[5] = bfhi(u[2]); f[6] = bflo(u[3]); f[7] = bfhi(u[3]);
}
#define WAVE_LDS_SYNC() asm volatile("s_waitcnt lgkmcnt(0)" ::: "memory")
#define MFMA32(a, b, c) __builtin_amdgcn_mfma_f32_32x32x16_bf16((a), (b), (c), 0, 0, 0)
#define MFMA16(a, b, c) __builtin_amdgcn_mfma_f32_16x16x32_bf16((a), (b), (c), 0, 0, 0)

__device__ const float INV_FREQ[16] = {
    1.0f, 0.5623413251903491f, 0.31622776601683794f, 0.1778279410038923f, 0.1f, 0.05623413251903491f,
    0.03162277660168379f, 0.01778279410038923f, 0.01f, 0.005623413251903491f, 0.0031622776601683794f,
    0.001778279410038923f, 0.001f, 0.0005623413251903491f, 0.00031622776601683794f, 0.0001778279410038923f};

DI void transpose_tile(const float* __restrict__ src, u16* __restrict__ dst, int K, int N, int kt, int nt, float* tile) {
  const int TIDX = ltid();
  const int tid = TIDX;
  {
    const int n = tid & 63, k0 = tid >> 6;
#pragma unroll
    for (int i = 0; i < 16; ++i) {
      const int k = k0 + 4 * i;
      tile[k * 65 + n] = src[(size_t)(kt * 64 + k) * N + nt * 64 + n];
    }
  }
  __syncthreads();
  {
    const int n = tid >> 2, kq = tid & 3;
    unsigned pk[8];
#pragma unroll
    for (int j = 0; j < 8; ++j) pk[j] = pack2(tile[(kq * 16 + 2 * j) * 65 + n], tile[(kq * 16 + 2 * j + 1) * 65 + n]);
    u32x4* d = (u32x4*)(dst + (size_t)(nt * 64 + n) * K + kt * 64 + kq * 16);
    d[0] = u32x4{pk[0], pk[1], pk[2], pk[3]};
    d[1] = u32x4{pk[4], pk[5], pk[6], pk[7]};
  }
  __syncthreads();
}

DI void phase_prep(const Params& p, char* smem) {
  const int TIDX = ltid();
  float* tile = (float*)smem;
  const int tid = TIDX;
  constexpr int T_IN0 = 16 * 68, T_OUT = 256, T_IN1 = 16 * 64, T_LORA = 16;
  constexpr int E0 = T_IN0, E1 = E0 + T_OUT, E2 = E1 + T_IN1, E3 = E2 + T_OUT, E4 = E3 + 2 * T_LORA, E5 = E4 + 2 * T_LORA;
  constexpr int NMOD = 192;
  constexpr int TOTAL = E5 + NMOD + 1;
  for (int it = blockIdx.x; it < TOTAL; it += gridDim.x) {
    if (it < E0) { transpose_tile(p.rw_in, (u16*)(p.ws + OFF_WT_IN0), 1024, N0, it / 68, it % 68, tile); }
    else if (it < E1) { int j = it - E0; transpose_tile(p.rw_out, (u16*)(p.ws + OFF_WT_OUT0), 1024, 1024, j >> 4, j & 15, tile); }
    else if (it < E3) {   }
    else if (it < E4) { int j = it - E3; int d = j >> 4; transpose_tile(p.rw_w2 + (size_t)d * 65536, (u16*)(p.ws + OFF_W2T) + (size_t)d * 65536, 64, 1024, 0, j & 15, tile); }
    else if (it < E5) { int j = it - E4; int d = j >> 4; transpose_tile(p.rw_a2 + (size_t)d * 65536, (u16*)(p.ws + OFF_A2T) + (size_t)d * 65536, 64, 1024, 0, j & 15, tile); }
    else if (it < E5 + NMOD) {
      const int j = it - E5; const int layer = j / 96; const int nb = (j % 96) * 32;
      const int n = nb + (tid & 31), kg = tid >> 5;
      const float* W = p.ada_w + (size_t)layer * 1024 * 3072;
      float a0 = 0.f, a1 = 0.f, a2 = 0.f;
#pragma unroll 8
      for (int k = kg * 128; k < kg * 128 + 128; ++k) {
        const float w = W[(size_t)k * 3072 + n];
        a0 += siluf_(p.c[k]) * w; a1 += siluf_(p.c[1024 + k]) * w; a2 += siluf_(p.c_ctx[k]) * w;
      }
      tile[(kg * 3 + 0) * 32 + (tid & 31)] = a0; tile[(kg * 3 + 1) * 32 + (tid & 31)] = a1; tile[(kg * 3 + 2) * 32 + (tid & 31)] = a2;
      __syncthreads();
      if (tid < 96) {
        const int s = tid >> 5, nn = tid & 31;
        float acc = p.ada_b[layer * 3072 + nb + nn];
#pragma unroll
        for (int g = 0; g < 8; ++g) acc += tile[(g * 3 + s) * 32 + nn];
        ((float*)(p.ws + OFF_MOD))[(layer * 3 + s) * 3072 + nb + nn] = acc;
      }
      __syncthreads();
    } else {
      float* rope = (float*)(p.ws + OFF_ROPE);
      for (int e = tid; e < 2048; e += 256) {
        const int pos = e >> 4, f = e & 15;
        const float ang = (float)pos * INV_FREQ[f];
        const float rev = ang * 0.15915494309189535f;
        const float fr = rev - rintf(rev);
        const float a = fr * 6.283185307179586f;
        rope[e] = __cosf(a); rope[2048 + e] = __sinf(a);
      }
    }
  }
}

DI void phase_normmod(const Params& p, int layer, const float* __restrict__ xl, const float* __restrict__ xc, bool zero_o) {
  const int TIDX = ltid();
  const int lane = TIDX & 63, wv = __builtin_amdgcn_readfirstlane(TIDX >> 6);
  const float* mod = (const float*)(p.ws + OFF_MOD) + layer * 3 * 3072;
  const float* g = p.norm_g + layer * 1024;
  u16* hb = (u16*)(p.ws + OFF_HB);
  for (int row = blockIdx.x * 4 + wv; row < T_ALL; row += gridDim.x * 4) {
    const float* src; const float* m;
    if (row < T_LAT) { src = xl + (size_t)row * 1024; m = mod + (row >> 13) * 3072; }
    else { src = xc + (size_t)(row - T_LAT) * 1024; m = mod + 2 * 3072; }
    float v[16];
    float ss = 0.f;
#pragma unroll
    for (int q = 0; q < 4; ++q) {
      const f32x4 t = *(const f32x4*)(src + lane * 16 + q * 4);
      v[q * 4] = t[0]; v[q * 4 + 1] = t[1]; v[q * 4 + 2] = t[2]; v[q * 4 + 3] = t[3];
      ss += t[0] * t[0] + t[1] * t[1] + t[2] * t[2] + t[3] * t[3];
    }
#pragma unroll
    for (int o = 32; o >= 1; o >>= 1) ss += __shfl_xor(ss, o);
    const float rstd = rsqrtf(ss * (1.0f / 1024.0f) + 1e-6f);
    unsigned pk[8];
#pragma unroll
    for (int j = 0; j < 8; ++j) {
      const int c0 = lane * 16 + 2 * j;
      const float h0 = v[2 * j] * rstd * g[c0] * (1.0f + m[1024 + c0]) + m[c0];
      const float h1 = v[2 * j + 1] * rstd * g[c0 + 1] * (1.0f + m[1024 + c0 + 1]) + m[c0 + 1];
      pk[j] = pack2(h0, h1);
    }
    u32x4* d = (u32x4*)(hb + (size_t)row * 1024 + lane * 16);
    d[0] = u32x4{pk[0], pk[1], pk[2], pk[3]};
    d[1] = u32x4{pk[4], pk[5], pk[6], pk[7]};
    if (zero_o) {
      float* o = (row < T_LAT) ? (p.out + (size_t)row * 1024) : ((float*)(p.ws + OFF_OCTX) + (size_t)(row - T_LAT) * 1024);
      const f32x4 z = {0.f, 0.f, 0.f, 0.f};
#pragma unroll
      for (int q = 0; q < 4; ++q) *(f32x4*)(o + lane * 16 + q * 4) = z;
    }
  }
}

constexpr int LDT = 72;
#ifndef REP_GEMM
#define REP_GEMM 1
#endif
#ifndef REP_SCAN
#define REP_SCAN 1
#endif
#ifndef REP_ATTN
#define REP_ATTN 1
#endif
template <int EPI>
DI void phase_gemm(const Params& p, char* smem, const u16* __restrict__ A, const u16* __restrict__ Bt, int Mtiles, int Ntiles, int Mbase = 0) {
  const int TIDX = ltid();
  u16* As0 = (u16*)smem;
  const int tid = TIDX, lane = tid & 63, wv = __builtin_amdgcn_readfirstlane(tid >> 6);
  const int r = lane & 31, h = lane >> 5;
  const int wm = wv >> 1, wn = wv & 1;
  const int ntiles = Mtiles * Ntiles;
  const int npad = (ntiles + 511) & ~511;
  int repg = (EPI == 0 || EPI == 2) ? REP_GEMM : 1; asm volatile("" : "+s"(repg));
  for (int rp = 0; rp < repg; ++rp)
  for (int tt = blockIdx.x; tt < npad; tt += gridDim.x) {
    const int tile = (tt & ~511) + ((tt & 7) << 6) + ((tt >> 3) & 63);
    if (tile >= ntiles) continue;
    const int band = tile / (4 * Ntiles), rem = tile % (4 * Ntiles);
    const int mt_ = band * 4 + (rem & 3), nt_ = rem >> 2;
    const int m0 = (Mbase + mt_) * 128, n0 = nt_ * 128;
    f32x16 acc[2][2];
#pragma unroll
    for (int a = 0; a < 2; ++a)
#pragma unroll
      for (int b = 0; b < 2; ++b)
#pragma unroll
        for (int i = 0; i < 16; ++i) acc[a][b][i] = 0.f;
    u32x4 ra[4], rb[4];
    const u16* Ag = A + (size_t)m0 * 1024;
    const u16* Bg = Bt + (size_t)n0 * 1024;
#pragma unroll
    for (int i = 0; i < 4; ++i) {
      const int id = tid + 256 * i; const int row = id >> 3, cc = id & 7;
      ra[i] = *(const u32x4*)(Ag + (size_t)row * 1024 + cc * 8);
      rb[i] = *(const u32x4*)(Bg + (size_t)row * 1024 + cc * 8);
    }
    __syncthreads();
    for (int kt = 0; kt < 16; ++kt) {
      u16* As = As0 + (kt & 1) * (256 * LDT);
      u16* Bs = As + 128 * LDT;
#pragma unroll
      for (int i = 0; i < 4; ++i) {
        const int id = tid + 256 * i; const int row = id >> 3, cc = id & 7;
        *(u32x4*)(As + row * LDT + cc * 8) = ra[i];
        *(u32x4*)(Bs + row * LDT + cc * 8) = rb[i];
      }
      __syncthreads();
      if (kt + 1 < 16) {
#pragma unroll
        for (int i = 0; i < 4; ++i) {
          const int id = tid + 256 * i; const int row = id >> 3, cc = id & 7;
          ra[i] = *(const u32x4*)(Ag + (size_t)row * 1024 + (kt + 1) * 64 + cc * 8);
          rb[i] = *(const u32x4*)(Bg + (size_t)row * 1024 + (kt + 1) * 64 + cc * 8);
        }
      }
#pragma unroll
      for (int ks = 0; ks < 4; ++ks) {
        bf16x8 fa[2], fb[2];
#pragma unroll
        for (int t = 0; t < 2; ++t) {
          fa[t] = *(const bf16x8*)(As + (wm * 64 + t * 32 + r) * LDT + ks * 16 + 8 * h);
          fb[t] = *(const bf16x8*)(Bs + (wn * 64 + t * 32 + r) * LDT + ks * 16 + 8 * h);
        }
#pragma unroll
        for (int a = 0; a < 2; ++a)
#pragma unroll
          for (int b = 0; b < 2; ++b) acc[a][b] = MFMA32(fa[a], fb[b], acc[a][b]);
      }
    }
#pragma unroll
    for (int a = 0; a < 2; ++a)
#pragma unroll
      for (int b = 0; b < 2; ++b) {
        const int col = n0 + wn * 64 + b * 32 + r;
        const int rbase = m0 + wm * 64 + a * 32;
        if (EPI == 0) {
          u16* C = (u16*)(p.ws + OFF_PROJ);
#pragma unroll
          for (int i = 0; i < 16; ++i) C[(size_t)(rbase + crow(i, h)) * N0 + col] = f2bf(acc[a][b][i]);
        } else if (EPI == 1) {
          const float* mod = (const float*)(p.ws + OFF_MOD);
#pragma unroll
          for (int i = 0; i < 16; ++i) {
            const int row = rbase + crow(i, h);
            if (row < T_LAT) {
              const float gate = mod[(row >> 13) * 3072 + 2048 + col];
              p.out[(size_t)row * 1024 + col] = p.x[(size_t)row * 1024 + col] + gate * acc[a][b][i];
            } else {
              const int rc = row - T_LAT;
              const float gate = mod[2 * 3072 + 2048 + col];
              ((float*)(p.ws + OFF_XC1))[(size_t)rc * 1024 + col] = p.ctx[(size_t)rc * 1024 + col] + gate * acc[a][b][i];
            }
          }
        } else if (EPI == 2) {
          if (n0 < 2048) {
            u16* C = (u16*)(p.ws + OFF_RAW);
#pragma unroll
            for (int i = 0; i < 16; ++i) C[(size_t)(rbase + crow(i, h)) * 2048 + col] = f2bf(acc[a][b][i]);
          } else if (n0 < 3072) {
            u16* Vt = (u16*)(p.ws + OFF_VT);
            const int e = col - 2048;
#pragma unroll
            for (int g = 0; g < 4; ++g) {
              const int row = rbase + 8 * g + 4 * h;
              int bb, pp;
              if (row < T_LAT) { bb = row >> 13; pp = 256 + (row & 8191); } else { bb = (row - T_LAT) >> 8; pp = (row - T_LAT) & 255; }
              u32x2 v = {cvtpk(acc[a][b][4 * g], acc[a][b][4 * g + 1]), cvtpk(acc[a][b][4 * g + 2], acc[a][b][4 * g + 3])};
              const int q4 = (pp >> 2) & 3;
              const int pq = (pp & ~15) | ((((q4 & 1) << 1) | (q4 >> 1)) << 2);
              *(u32x2*)(Vt + ((size_t)bb * 1024 + e) * LKV + pq) = v;
            }
          } else {
            u16* G = (u16*)(p.ws + OFF_GB);
#pragma unroll
            for (int i = 0; i < 16; ++i) {
              const int row = rbase + crow(i, h);
              if (row < T_LAT) G[(size_t)row * 1024 + col - 3072] = f2bf(siluf_(acc[a][b][i]));
            }
          }
        } else {
          const float* mod = (const float*)(p.ws + OFF_MOD) + 3 * 3072;
#pragma unroll
          for (int i = 0; i < 16; ++i) {
            const int row = rbase + crow(i, h);
            const float gate = mod[(row >> 13) * 3072 + 2048 + col];
            float* o = p.out + (size_t)row * 1024 + col;
            *o = *o + gate * acc[a][b][i];
          }
        }
      }
  }
}

template <int EPI>
DI void phase_gemm_wide(const Params& p, char* smem, const u16* __restrict__ A, const u16* __restrict__ Bt, int Mtiles, int Ntiles, int Mbase = 0) {
  const int TIDX = ltid();
  u16* As = (u16*)smem;
  u16* Bs = As + 128 * LDT;
  const int tid = TIDX, lane = tid & 63, wv = __builtin_amdgcn_readfirstlane(tid >> 6);
  const int r = lane & 31, h = lane >> 5;
  const int wm = wv >> 1, wn = wv & 1;
  const int ntiles = Mtiles * Ntiles;
  const int npad = (ntiles + 511) & ~511;
  int repg = (EPI == 0 || EPI == 2) ? REP_GEMM : 1; asm volatile("" : "+s"(repg));
  for (int rp = 0; rp < repg; ++rp)
  for (int tt = blockIdx.x; tt < npad; tt += gridDim.x) {
    const int tile = (tt & ~511) + ((tt & 7) << 6) + ((tt >> 3) & 63);
    if (tile >= ntiles) continue;
    const int band = tile / (4 * Ntiles), rem = tile % (4 * Ntiles);
    const int mt_ = band * 4 + (rem & 3), nt_ = rem >> 2;
    const int m0 = (Mbase + mt_) * 128, n0 = nt_ * 256;
    f32x16 acc[2][4];
#pragma unroll
    for (int a = 0; a < 2; ++a)
#pragma unroll
      for (int b = 0; b < 4; ++b)
#pragma unroll
        for (int i = 0; i < 16; ++i) acc[a][b][i] = 0.f;
    u32x4 ra[4], rb[8];
    const u16* Ag = A + (size_t)m0 * 1024;
    const u16* Bg = Bt + (size_t)n0 * 1024;
#pragma unroll
    for (int i = 0; i < 8; ++i) {
      const int id = tid + 256 * i; const int row = id >> 3, cc = id & 7;
      if (i < 4) ra[i] = *(const u32x4*)(Ag + (size_t)row * 1024 + cc * 8);
      rb[i] = *(const u32x4*)(Bg + (size_t)row * 1024 + cc * 8);
    }
    for (int kt = 0; kt < 16; ++kt) {
      __syncthreads();
      int ts = tid; asm volatile("" : "+v"(ts));
#pragma unroll
      for (int i = 0; i < 8; ++i) {
        const int id = ts + 256 * i; const int row = id >> 3, cc = id & 7;
        if (i < 4) *(u32x4*)(As + row * LDT + cc * 8) = ra[i];
        *(u32x4*)(Bs + row * LDT + cc * 8) = rb[i];
      }
      __syncthreads();
      if (kt + 1 < 16) {
        int tl = tid; asm volatile("" : "+v"(tl));
#pragma unroll
        for (int i = 0; i < 8; ++i) {
          const int id = tl + 256 * i; const int row = id >> 3, cc = id & 7;
          if (i < 4) ra[i] = *(const u32x4*)(Ag + (size_t)row * 1024 + (kt + 1) * 64 + cc * 8);
          rb[i] = *(const u32x4*)(Bg + (size_t)row * 1024 + (kt + 1) * 64 + cc * 8);
        }
      }
#pragma unroll
      for (int ks = 0; ks < 4; ++ks) {
        bf16x8 fa[2], fb[4];
#pragma unroll
        for (int t = 0; t < 2; ++t) fa[t] = *(const bf16x8*)(As + (wm * 64 + t * 32 + r) * LDT + ks * 16 + 8 * h);
#pragma unroll
        for (int t = 0; t < 4; ++t) fb[t] = *(const bf16x8*)(Bs + (wn * 128 + t * 32 + r) * LDT + ks * 16 + 8 * h);
#pragma unroll
        for (int a = 0; a < 2; ++a)
#pragma unroll
          for (int b = 0; b < 4; ++b) acc[a][b] = MFMA32(fa[a], fb[b], acc[a][b]);
      }
    }
#pragma unroll
    for (int a = 0; a < 2; ++a)
#pragma unroll
      for (int b = 0; b < 4; ++b) {
        const int col = n0 + wn * 128 + b * 32 + r;
        const int rbase = m0 + wm * 64 + a * 32;
        if (EPI == 0) {
          u16* C = (u16*)(p.ws + OFF_PROJ);
#pragma unroll
          for (int i = 0; i < 16; ++i) C[(size_t)(rbase + crow(i, h)) * N0 + col] = f2bf(acc[a][b][i]);
        } else if (EPI == 1) {
          const float* mod = (const float*)(p.ws + OFF_MOD);
#pragma unroll
          for (int i = 0; i < 16; ++i) {
            const int row = rbase + crow(i, h);
            if (row < T_LAT) {
              const float gate = mod[(row >> 13) * 3072 + 2048 + col];
              p.out[(size_t)row * 1024 + col] = p.x[(size_t)row * 1024 + col] + gate * acc[a][b][i];
            } else {
              const int rc = row - T_LAT;
              const float gate = mod[2 * 3072 + 2048 + col];
              ((float*)(p.ws + OFF_XC1))[(size_t)rc * 1024 + col] = p.ctx[(size_t)rc * 1024 + col] + gate * acc[a][b][i];
            }
          }
        } else if (EPI == 2) {
          if (n0 < 2048) {
            u16* C = (u16*)(p.ws + OFF_RAW);
#pragma unroll
            for (int i = 0; i < 16; ++i) C[(size_t)(rbase + crow(i, h)) * 2048 + col] = f2bf(acc[a][b][i]);
          } else if (n0 < 3072) {
            u16* Vt = (u16*)(p.ws + OFF_VT);
            const int e = col - 2048;
#pragma unroll
            for (int g = 0; g < 4; ++g) {
              const int row = rbase + 8 * g + 4 * h;
              int bb, pp;
              if (row < T_LAT) { bb = row >> 13; pp = 256 + (row & 8191); } else { bb = (row - T_LAT) >> 8; pp = (row - T_LAT) & 255; }
              u32x2 v = {cvtpk(acc[a][b][4 * g], acc[a][b][4 * g + 1]), cvtpk(acc[a][b][4 * g + 2], acc[a][b][4 * g + 3])};
              const int q4 = (pp >> 2) & 3;
              const int pq = (pp & ~15) | ((((q4 & 1) << 1) | (q4 >> 1)) << 2);
              *(u32x2*)(Vt + ((size_t)bb * 1024 + e) * LKV + pq) = v;
            }
          } else {
            u16* G = (u16*)(p.ws + OFF_GB);
#pragma unroll
            for (int i = 0; i < 16; ++i) {
              const int row = rbase + crow(i, h);
              if (row < T_LAT) G[(size_t)row * 1024 + col - 3072] = f2bf(siluf_(acc[a][b][i]));
            }
          }
        } else {
          const float* mod = (const float*)(p.ws + OFF_MOD) + 3 * 3072;
#pragma unroll
          for (int i = 0; i < 16; ++i) {
            const int row = rbase + crow(i, h);
            const float gate = mod[(row >> 13) * 3072 + 2048 + col];
            float* o = p.out + (size_t)row * 1024 + col;
            *o = *o + gate * acc[a][b][i];
          }
        }
      }
  }
}

constexpr int LDW = 80;
template <int EPI>
DI void phase_gemm_wide16(const Params& p, char* smem, const u16* __restrict__ A, const u16* __restrict__ Bt, int Mtiles, int Ntiles, int Mbase = 0) {
  const int TIDX = ltid();
  u16* As = (u16*)smem;
  u16* Bs = As + 128 * LDW;
  const int tid = TIDX, lane = tid & 63, wv = __builtin_amdgcn_readfirstlane(tid >> 6);
  const int lr = lane & 15, lq = lane >> 4;
  const int wm = wv >> 1, wn = wv & 1;
  const int ntiles = Mtiles * Ntiles;
  const int npad = (ntiles + 511) & ~511;
  for (int tt = blockIdx.x; tt < npad; tt += gridDim.x) {
    const int tile = (tt & ~511) + ((tt & 7) << 6) + ((tt >> 3) & 63);
    if (tile >= ntiles) continue;
    const int band = tile / (4 * Ntiles), rem = tile % (4 * Ntiles);
    const int mt_ = band * 4 + (rem & 3), nt_ = rem >> 2;
    const int m0 = (Mbase + mt_) * 128, n0 = nt_ * 256;
    f32x4 acc[4][8];
#pragma unroll
    for (int t = 0; t < 4; ++t)
#pragma unroll
      for (int u = 0; u < 8; ++u) acc[t][u] = f32x4{0.f, 0.f, 0.f, 0.f};
    u32x4 ra[4], rb[8];
    const u16* Ag = A + (size_t)m0 * 1024;
    const u16* Bg = Bt + (size_t)n0 * 1024;
#pragma unroll
    for (int i = 0; i < 8; ++i) {
      const int id = tid + 256 * i; const int row = id >> 3, cc = id & 7;
      if (i < 4) ra[i] = *(const u32x4*)(Ag + (size_t)row * 1024 + cc * 8);
      rb[i] = *(const u32x4*)(Bg + (size_t)row * 1024 + cc * 8);
    }
    for (int kt = 0; kt < 16; ++kt) {
      __syncthreads();
      int ts = tid; asm volatile("" : "+v"(ts));
#pragma unroll
      for (int i = 0; i < 8; ++i) {
        const int id = ts + 256 * i; const int row = id >> 3, cc = id & 7;
        if (i < 4) *(u32x4*)(As + row * LDW + cc * 8) = ra[i];
        *(u32x4*)(Bs + row * LDW + cc * 8) = rb[i];
      }
      __syncthreads();
      if (kt + 1 < 16) {
        int tl = tid; asm volatile("" : "+v"(tl));
#pragma unroll
        for (int i = 0; i < 8; ++i) {
          const int id = tl + 256 * i; const int row = id >> 3, cc = id & 7;
          if (i < 4) ra[i] = *(const u32x4*)(Ag + (size_t)row * 1024 + (kt + 1) * 64 + cc * 8);
          rb[i] = *(const u32x4*)(Bg + (size_t)row * 1024 + (kt + 1) * 64 + cc * 8);
        }
      }
#pragma unroll
      for (int ks = 0; ks < 2; ++ks) {
        bf16x8 fa[4], fb[8];
#pragma unroll
        for (int t = 0; t < 4; ++t) fa[t] = *(const bf16x8*)(As + (wm * 64 + t * 16 + lr) * LDW + ks * 32 + lq * 8);
#pragma unroll
        for (int u = 0; u < 8; ++u) fb[u] = *(const bf16x8*)(Bs + (wn * 128 + u * 16 + lr) * LDW + ks * 32 + lq * 8);
#pragma unroll
        for (int t = 0; t < 4; ++t)
#pragma unroll
          for (int u = 0; u < 8; ++u) acc[t][u] = MFMA16(fa[t], fb[u], acc[t][u]);
      }
    }
#pragma unroll
    for (int t = 0; t < 4; ++t)
#pragma unroll
      for (int u = 0; u < 8; ++u) {
        const int col = n0 + wn * 128 + u * 16 + lr;
        const int row0 = m0 + wm * 64 + t * 16 + 4 * lq;
        if (EPI == 0) {
          u16* C = (u16*)(p.ws + OFF_PROJ);
#pragma unroll
          for (int g = 0; g < 4; ++g) C[(size_t)(row0 + g) * N0 + col] = f2bf(acc[t][u][g]);
        } else if (EPI == 1) {
          const float* mod = (const float*)(p.ws + OFF_MOD);
#pragma unroll
          for (int g = 0; g < 4; ++g) {
            const int row = row0 + g;
            if (row < T_LAT) {
              const float gate = mod[(row >> 13) * 3072 + 2048 + col];
              p.out[(size_t)row * 1024 + col] = p.x[(size_t)row * 1024 + col] + gate * acc[t][u][g];
            } else {
              const int rc = row - T_LAT;
              const float gate = mod[2 * 3072 + 2048 + col];
              ((float*)(p.ws + OFF_XC1))[(size_t)rc * 1024 + col] = p.ctx[(size_t)rc * 1024 + col] + gate * acc[t][u][g];
            }
          }
        } else if (EPI == 3) {
          const float* mod = (const float*)(p.ws + OFF_MOD) + 3 * 3072;
#pragma unroll
          for (int g = 0; g < 4; ++g) {
            const int row = row0 + g;
            const float gate = mod[(row >> 13) * 3072 + 2048 + col];
            float* o = p.out + (size_t)row * 1024 + col;
            *o = *o + gate * acc[t][u][g];
          }
        } else {
          if (n0 < 2048) {
            u16* C = (u16*)(p.ws + OFF_RAW);
#pragma unroll
            for (int g = 0; g < 4; ++g) C[(size_t)(row0 + g) * 2048 + col] = f2bf(acc[t][u][g]);
          } else if (n0 < 3072) {
            u16* Vt = (u16*)(p.ws + OFF_VT);
            const int e = col - 2048;
            int bb, pp;
            if (row0 < T_LAT) { bb = row0 >> 13; pp = 256 + (row0 & 8191); } else { bb = (row0 - T_LAT) >> 8; pp = (row0 - T_LAT) & 255; }
            u32x2 v = {cvtpk(acc[t][u][0], acc[t][u][1]), cvtpk(acc[t][u][2], acc[t][u][3])};
            const int q4 = (pp >> 2) & 3;
            const int pq = (pp & ~15) | ((((q4 & 1) << 1) | (q4 >> 1)) << 2);
            *(u32x2*)(Vt + ((size_t)bb * 1024 + e) * LKV + pq) = v;
          } else {
            u16* G = (u16*)(p.ws + OFF_GB);
#pragma unroll
            for (int g = 0; g < 4; ++g)
              if (row0 + g < T_LAT) G[(size_t)(row0 + g) * 1024 + col - 3072] = f2bf(siluf_(acc[t][u][g]));
          }
        }
      }
  }
}

DI void tokmap(int pos, int d, int b, int& row, bool& hp, bool& hn) {
  if (pos < 256) { const int t = d ? 255 - pos : pos; row = T_LAT + b * 256 + t; hp = t > 0; hn = t < 255; }
  else { const int q = pos - 256; const int t = d ? 8191 - q : q; row = b * 8192 + t; hp = t > 0; hn = t < 8191; }
}

DI void load_mix8(const u16* pr, bool hp, bool hn, const float* mu, float* out) {
  const u32x4 uc = *(const u32x4*)pr;
  u32x4 up = {0u, 0u, 0u, 0u}, un = {0u, 0u, 0u, 0u};
  if (hp) up = *(const u32x4*)(pr - N0);
  if (hn) un = *(const u32x4*)(pr + N0);
  float c[8], a[8], n[8];
  unpack8(uc, c); unpack8(up, a); unpack8(un, n);
  const f32x4 m0 = *(const f32x4*)mu, m1 = *(const f32x4*)(mu + 4);
#pragma unroll
  for (int j = 0; j < 8; ++j) {
    const float m = j < 4 ? m0[j & 3] : m1[j & 3];
    out[j] = c[j] + m * (0.5f * (a[j] + n[j]) - c[j]);
  }
}

DI void mixraw8(const u32x4& uc, const u32x4& up, const u32x4& un, bool hp, bool hn, const float* mu, float* out) {
  float c[8], a[8], n[8];
  unpack8(uc, c); unpack8(up, a); unpack8(un, n);
  const f32x4 m0 = *(const f32x4*)mu, m1 = *(const f32x4*)(mu + 4);
#pragma unroll
  for (int j = 0; j < 8; ++j) {
    const float m = j < 4 ? m0[j & 3] : m1[j & 3];
    const float av = hp ? a[j] : 0.f, nv = hn ? n[j] : 0.f;
    out[j] = c[j] + m * (0.5f * (av + nv) - c[j]);
  }
}

template <int PASS>
DI void phase_scan(const Params& p, char* smem) {
  const int TIDX = ltid();
  const int lane = TIDX & 63, wv = __builtin_amdgcn_readfirstlane(TIDX >> 6);
  float* sm = (float*)smem + wv * 3584;
  float* sW = sm; float* sKK = sm + 512; float* sKKA = sm + 1024; float* sKD = sm + 1536; float* sR = sm + 2048; float* sV = sm + 2560; float* sA = sm + 3072;
  const u16* proj = (const u16*)(p.ws + OFF_PROJ);
  float* stP = (float*)(p.ws + OFF_STP);
  float* stS = (float*)(p.ws + OFF_STS);
  float* bonus = (float*)(p.ws + OFF_BONUS);
  const int nwaves = gridDim.x * 4;
  int reps = (PASS == 1) ? REP_SCAN : 1; asm volatile("" : "+s"(reps));
  for (int rp = 0; rp < reps; ++rp)
  for (int item = blockIdx.x * 4 + wv; item < 2048; item += nwaves) {
    const int chain = item >> 5, chunk = item & 31;
    const int d = chain & 1, hh = (chain >> 1) & 15, b = chain >> 5;
    u16* cB = (u16*)(smem + 57344);
    float* cP = (float*)(smem + 57344 + 18432);
    __syncthreads();
    {
      const int tid = TIDX;
#pragma unroll
      for (int i = 0; i < 4; ++i) {
        const int id = tid + 256 * i;
        const int which = id >> 9, row = (id >> 3) & 63, cc = id & 7;
        const u16* src = (const u16*)(p.ws + (which ? OFF_A2T : OFF_W2T)) + ((size_t)d * 1024 + hh * 64 + row) * 64 + cc * 8;
        *(u32x4*)(cB + (which * 64 + row) * 72 + cc * 8) = *(const u32x4*)src;
      }
      if (tid < 160) {
        const int a = tid >> 4, q = (tid & 15) * 4;
        const float* src;
        switch (a) {
          case 0: src = p.rw_mu + 3072 + d * 64; break;
          case 1: src = p.rw_mu + 3072 + 128 + d * 64; break;
          case 2: src = p.rw_mu + hh * 64; break;
          case 3: src = p.rw_mu + 1024 + hh * 64; break;
          case 4: src = p.rw_mu + 2048 + hh * 64; break;
          case 5: src = p.rw_w0 + d * 1024 + hh * 64; break;
          case 6: src = p.rw_a0 + d * 1024 + hh * 64; break;
          case 7: src = p.rw_kk + hh * 64; break;
          case 8: src = p.rw_ka + hh * 64; break;
          default: src = p.rw_rk + hh * 64; break;
        }
        *(f32x4*)(cP + a * 64 + q) = *(const f32x4*)(src + q);
      }
    }
    __syncthreads();
    if (PASS == 1 && chunk == 31) continue;
    f32x16 S[2][2];
    f32x32 P[2];
    {
      int li = lane; asm volatile("" : "+v"(li));
      const int lv = li & 31, lh = li >> 5;
      if (PASS == 1) {
#pragma unroll
        for (int kt = 0; kt < 2; ++kt)
#pragma unroll
          for (int vt = 0; vt < 2; ++vt)
#pragma unroll
            for (int i = 0; i < 16; ++i) {
              S[kt][vt][i] = 0.f;
              P[vt][16 * kt + i] = (32 * kt + (i & 3) + 8 * (i >> 2) + 4 * lh == 32 * vt + lv) ? 1.f : 0.f;
            }
      } else {
        if (chunk == 0) {
#pragma unroll
          for (int kt = 0; kt < 2; ++kt)
#pragma unroll
            for (int vt = 0; vt < 2; ++vt)
#pragma unroll
              for (int i = 0; i < 16; ++i) S[kt][vt][i] = 0.f;
        } else {
          const float* src = stS + (size_t)(item - 1) * 4096;
#pragma unroll
          for (int kt = 0; kt < 2; ++kt)
#pragma unroll
            for (int vt = 0; vt < 2; ++vt)
#pragma unroll
              for (int g = 0; g < 4; ++g) {
                const f32x4 t = *(const f32x4*)(src + (32 * vt + lv) * 64 + 32 * kt + 8 * g + 4 * lh);
                S[kt][vt][4 * g] = t[0]; S[kt][vt][4 * g + 1] = t[1]; S[kt][vt][4 * g + 2] = t[2]; S[kt][vt][4 * g + 3] = t[3];
              }
        }
      }
    }
    for (int sc = 0; sc < NSUB; ++sc) {
      const int p0 = chunk * LCH + sc * 8;
      int ln = lane; asm volatile("" : "+v"(ln));
      u32x4 rawA[2][3], rawB[3][3];
      bool hpA, hnA, hpB, hnB; int rowB;
      {
        int rowA; tokmap(p0 + (ln & 7), d, b, rowA, hpA, hnA);
        const u16* prA = proj + (size_t)rowA * N0 + 4096 + d * 64 + (ln >> 4) * 8 + ((ln >> 3) & 1) * 32;
        const ptrdiff_t dpA = hpA ? -N0 : 0, dnA = hnA ? N0 : 0;
#pragma unroll
        for (int X = 0; X < 2; ++X) {
          const u16* q = prA + X * 128;
          rawA[X][0] = *(const u32x4*)q; rawA[X][1] = *(const u32x4*)(q + dpA); rawA[X][2] = *(const u32x4*)(q + dnA);
        }
        tokmap(p0 + (ln >> 3), d, b, rowB, hpB, hnB);
        const u16* prB = proj + (size_t)rowB * N0 + hh * 64 + (ln & 7) * 8;
        const ptrdiff_t dpB = hpB ? -N0 : 0, dnB = hnB ? N0 : 0;
#pragma unroll
        for (int X = (PASS == 2 ? 0 : 1); X < 3; ++X) {
          const u16* q = prB + X * 1024;
          rawB[X][0] = *(const u32x4*)q; rawB[X][1] = *(const u32x4*)(q + dpB); rawB[X][2] = *(const u32x4*)(q + dnB);
        }
      }
      {
        const int m = ln & 15, kg = ln >> 4;
        bf16x8 fa[2][2];
        const int ssel = (m >> 3) & 1;
#pragma unroll
        for (int X = 0; X < 2; ++X) {
          float mx[8];
          mixraw8(rawA[X][0], rawA[X][1], rawA[X][2], hpA, hnA, cP + X * 64 + ssel * 32 + kg * 8, mx);
          if (X == 0) {
#pragma unroll
            for (int j = 0; j < 8; ++j) { const float e = __expf(2.0f * mx[j]); mx[j] = 1.0f - 2.0f * __builtin_amdgcn_rcpf(e + 1.0f); }
          }
          u32x4 own = {cvtpk(mx[0], mx[1]), cvtpk(mx[2], mx[3]), cvtpk(mx[4], mx[5]), cvtpk(mx[6], mx[7])};
          u32x4 oth;
#pragma unroll
          for (int q = 0; q < 4; ++q) oth[q] = (unsigned)__shfl_down((int)own[q], 8);
          fa[X][0] = __builtin_bit_cast(bf16x8, own);
          fa[X][1] = __builtin_bit_cast(bf16x8, ssel ? own : oth);
        }
#pragma unroll
        for (int nt = 0; nt < 4; ++nt) {
          f32x4 aw = {0.f, 0.f, 0.f, 0.f}, aa = {0.f, 0.f, 0.f, 0.f};
#pragma unroll
          for (int s = 0; s < 2; ++s) {
            const bf16x8 bw = *(const bf16x8*)(cB + (16 * nt + m) * 72 + s * 32 + kg * 8);
            const bf16x8 ba = *(const bf16x8*)(cB + (64 + 16 * nt + m) * 72 + s * 32 + kg * 8);
            aw = MFMA16(fa[0][s], bw, aw);
            aa = MFMA16(fa[1][s], ba, aa);
          }
          const int ch = 16 * nt + m;
          const float w0 = cP[5 * 64 + ch];
          const float a0 = cP[6 * 64 + ch];
          if (kg < 2) {
#pragma unroll
            for (int rg = 0; rg < 4; ++rg) {
              sW[(4 * kg + rg) * 64 + ch] = w0 + aw[rg];
              sA[(4 * kg + rg) * 64 + ch] = a0 + aa[rg];
            }
          }
        }
      }
      WAVE_LDS_SYNC();
      __builtin_amdgcn_sched_barrier(0);
      {
        const int tk = ln >> 3, g = ln & 7;
        const int row = rowB;
        const int cb = hh * 64 + g * 8;
        float rr[8], kk[8], vv[8];
        if (PASS == 2) mixraw8(rawB[0][0], rawB[0][1], rawB[0][2], hpB, hnB, cP + 2 * 64 + g * 8, rr);
        else { for (int j = 0; j < 8; ++j) rr[j] = 0.f; }
        mixraw8(rawB[1][0], rawB[1][1], rawB[1][2], hpB, hnB, cP + 3 * 64 + g * 8, kk);
        mixraw8(rawB[2][0], rawB[2][1], rawB[2][2], hpB, hnB, cP + 4 * 64 + g * 8, vv);
        float av[8], kkn[8], kd[8], pkkv[8], pkav[8], prkv[8];
        { const f32x4 t0 = *(const f32x4*)(sA + tk * 64 + g * 8), t1 = *(const f32x4*)(sA + tk * 64 + g * 8 + 4);
          av[0] = fsig(t0[0]); av[1] = fsig(t0[1]); av[2] = fsig(t0[2]); av[3] = fsig(t0[3]); av[4] = fsig(t1[0]); av[5] = fsig(t1[1]); av[6] = fsig(t1[2]); av[7] = fsig(t1[3]); }
        { const f32x4 t0 = *(const f32x4*)(sW + tk * 64 + g * 8), t1 = *(const f32x4*)(sW + tk * 64 + g * 8 + 4);
          f32x4 o0, o1;
#pragma unroll
          for (int j = 0; j < 4; ++j) { o0[j] = __expf(-0.6065306597126334f * fsig(t0[j])); o1[j] = __expf(-0.6065306597126334f * fsig(t1[j])); }
          *(f32x4*)(sW + tk * 64 + g * 8) = o0; *(f32x4*)(sW + tk * 64 + g * 8 + 4) = o1; }
        WAVE_LDS_SYNC();
        { float Wc = 1.0f;
#pragma unroll
          for (int j = 0; j < 8; ++j) { Wc *= sW[j * 64 + ln]; sW[j * 64 + ln] = Wc; } }
        WAVE_LDS_SYNC();
        float wcur[8], wprv[8];
        { const f32x4 t0 = *(const f32x4*)(sW + tk * 64 + g * 8), t1 = *(const f32x4*)(sW + tk * 64 + g * 8 + 4);
          const int tp = tk > 0 ? tk - 1 : 0;
          const f32x4 u0 = *(const f32x4*)(sW + tp * 64 + g * 8), u1 = *(const f32x4*)(sW + tp * 64 + g * 8 + 4);
#pragma unroll
          for (int j = 0; j < 4; ++j) { wcur[j] = t0[j]; wcur[j + 4] = t1[j]; wprv[j] = tk > 0 ? u0[j] : 1.0f; wprv[j + 4] = tk > 0 ? u1[j] : 1.0f; } }
        { const float* q7 = cP + 7 * 64 + g * 8;
          const f32x4 a0 = *(const f32x4*)(q7), a1 = *(const f32x4*)(q7 + 4), b0 = *(const f32x4*)(q7 + 64), b1 = *(const f32x4*)(q7 + 68),
                      c0 = *(const f32x4*)(q7 + 128), c1 = *(const f32x4*)(q7 + 132);
#pragma unroll
          for (int j = 0; j < 4; ++j) { pkkv[j] = a0[j]; pkkv[j + 4] = a1[j]; pkav[j] = b0[j]; pkav[j + 4] = b1[j]; prkv[j] = c0[j]; prkv[j + 4] = c1[j]; } }
        float ss = 0.f, bon = 0.f;
#pragma unroll
        for (int j = 0; j < 8; ++j) {
          kkn[j] = kk[j] * pkkv[j]; ss += kkn[j] * kkn[j];
          kd[j] = kk[j] * (1.0f + (av[j] - 1.0f) * pkav[j]);
          bon += rr[j] * kd[j] * prkv[j];
        }
        ss += __shfl_xor(ss, 1); ss += __shfl_xor(ss, 2); ss += __shfl_xor(ss, 4);
        const float inv = rsqrtf(ss + 1e-12f);
        if (PASS == 2) {
          bon += __shfl_xor(bon, 1); bon += __shfl_xor(bon, 2); bon += __shfl_xor(bon, 4);
          if (g == 0) bonus[(size_t)d * (T_ALL * 16) + (size_t)row * 16 + hh] = bon;
        }
        float iw[8];
#pragma unroll
        for (int j = 0; j < 8; ++j) iw[j] = __builtin_amdgcn_rcpf(wcur[j]);
        float* o;
        o = sKK + tk * 64 + g * 8;
        *(f32x4*)o = f32x4{kkn[0] * inv * wprv[0], kkn[1] * inv * wprv[1], kkn[2] * inv * wprv[2], kkn[3] * inv * wprv[3]};
        *(f32x4*)(o + 4) = f32x4{kkn[4] * inv * wprv[4], kkn[5] * inv * wprv[5], kkn[6] * inv * wprv[6], kkn[7] * inv * wprv[7]};
        o = sKKA + tk * 64 + g * 8;
        *(f32x4*)o = f32x4{kkn[0] * inv * av[0] * iw[0], kkn[1] * inv * av[1] * iw[1], kkn[2] * inv * av[2] * iw[2], kkn[3] * inv * av[3] * iw[3]};
        *(f32x4*)(o + 4) = f32x4{kkn[4] * inv * av[4] * iw[4], kkn[5] * inv * av[5] * iw[5], kkn[6] * inv * av[6] * iw[6], kkn[7] * inv * av[7] * iw[7]};
        o = sKD + tk * 64 + g * 8;
        *(f32x4*)o = f32x4{kd[0] * iw[0], kd[1] * iw[1], kd[2] * iw[2], kd[3] * iw[3]};
        *(f32x4*)(o + 4) = f32x4{kd[4] * iw[4], kd[5] * iw[5], kd[6] * iw[6], kd[7] * iw[7]};
        if (PASS == 2) {
          o = sR + tk * 64 + g * 8;
          *(f32x4*)o = f32x4{rr[0] * wcur[0], rr[1] * wcur[1], rr[2] * wcur[2], rr[3] * wcur[3]};
          *(f32x4*)(o + 4) = f32x4{rr[4] * wcur[4], rr[5] * wcur[5], rr[6] * wcur[6], rr[7] * wcur[7]};
        }
        o = sV + tk * 64 + g * 8;
        *(f32x4*)o = f32x4{vv[0], vv[1], vv[2], vv[3]};
        *(f32x4*)(o + 4) = f32x4{vv[4], vv[5], vv[6], vv[7]};
      }
      WAVE_LDS_SYNC();
      __builtin_amdgcn_sched_barrier(0);
      float* obase = nullptr; ptrdiff_t ostep = d ? -1024 : 1024;
      if (PASS == 2) {
        int row0; bool hp0, hn0; tokmap(p0, d, b, row0, hp0, hn0);
        obase = ((row0 < T_LAT) ? (p.out + (size_t)row0 * 1024) : ((float*)(p.ws + OFF_OCTX) + (size_t)(row0 - T_LAT) * 1024)) + hh * 64 + lane;
      }
      const int lv31 = lane & 31, lh1 = lane >> 5;
      __builtin_amdgcn_s_setprio(1);
#pragma unroll 1
      for (int j = 0; j < 8; ++j) {
        f32x4 kkv[2][4];
#pragma unroll
        for (int kt = 0; kt < 2; ++kt)
#pragma unroll
          for (int g = 0; g < 4; ++g) kkv[kt][g] = *(const f32x4*)(sKK + j * 64 + 32 * kt + 8 * g + 4 * lh1);
        float aop[2], vvv[2];
        const float akka = sKKA[j * 64 + lane];
#pragma unroll
        for (int t = 0; t < 2; ++t) {
          aop[t] = (lh1 ? sKD : sKKA)[j * 64 + 32 * t + lv31];
          vvv[t] = sV[j * 64 + 32 * t + lv31];
        }
        float saS[2], saP[2];
#pragma unroll
        for (int vt = 0; vt < 2; ++vt) {
          f2 a2 = {0.f, 0.f}, b2 = {0.f, 0.f};
#pragma unroll
          for (int kt = 0; kt < 2; ++kt)
#pragma unroll
            for (int g = 0; g < 4; ++g) {
              a2 += f2{S[kt][vt][4 * g], S[kt][vt][4 * g + 1]} * f2{kkv[kt][g][0], kkv[kt][g][1]};
              a2 += f2{S[kt][vt][4 * g + 2], S[kt][vt][4 * g + 3]} * f2{kkv[kt][g][2], kkv[kt][g][3]};
              if (PASS == 1) {
                b2 += f2{P[vt][16 * kt + 4 * g], P[vt][16 * kt + 4 * g + 1]} * f2{kkv[kt][g][0], kkv[kt][g][1]};
                b2 += f2{P[vt][16 * kt + 4 * g + 2], P[vt][16 * kt + 4 * g + 3]} * f2{kkv[kt][g][2], kkv[kt][g][3]};
              }
            }
          float x = a2[0] + a2[1];
          x += __shfl_xor(x, 32);
          saS[vt] = x;
          if (PASS == 1) { float y = b2[0] + b2[1]; y += __shfl_xor(y, 32); saP[vt] = y; }
        }
#pragma unroll
        for (int vt = 0; vt < 2; ++vt) {
          const float bS = lh1 ? vvv[vt] : -saS[vt];
          if (PASS == 1) P[vt] = __builtin_amdgcn_mfma_f32_32x32x1f32(akka, -saP[vt], P[vt], 0, 0, 0);
#pragma unroll
          for (int kt = 0; kt < 2; ++kt) {
            S[kt][vt] = __builtin_amdgcn_mfma_f32_32x32x2f32(aop[kt], bS, S[kt][vt], 0, 0, 0);
          }
        }
        if (PASS == 2) {
          f32x4 rv[2][4];
#pragma unroll
          for (int kt = 0; kt < 2; ++kt)
#pragma unroll
            for (int g = 0; g < 4; ++g) rv[kt][g] = *(const f32x4*)(sR + j * 64 + 32 * kt + 8 * g + 4 * lh1);
          float ov[2];
#pragma unroll
          for (int vt = 0; vt < 2; ++vt) {
            f2 a2 = {0.f, 0.f};
#pragma unroll
            for (int kt = 0; kt < 2; ++kt)
#pragma unroll
              for (int g = 0; g < 4; ++g) {
                a2 += f2{S[kt][vt][4 * g], S[kt][vt][4 * g + 1]} * f2{rv[kt][g][0], rv[kt][g][1]};
                a2 += f2{S[kt][vt][4 * g + 2], S[kt][vt][4 * g + 3]} * f2{rv[kt][g][2], rv[kt][g][3]};
              }
            float x = a2[0] + a2[1];
            x += __shfl_xor(x, 32);
            ov[vt] = x;
          }
          atomicAdd(obase + (ptrdiff_t)j * ostep, lh1 ? ov[1] : ov[0]);
        }
      }
      __builtin_amdgcn_s_setprio(0);
      {
        f32x4 w7[2][4];
#pragma unroll
        for (int kt = 0; kt < 2; ++kt)
#pragma unroll
          for (int g = 0; g < 4; ++g) w7[kt][g] = *(const f32x4*)(sW + 7 * 64 + 32 * kt + 8 * g + 4 * lh1);
#pragma unroll
        for (int kt = 0; kt < 2; ++kt)
#pragma unroll
          for (int vt = 0; vt < 2; ++vt)
#pragma unroll
            for (int i = 0; i < 16; ++i) {
              S[kt][vt][i] *= w7[kt][i >> 2][i & 3];
              if (PASS == 1) P[vt][16 * kt + i] *= w7[kt][i >> 2][i & 3];
            }
      }
      WAVE_LDS_SYNC();
    }
    if (PASS == 1) {
      int li = lane; asm volatile("" : "+v"(li));
      const int lv = li & 31, lh = li >> 5;
      float* dP = stP + (size_t)item * 4096;
      float* dS = stS + (size_t)item * 4096;
#pragma unroll
      for (int kt = 0; kt < 2; ++kt)
#pragma unroll
        for (int vt = 0; vt < 2; ++vt)
#pragma unroll
          for (int g = 0; g < 4; ++g) {
            const int off = (32 * vt + lv) * 64 + 32 * kt + 8 * g + 4 * lh;
            *(f32x4*)(dP + off) = f32x4{P[vt][16 * kt + 4 * g], P[vt][16 * kt + 4 * g + 1], P[vt][16 * kt + 4 * g + 2], P[vt][16 * kt + 4 * g + 3]};
            *(f32x4*)(dS + off) = f32x4{S[kt][vt][4 * g], S[kt][vt][4 * g + 1], S[kt][vt][4 * g + 2], S[kt][vt][4 * g + 3]};
          }
    }
  }
}

DI void phase_carry(const Params& p, char* smem) {
  const int TIDX = ltid();
  float* cur = (float*)smem;
  const int tid = TIDX, lane = tid & 63, w = __builtin_amdgcn_readfirstlane(tid >> 6);
  const int lc = lane & 15, lq = lane >> 4;
  float* stP = (float*)(p.ws + OFF_STP);
  float* stS = (float*)(p.ws + OFF_STS);
  for (int it = blockIdx.x; it < 256; it += gridDim.x) {
    const int chain = it >> 2, rg = it & 3;
    const size_t slot0 = (size_t)chain * 32;
    __syncthreads();
    {
      const int row = tid >> 4, c4 = (tid & 15) * 4;
      const f32x4 t = *(const f32x4*)(stS + (slot0 * 64 + rg * 16 + row) * 64 + c4);
      *(f32x4*)(cur + row * 68 + c4) = t;
    }
    __syncthreads();
    float pn[16]; f32x4 an;
    {
      const float* Pm = stP + (slot0 + 1) * 4096;
#pragma unroll
      for (int s = 0; s < 16; ++s) pn[s] = Pm[(size_t)(4 * s + lq) * 64 + 16 * w + lc];
#pragma unroll
      for (int rr = 0; rr < 4; ++rr) an[rr] = stS[((slot0 + 1) * 64 + rg * 16 + 4 * lq + rr) * 64 + 16 * w + lc];
    }
    for (int c = 1; c < 31; ++c) {
      const size_t slot = slot0 + c;
      float pj[16]; f32x4 acc = an;
#pragma unroll
      for (int s = 0; s < 16; ++s) pj[s] = pn[s];
      if (c + 1 < 31) {
        const float* Pm = stP + (slot + 1) * 4096;
#pragma unroll
        for (int s = 0; s < 16; ++s) pn[s] = Pm[(size_t)(4 * s + lq) * 64 + 16 * w + lc];
#pragma unroll
        for (int rr = 0; rr < 4; ++rr) an[rr] = stS[((slot + 1) * 64 + rg * 16 + 4 * lq + rr) * 64 + 16 * w + lc];
      }
#pragma unroll
      for (int s = 0; s < 16; ++s) {
        const float a = cur[lc * 68 + 4 * s + lq];
        acc = __builtin_amdgcn_mfma_f32_16x16x4f32(a, pj[s], acc, 0, 0, 0);
      }
      __syncthreads();
#pragma unroll
      for (int rr = 0; rr < 4; ++rr) {
        cur[(4 * lq + rr) * 68 + 16 * w + lc] = acc[rr];
        stS[(slot * 64 + rg * 16 + 4 * lq + rr) * 64 + 16 * w + lc] = acc[rr];
      }
      __syncthreads();
    }
  }
  {
    const int nidle = (int)gridDim.x > 256 ? (int)gridDim.x - 256 : 0;
    int t0, tstep;
    if (nidle > 0) { t0 = (int)blockIdx.x - 256; tstep = nidle; if (t0 < 0) t0 = 1 << 30; }
    else { t0 = (int)blockIdx.x; tstep = (int)gridDim.x; }
    __syncthreads();
    for (int t = t0; t < 1280; t += tstep) {
      if (t < 1024) transpose_tile(p.da_in, (u16*)(p.ws + OFF_WT_IN1), 1024, N1, t >> 6, t & 63, (float*)smem);
      else { const int j = t - 1024; transpose_tile(p.da_out, (u16*)(p.ws + OFF_WT_OUT1), 1024, 1024, j >> 4, j & 15, (float*)smem); }
    }
  }
}

DI void phase_readout(const Params& p) {
  const int TIDX = ltid();
  const int lane = TIDX & 63, wv = __builtin_amdgcn_readfirstlane(TIDX >> 6);
  const u16* proj = (const u16*)(p.ws + OFF_PROJ);
  const float* bonus = (const float*)(p.ws + OFF_BONUS);
  u16* hb = (u16*)(p.ws + OFF_HB);
  for (int row = blockIdx.x * 4 + wv; row < T_ALL; row += gridDim.x * 4) {
    const float* o = (row < T_LAT) ? (p.out + (size_t)row * 1024) : ((const float*)(p.ws + OFF_OCTX) + (size_t)(row - T_LAT) * 1024);
    bool hp, hn;
    if (row < T_LAT) { const int t = row & 8191; hp = t > 0; hn = t < 8191; } else { const int t = (row - T_LAT) & 255; hp = t > 0; hn = t < 255; }
    const int c0 = lane * 16, hh = lane >> 2;
    float ov[16];
    float s = 0.f;
#pragma unroll
    for (int q = 0; q < 4; ++q) { const f32x4 t = *(const f32x4*)(o + c0 + q * 4); ov[q * 4] = t[0]; ov[q * 4 + 1] = t[1]; ov[q * 4 + 2] = t[2]; ov[q * 4 + 3] = t[3]; s += t[0] + t[1] + t[2] + t[3]; }
    s += __shfl_xor(s, 1); s += __shfl_xor(s, 2);
    const float mean = s * (1.0f / 64.0f);
    float vs = 0.f;
#pragma unroll
    for (int j = 0; j < 16; ++j) { const float dlt = ov[j] - mean; vs += dlt * dlt; }
    vs += __shfl_xor(vs, 1); vs += __shfl_xor(vs, 2);
    const float rstd = rsqrtf(vs * (1.0f / 64.0f) + 64e-5f);
    const float bon = bonus[(size_t)row * 16 + hh] + bonus[(size_t)(T_ALL * 16) + (size_t)row * 16 + hh];
    float vm[16];
    const u16* pr = proj + (size_t)row * N0;
    load_mix8(pr + 2048 + c0, hp, hn, p.rw_mu + 2048 + c0, vm);
    load_mix8(pr + 2048 + c0 + 8, hp, hn, p.rw_mu + 2048 + c0 + 8, vm + 8);
    float gv[16];
    unpack8(*(const u32x4*)(pr + 3072 + c0), gv);
    unpack8(*(const u32x4*)(pr + 3072 + c0 + 8), gv + 8);
    unsigned pk[8];
#pragma unroll
    for (int j = 0; j < 8; ++j) {
      const int ca = c0 + 2 * j, cb = ca + 1;
      const float ya = ((ov[2 * j] - mean) * rstd * p.rw_gn_g[ca] + p.rw_gn_b[ca] + bon * vm[2 * j]) * siluf_(gv[2 * j]);
      const float yb = ((ov[2 * j + 1] - mean) * rstd * p.rw_gn_g[cb] + p.rw_gn_b[cb] + bon * vm[2 * j + 1]) * siluf_(gv[2 * j + 1]);
      pk[j] = pack2(ya, yb);
    }
    u32x4* dd = (u32x4*)(hb + (size_t)row * 1024 + c0);
    dd[0] = u32x4{pk[0], pk[1], pk[2], pk[3]};
    dd[1] = u32x4{pk[4], pk[5], pk[6], pk[7]};
  }
}

DI void phase_qkprep(const Params& p) {
  const int TIDX = ltid();
  const int lane = TIDX & 63, wv = __builtin_amdgcn_readfirstlane(TIDX >> 6);
  const u16* raw = (const u16*)(p.ws + OFF_RAW);
  u16* Qs = (u16*)(p.ws + OFF_QS);
  u16* Ks = (u16*)(p.ws + OFF_KS);
  const float* rope = (const float*)(p.ws + OFF_ROPE);
  const int grp = lane >> 1, axis = lane & 1;
  const bool isq = grp < 16;
  const int hd = (grp & 15) >> 1, comp = grp & 1;
  const float* gain = (isq ? p.da_qn : p.da_kn) + axis * 32;
  for (int row = blockIdx.x * 4 + wv; row < T_ALL; row += gridDim.x * 4) {
    const bool lat = row < T_LAT;
    int b, t;
    if (lat) { b = row >> 13; t = row & 8191; } else { b = (row - T_LAT) >> 8; t = (row - T_LAT) & 255; }
    const u16* src = raw + (size_t)row * 2048 + lane * 32;
    float v[32];
#pragma unroll
    for (int q = 0; q < 4; ++q) unpack8(*(const u32x4*)(src + q * 8), v + q * 8);
    float ss = 0.f;
#pragma unroll
    for (int j = 0; j < 32; ++j) ss += v[j] * v[j];
    ss += __shfl_xor(ss, 1);
    const float rstd = rsqrtf(ss * (1.0f / 64.0f) + 1e-6f);
#pragma unroll
    for (int j = 0; j < 32; ++j) v[j] = v[j] * rstd * gain[j];
    if (lat) {
      const int pos = axis == 0 ? (t >> 6) : (t & 63);
#pragma unroll
      for (int f = 0; f < 16; ++f) {
        const float c = rope[pos * 16 + f], s = rope[2048 + pos * 16 + f];
        const float x1 = v[f], x2 = v[16 + f];
        v[f] = x1 * c - x2 * s; v[16 + f] = x2 * c + x1 * s;
      }
    }
    u16* dst;
    float sc = 1.0f;
    if (isq) {
      if (!lat) continue;
      sc = 0.125f * 1.4426950408889634f;
      dst = Qs + (((size_t)(b * 8 + hd) * 2 + comp) * 8192 + t) * 64 + axis * 32;
    } else {
      const int pp = lat ? 256 + t : t;
      dst = Ks + (((size_t)(b * 8 + hd) * 2 + comp) * LKV + pp) * 64 + axis * 32;
    }
#pragma unroll
    for (int q = 0; q < 4; ++q) {
      u32x4 o = {pack2(v[q * 8] * sc, v[q * 8 + 1] * sc), pack2(v[q * 8 + 2] * sc, v[q * 8 + 3] * sc),
                 pack2(v[q * 8 + 4] * sc, v[q * 8 + 5] * sc), pack2(v[q * 8 + 6] * sc, v[q * 8 + 7] * sc)};
      *(u32x4*)(dst + q * 8) = o;
    }
  }
}

typedef __attribute__((address_space(3))) unsigned* lds_uptr;
typedef __attribute__((address_space(1))) const unsigned* glb_uptr;
DI void dma16(const void* g, char* ldsbase) {
  __builtin_amdgcn_global_load_lds((glb_uptr)(g), (lds_uptr)(ldsbase), 16, 0, 0);
}

DI void attn_issue_tile(const u16* Kg, const u16* Vg, int k0, char* buf, int wv, int lane) {
  asm volatile("" : "+v"(lane));
  const int rr = lane >> 3, cp = lane & 7;
#pragma unroll
  for (int i = 0; i < 4; ++i) {
    const int seg = wv * 4 + i;
    const int c = seg >> 3, key = (seg & 7) * 8 + rr;
    const int sw = (key >> 1) & 7;
    dma16(Kg + ((size_t)c * LKV + k0 + key) * 64 + ((cp ^ sw) << 3), buf + seg * 1024);
    const int e = seg * 8 + rr;
    const int swv = (e >> 1) & 7;
    dma16(Vg + (size_t)e * LKV + k0 + ((cp ^ swv) << 3), buf + 16384 + seg * 1024);
  }
}

DI void phase_attn(const Params& p, char* smem) {
  const int TIDX = ltid();
  const int tid = TIDX, lane = tid & 63, wv = __builtin_amdgcn_readfirstlane(tid >> 6);
  const int r = lane & 31, h = lane >> 5;
  const u16* Qs = (const u16*)(p.ws + OFF_QS);
  const u16* Ks = (const u16*)(p.ws + OFF_KS);
  const u16* Vt = (const u16*)(p.ws + OFF_VT);
  const u16* GB = (const u16*)(p.ws + OFF_GB);
  u16* Y2 = (u16*)(p.ws + OFF_Y2);
  float lam;
  {
    float a = p.da_lam[lane] * p.da_lam[64 + lane];
    float bq = p.da_lam[128 + lane] * p.da_lam[192 + lane];
#pragma unroll
    for (int o = 32; o >= 1; o >>= 1) { a += __shfl_xor(a, o); bq += __shfl_xor(bq, o); }
    lam = __expf(a) - __expf(bq) + 0.35550906759096927f;
  }
  const float one_m_li = 1.0f - 0.35550906759096927f;
  const int sw = (r >> 1) & 7;
  int repa = REP_ATTN; asm volatile("" : "+s"(repa));
  for (int rp = 0; rp < repa; ++rp)
  for (int item = blockIdx.x; item < 1024; item += gridDim.x) {
    const int bh = (item & 7) * 2 + (item >> 9), qt = (item >> 3) & 63;
    const int q0 = qt * 128 + wv * 32;
    const u16* Kg = Ks + (size_t)bh * 2 * LKV * 64;
    const u16* Vg = Vt + (size_t)bh * 128 * LKV;
    __syncthreads();
    attn_issue_tile(Kg, Vg, 0, smem, wv, lane);
    bf16x8 qf[2][4];
#pragma unroll
    for (int c = 0; c < 2; ++c)
#pragma unroll
      for (int s = 0; s < 4; ++s)
        qf[c][s] = *(const bf16x8*)(Qs + (((size_t)bh * 2 + c) * 8192 + q0 + r) * 64 + s * 16 + 8 * h);
    f32x16 O[2][4];
#pragma unroll
    for (int c = 0; c < 2; ++c)
#pragma unroll
      for (int e = 0; e < 4; ++e)
#pragma unroll
        for (int i = 0; i < 16; ++i) O[c][e][i] = 0.f;
    f2 lsum[2] = {f2{0.f, 0.f}, f2{0.f, 0.f}};
#pragma unroll 1
    for (int kt = 0; kt < LKV / 64; ++kt) {
      char* buf = smem + (kt & 1) * 32768;
      asm volatile("s_waitcnt vmcnt(0)" ::: "memory");
      __syncthreads();
      if (kt + 1 < LKV / 64) attn_issue_tile(Kg, Vg, (kt + 1) * 64, smem + ((kt + 1) & 1) * 32768, wv, lane);
      const char* Kb = buf + r * 128;
      const char* Vb = buf + 16384 + r * 128;
#pragma unroll
      for (int sub = 0; sub < 2; ++sub) {
        f32x16 sacc[2];
#pragma unroll
        for (int c = 0; c < 2; ++c) {
#pragma unroll
          for (int i = 0; i < 16; ++i) sacc[c][i] = 0.f;
#pragma unroll
          for (int s = 0; s < 4; ++s) {
            const bf16x8 kf = *(const bf16x8*)(Kb + c * 8192 + sub * 4096 + (((2 * s + h) ^ sw) << 4));
            sacc[c] = MFMA32(kf, qf[c][s], sacc[c]);
          }
        }
#pragma unroll
        for (int c = 0; c < 2; ++c) {
          bf16x8 pf[2];
#pragma unroll
          for (int s = 0; s < 2; ++s) {
            float ps[8];
#pragma unroll
            for (int i = 0; i < 8; ++i) ps[i] = __builtin_amdgcn_exp2f(sacc[c][8 * s + i]);
            lsum[c] += f2{ps[0], ps[1]}; lsum[c] += f2{ps[2], ps[3]}; lsum[c] += f2{ps[4], ps[5]}; lsum[c] += f2{ps[6], ps[7]};
            u32x4 pk = {cvtpk(ps[0], ps[1]), cvtpk(ps[2], ps[3]), cvtpk(ps[4], ps[5]), cvtpk(ps[6], ps[7])};
            pf[s] = __builtin_bit_cast(bf16x8, pk);
          }
#pragma unroll
          for (int e = 0; e < 4; ++e)
#pragma unroll
            for (int s = 0; s < 2; ++s) {
              const bf16x8 vf = *(const bf16x8*)(Vb + e * 4096 + (((sub * 4 + 2 * s + h) ^ sw) << 4));
              O[c][e] = MFMA32(vf, pf[s], O[c][e]);
            }
        }
      }
    }
    float l0 = lsum[0][0] + lsum[0][1], l1 = lsum[1][0] + lsum[1][1];
    l0 += __shfl_xor(l0, 32); l1 += __shfl_xor(l1, 32);
    const float i0 = 1.0f / l0, i1 = lam / l1;
    float ss = 0.f;
#pragma unroll
    for (int e = 0; e < 4; ++e)
#pragma unroll
      for (int i = 0; i < 16; ++i) { const float o = O[0][e][i] * i0 - O[1][e][i] * i1; O[0][e][i] = o; ss += o * o; }
    ss += __shfl_xor(ss, 32);
    const float rstd = rsqrtf(ss * (1.0f / 128.0f) + 1e-5f) * one_m_li;
    const int b = bh >> 3, hd = bh & 7;
    int rl = r; asm volatile("" : "+v"(rl));
    const size_t row = (size_t)b * 8192 + q0 + rl;
#pragma unroll
    for (int e = 0; e < 4; ++e) {
#pragma unroll
      for (int g = 0; g < 4; ++g) {
        const int ee = e * 32 + 8 * g + 4 * h;
        const u32x2 gg = *(const u32x2*)(GB + row * 1024 + hd * 128 + ee);
        const float g0 = bflo(gg[0]), g1 = bfhi(gg[0]), g2 = bflo(gg[1]), g3 = bfhi(gg[1]);
        const f32x4 sl = *(const f32x4*)(p.da_subln + ee);
        const float y0 = O[0][e][4 * g] * rstd * sl[0] * g0;
        const float y1 = O[0][e][4 * g + 1] * rstd * sl[1] * g1;
        const float y2 = O[0][e][4 * g + 2] * rstd * sl[2] * g2;
        const float y3 = O[0][e][4 * g + 3] * rstd * sl[3] * g3;
        *(u32x2*)(Y2 + row * 1024 + hd * 128 + ee) = u32x2{cvtpk(y0, y1), cvtpk(y2, y3)};
      }
      asm volatile("" ::: "memory");
    }
  }
}

#define XB_TMO      128
#define XB_XCNT(j)  (256  + 64 * (j))
#define XB_XSUB(j)  (1280 + 64 * (j))
#define XB_XGEN(j)  (2304 + 64 * (j))
#define XB_TOP      3328
#define XB_TOPGEN   3392
#define XCD_BAR_WORDS 3456
#define XB_SPIN_CAP (1u << 18)
#define LAS __attribute__((address_space(3)))

__device__ __forceinline__ unsigned xb_ld(unsigned* p)              { return __hip_atomic_load(p, __ATOMIC_RELAXED, __HIP_MEMORY_SCOPE_AGENT); }
__device__ __forceinline__ unsigned xb_add(unsigned* p, unsigned v) { return __hip_atomic_fetch_add(p, v, __ATOMIC_RELAXED, __HIP_MEMORY_SCOPE_AGENT); }
__device__ __forceinline__ unsigned xb_xcc_id() { return (unsigned)__builtin_amdgcn_s_getreg((3 << 11) | 20) & 0xFu; }
#define XB_SPIN(cond, bar) do { unsigned _sp = 0; while (cond) { __builtin_amdgcn_s_sleep(1); \
    if ((++_sp & 255u) == 0u) { if (xb_ld(&(bar)[XB_TMO])) break; if (_sp > XB_SPIN_CAP) { atomicAdd(&(bar)[XB_TMO], 1u); break; } } } } while (0)

struct XcdBarrier {
    unsigned* bar; unsigned x;
    volatile LAS unsigned* st;
};

__device__ __forceinline__ XcdBarrier xcd_barrier_post(unsigned* bar, volatile LAS unsigned* st) {
    XcdBarrier b; b.bar = bar; b.x = xb_xcc_id(); b.st = st;
    if (threadIdx.x == 0) (void)xb_add(&bar[XB_XCNT(b.x)], 1u);
    return b;
}
__device__ __forceinline__ void xcd_barrier_complete(unsigned* bar, unsigned x, unsigned& nloc, unsigned& nx) {
    const unsigned G = gridDim.x * gridDim.y * gridDim.z;
    unsigned sum, cnt, mine, sp = 0u;
    for (;;) {
        sum = 0u; cnt = 0u; mine = 0u;
#pragma unroll
        for (unsigned j = 0; j < 16; ++j) { const unsigned c = xb_ld(&bar[XB_XCNT(j)]); sum += c; cnt += (c > 0u) ? 1u : 0u; mine = (j == x) ? c : mine; }
        if (sum == G) break;
        __builtin_amdgcn_s_sleep(1);
        if ((++sp & 255u) == 0u) { if (xb_ld(&bar[XB_TMO])) break; if (sp > XB_SPIN_CAP) { atomicAdd(&bar[XB_TMO], 1u); break; } }
    }
    nloc = mine > 0u ? mine : 1u; nx = cnt > 0u ? cnt : 1u;
}

__device__ __forceinline__ void xcd_barrier(const XcdBarrier& b) {
    asm volatile("s_waitcnt vmcnt(0)" ::: "memory");
    __syncthreads();
    if (threadIdx.x == 0) {
        unsigned* bar = b.bar;
        __builtin_amdgcn_s_waitcnt(0);
        unsigned nloc = b.st[0], nx = b.st[1];
        if (nloc == 0u) { xcd_barrier_complete(bar, b.x, nloc, nx); b.st[0] = nloc; b.st[1] = nx; }
        const unsigned old = xb_add(&bar[XB_XSUB(b.x)], 1u);
        const unsigned gen = old / nloc;
        if (old + 1u == (gen + 1u) * nloc) {
            __builtin_amdgcn_fence(__ATOMIC_RELEASE, "agent");
            asm volatile("s_waitcnt vmcnt(0)" ::: "memory");
            const unsigned og = xb_add(&bar[XB_TOP], 1u);
            const unsigned tg = og / nx;
            if (og + 1u == (tg + 1u) * nx) xb_add(&bar[XB_TOPGEN], 1u);
            else XB_SPIN(xb_ld(&bar[XB_TOPGEN]) == tg, bar);
            __builtin_amdgcn_fence(__ATOMIC_ACQUIRE, "agent");
            xb_add(&bar[XB_XGEN(b.x)], 1u);
            asm volatile("s_waitcnt vmcnt(0)" ::: "memory");
        } else {
            XB_SPIN(xb_ld(&bar[XB_XGEN(b.x)]) == gen, bar);
            __builtin_amdgcn_fence(__ATOMIC_ACQUIRE, "agent");
            asm volatile("s_waitcnt vmcnt(0)" ::: "memory");
        }
    }
    __syncthreads();
}


__global__ void __launch_bounds__(256, 2) fwd_megakernel(Params p) {
  extern __shared__ __attribute__((aligned(16))) char smem[];
  __shared__ uint4 xb_words;
  cg::grid_group grid = cg::this_grid();
  if (threadIdx.x == 0) xb_words = make_uint4(0u, 0u, 0u, 0u);
  __syncthreads();
  XcdBarrier xb = xcd_barrier_post((unsigned*)(p.ws + OFF_BAR), (volatile LAS unsigned*)&xb_words);
  phase_prep(p, smem);
  if (p.ws == nullptr) grid.sync();
  xcd_barrier(xb);
  phase_normmod(p, 0, p.x, p.ctx, true);
  xcd_barrier(xb);
  phase_gemm_wide16<0>(p, smem, (const u16*)(p.ws + OFF_HB), (const u16*)(p.ws + OFF_WT_IN0), 120, N0 / 256);
  phase_gemm<0>(p, smem, (const u16*)(p.ws + OFF_HB), (const u16*)(p.ws + OFF_WT_IN0), T_ALL / 128 - 120, N0 / 128, 120);
  xcd_barrier(xb);
  phase_scan<1>(p, smem);
  xcd_barrier(xb);
  phase_carry(p, smem);
  xcd_barrier(xb);
  phase_scan<2>(p, smem);
  xcd_barrier(xb);
  phase_readout(p);
  xcd_barrier(xb);
  phase_gemm_wide16<1>(p, smem, (const u16*)(p.ws + OFF_HB), (const u16*)(p.ws + OFF_WT_OUT0), 128, 4);
  phase_gemm<1>(p, smem, (const u16*)(p.ws + OFF_HB), (const u16*)(p.ws + OFF_WT_OUT0), T_ALL / 128 - 128, 8, 128);
  xcd_barrier(xb);
  phase_normmod(p, 1, p.out, (const float*)(p.ws + OFF_XC1), false);
  xcd_barrier(xb);
  phase_gemm_wide16<2>(p, smem, (const u16*)(p.ws + OFF_HB), (const u16*)(p.ws + OFF_WT_IN1), 128, N1 / 256);
  phase_gemm<2>(p, smem, (const u16*)(p.ws + OFF_HB), (const u16*)(p.ws + OFF_WT_IN1), T_ALL / 128 - 128, N1 / 128, 128);
  xcd_barrier(xb);
  phase_qkprep(p);
  xcd_barrier(xb);
  phase_attn(p, smem);
  xcd_barrier(xb);
  phase_gemm_wide16<3>(p, smem, (const u16*)(p.ws + OFF_Y2), (const u16*)(p.ws + OFF_WT_OUT1), T_LAT / 128, 4);
}

extern "C" void kernel_launch(void* const* d_in, const int* in_sizes, int n_in, void* d_out, int out_size, void* d_ws,
                              size_t ws_size, hipStream_t stream) {
  static int grid_blocks = 0;
  if (!grid_blocks) {
    int dev = 0, cus = 0, per_cu = 0;
    hipGetDevice(&dev);
    hipDeviceGetAttribute(&cus, hipDeviceAttributeMultiprocessorCount, dev);
    hipFuncSetAttribute((const void*)fwd_megakernel, hipFuncAttributeMaxDynamicSharedMemorySize, LDS_BYTES);
    hipOccupancyMaxActiveBlocksPerMultiprocessor(&per_cu, fwd_megakernel, 256, LDS_BYTES);
    if (per_cu < 1) per_cu = 1;
    if (per_cu > 2) per_cu = 2;
    grid_blocks = cus * per_cu;
    if (ws_size < 256 * MiB) fprintf(stderr, "kernel_launch: workspace too small: %zu\n", ws_size);
  }
  Params p{};
  const float** pp = (const float**)&p;
  for (int i = 0; i < 25; ++i) pp[i] = (const float*)d_in[i];
  p.out = (float*)d_out;
  p.ws = (char*)d_ws;
  hipMemsetAsync((char*)d_ws + OFF_BAR, 0, XCD_BAR_WORDS * sizeof(unsigned), stream);
  void* args[] = {&p};
  hipError_t e = hipLaunchCooperativeKernel((void*)fwd_megakernel, dim3(grid_blocks), dim3(256), args, LDS_BYTES, stream);
  if (e != hipSuccess) fprintf(stderr, "cooperative launch failed: %s (grid %d)\n", hipGetErrorString(e), grid_blocks);
}
```

```cpp
#include <hip/hip_runtime.h>
#include <hip/hip_cooperative_groups.h>
#include <cstdio>
namespace cg = cooperative_groups;

#define DI __device__ __forceinline__
typedef unsigned short u16;
using bf16x8 = __attribute__((ext_vector_type(8))) short;
using s16x4  = __attribute__((ext_vector_type(4))) short;
using f32x16 = __attribute__((ext_vector_type(16))) float;
using f32x4  = __attribute__((ext_vector_type(4))) float;
using f32x32 = __attribute__((ext_vector_type(32))) float;
using f2     = __attribute__((ext_vector_type(2))) float;
using u32x4  = __attribute__((ext_vector_type(4))) unsigned;
using u32x2  = __attribute__((ext_vector_type(2))) unsigned;

constexpr int T_LAT = 16384, T_CTX = 512, T_ALL = 16896, DM = 1024;
constexpr int N0 = 4352, N1 = 4096;
constexpr int LKV = 8448;
constexpr int NCHUNK = 32, LCH = 264, NSUB = 33;

constexpr size_t MiB = 1048576;
constexpr size_t OFF_WT_IN0 = 0;
constexpr size_t OFF_WT_OUT0 = 8912896;
constexpr size_t OFF_WT_IN1 = 11010048;
constexpr size_t OFF_WT_OUT1 = 19398656;
constexpr size_t OFF_W2T = 21495808;
constexpr size_t OFF_A2T = 21757952;
constexpr size_t OFF_MOD = 21 * MiB;
constexpr size_t OFF_ROPE = OFF_MOD + 73728;
constexpr size_t OFF_BONUS = 21 * MiB + 131072;
constexpr size_t OFF_XC1 = 24 * MiB;
constexpr size_t OFF_OCTX = 26 * MiB;
constexpr size_t OFF_BAR = 29 * MiB;
constexpr size_t OFF_PROJ = 30 * MiB;
constexpr size_t OFF_HB = 171 * MiB;
constexpr size_t OFF_STP = 171 * MiB;
constexpr size_t OFF_STS = 203 * MiB;
constexpr size_t OFF_RAW = 30 * MiB;
constexpr size_t OFF_VT = 96 * MiB;
constexpr size_t OFF_KS = 129 * MiB;
constexpr size_t OFF_GB = 204 * MiB;
constexpr size_t OFF_QS = OFF_HB;
constexpr size_t OFF_Y2 = OFF_RAW;

constexpr int LDS_BYTES = 78336;

struct Params {
  const float *x, *c, *ctx, *c_ctx, *ada_w, *ada_b, *norm_g, *rw_in, *rw_mu, *rw_w0, *rw_w2, *rw_a0, *rw_a2,
      *rw_kk, *rw_ka, *rw_rk, *rw_gn_g, *rw_gn_b, *rw_out, *da_in, *da_qn, *da_kn, *da_lam, *da_subln, *da_out;
  float* out;
  char* ws;
};

DI u16 f2bf(float x) { unsigned u = __float_as_uint(x); u += 0x7fffu + ((u >> 16) & 1u); return (u16)(u >> 16); }
DI float bf2f(u16 h) { return __uint_as_float(((unsigned)h) << 16); }
DI unsigned pack2(float a, float b) { return (unsigned)f2bf(a) | ((unsigned)f2bf(b) << 16); }
typedef __bf16 bf16v2 __attribute__((ext_vector_type(2)));
DI unsigned cvtpk(float a, float b) { f2 v = {a, b}; return __builtin_bit_cast(unsigned, __builtin_convertvector(v, bf16v2)); }
DI float fsig(float x) { return __builtin_amdgcn_rcpf(1.0f + __expf(-x)); }
DI int ltid() { int t = threadIdx.x; asm volatile("" : "+v"(t)); return t; }
DI float bflo(unsigned u) { return __uint_as_float(u << 16); }
DI float bfhi(unsigned u) { return __uint_as_float(u & 0xffff0000u); }
DI float sigmoidf_(float x) { return 1.0f / (1.0f + __expf(-x)); }
DI float siluf_(float x) { return x * sigmoidf_(x); }
DI int crow(int i, int h) { return (i & 3) + 8 * (i >> 2) + 4 * h; }
DI void unpack8(const u32x4& u, float* f) {
  f[0] = bflo(u[0]); f[1] = bfhi(u[0]); f[2] = bflo(u[1]); f[3] = bfhi(u[1]);
  f[4] = bflo(u[2]); f[5] = bfhi(u[2]); f[6] = bflo(u[3]); f[7] = bfhi(u[3]);
}
#define WAVE_LDS_SYNC() asm volatile("s_waitcnt lgkmcnt(0)" ::: "memory")
#define MFMA32(a, b, c) __builtin_amdgcn_mfma_f32_32x32x16_bf16((a), (b), (c), 0, 0, 0)
#define MFMA16(a, b, c) __builtin_amdgcn_mfma_f32_16x16x32_bf16((a), (b), (c), 0, 0, 0)

__device__ const float INV_FREQ[16] = {
    1.0f, 0.5623413251903491f, 0.31622776601683794f, 0.1778279410038923f, 0.1f, 0.05623413251903491f,
    0.03162277660168379f, 0.01778279410038923f, 0.01f, 0.005623413251903491f, 0.0031622776601683794f,
    0.001778279410038923f, 0.001f, 0.0005623413251903491f, 0.00031622776601683794f, 0.0001778279410038923f};

DI void transpose_tile(const float* __restrict__ src, u16* __restrict__ dst, int K, int N, int kt, int nt, float* tile) {
  const int TIDX = ltid();
  const int tid = TIDX;
  {
    const int n = tid & 63, k0 = tid >> 6;
#pragma unroll
    for (int i = 0; i < 16; ++i) {
      const int k = k0 + 4 * i;
      tile[k * 65 + n] = src[(size_t)(kt * 64 + k) * N + nt * 64 + n];
    }
  }
  __syncthreads();
  {
    const int n = tid >> 2, kq = tid & 3;
    unsigned pk[8];
#pragma unroll
    for (int j = 0; j < 8; ++j) pk[j] = pack2(tile[(kq * 16 + 2 * j) * 65 + n], tile[(kq * 16 + 2 * j + 1) * 65 + n]);
    u32x4* d = (u32x4*)(dst + (size_t)(nt * 64 + n) * K + kt * 64 + kq * 16);
    d[0] = u32x4{pk[0], pk[1], pk[2], pk[3]};
    d[1] = u32x4{pk[4], pk[5], pk[6], pk[7]};
  }
  __syncthreads();
}

DI void phase_prep(const Params& p, char* smem) {
  const int TIDX = ltid();
  float* tile = (float*)smem;
  const int tid = TIDX;
  constexpr int T_IN0 = 16 * 68, T_OUT = 256, T_IN1 = 16 * 64, T_LORA = 16;
  constexpr int E0 = T_IN0, E1 = E0 + T_OUT, E2 = E1 + T_IN1, E3 = E2 + T_OUT, E4 = E3 + 2 * T_LORA, E5 = E4 + 2 * T_LORA;
  constexpr int NMOD = 192;
  constexpr int TOTAL = E5 + NMOD + 1;
  for (int it = blockIdx.x; it < TOTAL; it += gridDim.x) {
    if (it < E0) { transpose_tile(p.rw_in, (u16*)(p.ws + OFF_WT_IN0), 1024, N0, it / 68, it % 68, tile); }
    else if (it < E1) { int j = it - E0; transpose_tile(p.rw_out, (u16*)(p.ws + OFF_WT_OUT0), 1024, 1024, j >> 4, j & 15, tile); }
    else if (it < E3) {   }
    else if (it < E4) { int j = it - E3; int d = j >> 4; transpose_tile(p.rw_w2 + (size_t)d * 65536, (u16*)(p.ws + OFF_W2T) + (size_t)d * 65536, 64, 1024, 0, j & 15, tile); }
    else if (it < E5) { int j = it - E4; int d = j >> 4; transpose_tile(p.rw_a2 + (size_t)d * 65536, (u16*)(p.ws + OFF_A2T) + (size_t)d * 65536, 64, 1024, 0, j & 15, tile); }
    else if (it < E5 + NMOD) {
      const int j = it - E5; const int layer = j / 96; const int nb = (j % 96) * 32;
      const int n = nb + (tid & 31), kg = tid >> 5;
      const float* W = p.ada_w + (size_t)layer * 1024 * 3072;
      float a0 = 0.f, a1 = 0.f, a2 = 0.f;
#pragma unroll 8
      for (int k = kg * 128; k < kg * 128 + 128; ++k) {
        const float w = W[(size_t)k * 3072 + n];
        a0 += siluf_(p.c[k]) * w; a1 += siluf_(p.c[1024 + k]) * w; a2 += siluf_(p.c_ctx[k]) * w;
      }
      tile[(kg * 3 + 0) * 32 + (tid & 31)] = a0; tile[(kg * 3 + 1) * 32 + (tid & 31)] = a1; tile[(kg * 3 + 2) * 32 + (tid & 31)] = a2;
      __syncthreads();
      if (tid < 96) {
        const int s = tid >> 5, nn = tid & 31;
        float acc = p.ada_b[layer * 3072 + nb + nn];
#pragma unroll
        for (int g = 0; g < 8; ++g) acc += tile[(g * 3 + s) * 32 + nn];
        ((float*)(p.ws + OFF_MOD))[(layer * 3 + s) * 3072 + nb + nn] = acc;
      }
      __syncthreads();
    } else {
      float* rope = (float*)(p.ws + OFF_ROPE);
      for (int e = tid; e < 2048; e += 256) {
        const int pos = e >> 4, f = e & 15;
        const float ang = (float)pos * INV_FREQ[f];
        const float rev = ang * 0.15915494309189535f;
        const float fr = rev - rintf(rev);
        const float a = fr * 6.283185307179586f;
        rope[e] = __cosf(a); rope[2048 + e] = __sinf(a);
      }
    }
  }
}

DI void phase_normmod(const Params& p, int layer, const float* __restrict__ xl, const float* __restrict__ xc, bool zero_o) {
  const int TIDX = ltid();
  const int lane = TIDX & 63, wv = __builtin_amdgcn_readfirstlane(TIDX >> 6);
  const float* mod = (const float*)(p.ws + OFF_MOD) + layer * 3 * 3072;
  const float* g = p.norm_g + layer * 1024;
  u16* hb = (u16*)(p.ws + OFF_HB);
  for (int row = blockIdx.x * 4 + wv; row < T_ALL; row += gridDim.x * 4) {
    const float* src; const float* m;
    if (row < T_LAT) { src = xl + (size_t)row * 1024; m = mod + (row >> 13) * 3072; }
    else { src = xc + (size_t)(row - T_LAT) * 1024; m = mod + 2 * 3072; }
    float v[16];
    float ss = 0.f;
#pragma unroll
    for (int q = 0; q < 4; ++q) {
      const f32x4 t = *(const f32x4*)(src + lane * 16 + q * 4);
      v[q * 4] = t[0]; v[q * 4 + 1] = t[1]; v[q * 4 + 2] = t[2]; v[q * 4 + 3] = t[3];
      ss += t[0] * t[0] + t[1] * t[1] + t[2] * t[2] + t[3] * t[3];
    }
#pragma unroll
    for (int o = 32; o >= 1; o >>= 1) ss += __shfl_xor(ss, o);
    const float rstd = rsqrtf(ss * (1.0f / 1024.0f) + 1e-6f);
    unsigned pk[8];
#pragma unroll
    for (int j = 0; j < 8; ++j) {
      const int c0 = lane * 16 + 2 * j;
      const float h0 = v[2 * j] * rstd * g[c0] * (1.0f + m[1024 + c0]) + m[c0];
      const float h1 = v[2 * j + 1] * rstd * g[c0 + 1] * (1.0f + m[1024 + c0 + 1]) + m[c0 + 1];
      pk[j] = pack2(h0, h1);
    }
    u32x4* d = (u32x4*)(hb + (size_t)row * 1024 + lane * 16);
    d[0] = u32x4{pk[0], pk[1], pk[2], pk[3]};
    d[1] = u32x4{pk[4], pk[5], pk[6], pk[7]};
    if (zero_o) {
      float* o = (row < T_LAT) ? (p.out + (size_t)row * 1024) : ((float*)(p.ws + OFF_OCTX) + (size_t)(row - T_LAT) * 1024);
      const f32x4 z = {0.f, 0.f, 0.f, 0.f};
#pragma unroll
      for (int q = 0; q < 4; ++q) *(f32x4*)(o + lane * 16 + q * 4) = z;
    }
  }
}

constexpr int LDT = 72;
#ifndef REP_GEMM
#define REP_GEMM 1
#endif
#ifndef REP_SCAN
#define REP_SCAN 1
#endif
#ifndef REP_ATTN
#define REP_ATTN 1
#endif
template <int EPI>
DI void phase_gemm(const Params& p, char* smem, const u16* __restrict__ A, const u16* __restrict__ Bt, int Mtiles, int Ntiles, int Mbase = 0) {
  const int TIDX = ltid();
  u16* As0 = (u16*)smem;
  const int tid = TIDX, lane = tid & 63, wv = __builtin_amdgcn_readfirstlane(tid >> 6);
  const int r = lane & 31, h = lane >> 5;
  const int wm = wv >> 1, wn = wv & 1;
  const int ntiles = Mtiles * Ntiles;
  const int npad = (ntiles + 511) & ~511;
  int repg = (EPI == 0 || EPI == 2) ? REP_GEMM : 1; asm volatile("" : "+s"(repg));
  for (int rp = 0; rp < repg; ++rp)
  for (int tt = blockIdx.x; tt < npad; tt += gridDim.x) {
    const int tile = (tt & ~511) + ((tt & 7) << 6) + ((tt >> 3) & 63);
    if (tile >= ntiles) continue;
    const int band = tile / (4 * Ntiles), rem = tile % (4 * Ntiles);
    const int mt_ = band * 4 + (rem & 3), nt_ = rem >> 2;
    const int m0 = (Mbase + mt_) * 128, n0 = nt_ * 128;
    f32x16 acc[2][2];
#pragma unroll
    for (int a = 0; a < 2; ++a)
#pragma unroll
      for (int b = 0; b < 2; ++b)
#pragma unroll
        for (int i = 0; i < 16; ++i) acc[a][b][i] = 0.f;
    u32x4 ra[4], rb[4];
    const u16* Ag = A + (size_t)m0 * 1024;
    const u16* Bg = Bt + (size_t)n0 * 1024;
#pragma unroll
    for (int i = 0; i < 4; ++i) {
      const int id = tid + 256 * i; const int row = id >> 3, cc = id & 7;
      ra[i] = *(const u32x4*)(Ag + (size_t)row * 1024 + cc * 8);
      rb[i] = *(const u32x4*)(Bg + (size_t)row * 1024 + cc * 8);
    }
    __syncthreads();
    for (int kt = 0; kt < 16; ++kt) {
      u16* As = As0 + (kt & 1) * (256 * LDT);
      u16* Bs = As + 128 * LDT;
#pragma unroll
      for (int i = 0; i < 4; ++i) {
        const int id = tid + 256 * i; const int row = id >> 3, cc = id & 7;
        *(u32x4*)(As + row * LDT + cc * 8) = ra[i];
        *(u32x4*)(Bs + row * LDT + cc * 8) = rb[i];
      }
      __syncthreads();
      if (kt + 1 < 16) {
#pragma unroll
        for (int i = 0; i < 4; ++i) {
          const int id = tid + 256 * i; const int row = id >> 3, cc = id & 7;
          ra[i] = *(const u32x4*)(Ag + (size_t)row * 1024 + (kt + 1) * 64 + cc * 8);
          rb[i] = *(const u32x4*)(Bg + (size_t)row * 1024 + (kt + 1) * 64 + cc * 8);
        }
      }
#pragma unroll
      for (int ks = 0; ks < 4; ++ks) {
        bf16x8 fa[2], fb[2];
#pragma unroll
        for (int t = 0; t < 2; ++t) {
          fa[t] = *(const bf16x8*)(As + (wm * 64 + t * 32 + r) * LDT + ks * 16 + 8 * h);
          fb[t] = *(const bf16x8*)(Bs + (wn * 64 + t * 32 + r) * LDT + ks * 16 + 8 * h);
        }
#pragma unroll
        for (int a = 0; a < 2; ++a)
#pragma unroll
          for (int b = 0; b < 2; ++b) acc[a][b] = MFMA32(fa[a], fb[b], acc[a][b]);
      }
    }
#pragma unroll
    for (int a = 0; a < 2; ++a)
#pragma unroll
      for (int b = 0; b < 2; ++b) {
        const int col = n0 + wn * 64 + b * 32 + r;
        const int rbase = m0 + wm * 64 + a * 32;
        if (EPI == 0) {
          u16* C = (u16*)(p.ws + OFF_PROJ);
#pragma unroll
          for (int i = 0; i < 16; ++i) C[(size_t)(rbase + crow(i, h)) * N0 + col] = f2bf(acc[a][b][i]);
        } else if (EPI == 1) {
          const float* mod = (const float*)(p.ws + OFF_MOD);
#pragma unroll
          for (int i = 0; i < 16; ++i) {
            const int row = rbase + crow(i, h);
            if (row < T_LAT) {
              const float gate = mod[(row >> 13) * 3072 + 2048 + col];
              p.out[(size_t)row * 1024 + col] = p.x[(size_t)row * 1024 + col] + gate * acc[a][b][i];
            } else {
              const int rc = row - T_LAT;
              const float gate = mod[2 * 3072 + 2048 + col];
              ((float*)(p.ws + OFF_XC1))[(size_t)rc * 1024 + col] = p.ctx[(size_t)rc * 1024 + col] + gate * acc[a][b][i];
            }
          }
        } else if (EPI == 2) {
          if (n0 < 2048) {
            u16* C = (u16*)(p.ws + OFF_RAW);
#pragma unroll
            for (int i = 0; i < 16; ++i) C[(size_t)(rbase + crow(i, h)) * 2048 + col] = f2bf(acc[a][b][i]);
          } else if (n0 < 3072) {
            u16* Vt = (u16*)(p.ws + OFF_VT);
            const int e = col - 2048;
#pragma unroll
            for (int g = 0; g < 4; ++g) {
              const int row = rbase + 8 * g + 4 * h;
              int bb, pp;
              if (row < T_LAT) { bb = row >> 13; pp = 256 + (row & 8191); } else { bb = (row - T_LAT) >> 8; pp = (row - T_LAT) & 255; }
              u32x2 v = {cvtpk(acc[a][b][4 * g], acc[a][b][4 * g + 1]), cvtpk(acc[a][b][4 * g + 2], acc[a][b][4 * g + 3])};
              const int q4 = (pp >> 2) & 3;
              const int pq = (pp & ~15) | ((((q4 & 1) << 1) | (q4 >> 1)) << 2);
              *(u32x2*)(Vt + ((size_t)bb * 1024 + e) * LKV + pq) = v;
            }
          } else {
            u16* G = (u16*)(p.ws + OFF_GB);
#pragma unroll
            for (int i = 0; i < 16; ++i) {
              const int row = rbase + crow(i, h);
              if (row < T_LAT) G[(size_t)row * 1024 + col - 3072] = f2bf(siluf_(acc[a][b][i]));
            }
          }
        } else {
          const float* mod = (const float*)(p.ws + OFF_MOD) + 3 * 3072;
#pragma unroll
          for (int i = 0; i < 16; ++i) {
            const int row = rbase + crow(i, h);
            const float gate = mod[(row >> 13) * 3072 + 2048 + col];
            float* o = p.out + (size_t)row * 1024 + col;
            *o = *o + gate * acc[a][b][i];
          }
        }
      }
  }
}

template <int EPI>
DI void phase_gemm_wide(const Params& p, char* smem, const u16* __restrict__ A, const u16* __restrict__ Bt, int Mtiles, int Ntiles, int Mbase = 0) {
  const int TIDX = ltid();
  u16* As = (u16*)smem;
  u16* Bs = As + 128 * LDT;
  const int tid = TIDX, lane = tid & 63, wv = __builtin_amdgcn_readfirstlane(tid >> 6);
  const int r = lane & 31, h = lane >> 5;
  const int wm = wv >> 1, wn = wv & 1;
  const int ntiles = Mtiles * Ntiles;
  const int npad = (ntiles + 511) & ~511;
  int repg = (EPI == 0 || EPI == 2) ? REP_GEMM : 1; asm volatile("" : "+s"(repg));
  for (int rp = 0; rp < repg; ++rp)
  for (int tt = blockIdx.x; tt < npad; tt += gridDim.x) {
    const int tile = (tt & ~511) + ((tt & 7) << 6) + ((tt >> 3) & 63);
    if (tile >= ntiles) continue;
    const int band = tile / (4 * Ntiles), rem = tile % (4 * Ntiles);
    const int mt_ = band * 4 + (rem & 3), nt_ = rem >> 2;
    const int m0 = (Mbase + mt_) * 128, n0 = nt_ * 256;
    f32x16 acc[2][4];
#pragma unroll
    for (int a = 0; a < 2; ++a)
#pragma unroll
      for (int b = 0; b < 4; ++b)
#pragma unroll
        for (int i = 0; i < 16; ++i) acc[a][b][i] = 0.f;
    u32x4 ra[4], rb[8];
    const u16* Ag = A + (size_t)m0 * 1024;
    const u16* Bg = Bt + (size_t)n0 * 1024;
#pragma unroll
    for (int i = 0; i < 8; ++i) {
      const int id = tid + 256 * i; const int row = id >> 3, cc = id & 7;
      if (i < 4) ra[i] = *(const u32x4*)(Ag + (size_t)row * 1024 + cc * 8);
      rb[i] = *(const u32x4*)(Bg + (size_t)row * 1024 + cc * 8);
    }
    for (int kt = 0; kt < 16; ++kt) {
      __syncthreads();
      int ts = tid; asm volatile("" : "+v"(ts));
#pragma unroll
      for (int i = 0; i < 8; ++i) {
        const int id = ts + 256 * i; const int row = id >> 3, cc = id & 7;
        if (i < 4) *(u32x4*)(As + row * LDT + cc * 8) = ra[i];
        *(u32x4*)(Bs + row * LDT + cc * 8) = rb[i];
      }
      __syncthreads();
      if (kt + 1 < 16) {
        int tl = tid; asm volatile("" : "+v"(tl));
#pragma unroll
        for (int i = 0; i < 8; ++i) {
          const int id = tl + 256 * i; const int row = id >> 3, cc = id & 7;
          if (i < 4) ra[i] = *(const u32x4*)(Ag + (size_t)row * 1024 + (kt + 1) * 64 + cc * 8);
          rb[i] = *(const u32x4*)(Bg + (size_t)row * 1024 + (kt + 1) * 64 + cc * 8);
        }
      }
#pragma unroll
      for (int ks = 0; ks < 4; ++ks) {
        bf16x8 fa[2], fb[4];
#pragma unroll
        for (int t = 0; t < 2; ++t) fa[t] = *(const bf16x8*)(As + (wm * 64 + t * 32 + r) * LDT + ks * 16 + 8 * h);
#pragma unroll
        for (int t = 0; t < 4; ++t) fb[t] = *(const bf16x8*)(Bs + (wn * 128 + t * 32 + r) * LDT + ks * 16 + 8 * h);
#pragma unroll
        for (int a = 0; a < 2; ++a)
#pragma unroll
          for (int b = 0; b < 4; ++b) acc[a][b] = MFMA32(fa[a], fb[b], acc[a][b]);
      }
    }
#pragma unroll
    for (int a = 0; a < 2; ++a)
#pragma unroll
      for (int b = 0; b < 4; ++b) {
        const int col = n0 + wn * 128 + b * 32 + r;
        const int rbase = m0 + wm * 64 + a * 32;
        if (EPI == 0) {
          u16* C = (u16*)(p.ws + OFF_PROJ);
#pragma unroll
          for (int i = 0; i < 16; ++i) C[(size_t)(rbase + crow(i, h)) * N0 + col] = f2bf(acc[a][b][i]);
        } else if (EPI == 1) {
          const float* mod = (const float*)(p.ws + OFF_MOD);
#pragma unroll
          for (int i = 0; i < 16; ++i) {
            const int row = rbase + crow(i, h);
            if (row < T_LAT) {
              const float gate = mod[(row >> 13) * 3072 + 2048 + col];
              p.out[(size_t)row * 1024 + col] = p.x[(size_t)row * 1024 + col] + gate * acc[a][b][i];
            } else {
              const int rc = row - T_LAT;
              const float gate = mod[2 * 3072 + 2048 + col];
              ((float*)(p.ws + OFF_XC1))[(size_t)rc * 1024 + col] = p.ctx[(size_t)rc * 1024 + col] + gate * acc[a][b][i];
            }
          }
        } else if (EPI == 2) {
          if (n0 < 2048) {
            u16* C = (u16*)(p.ws + OFF_RAW);
#pragma unroll
            for (int i = 0; i < 16; ++i) C[(size_t)(rbase + crow(i, h)) * 2048 + col] = f2bf(acc[a][b][i]);
          } else if (n0 < 3072) {
            u16* Vt = (u16*)(p.ws + OFF_VT);
            const int e = col - 2048;
#pragma unroll
            for (int g = 0; g < 4; ++g) {
              const int row = rbase + 8 * g + 4 * h;
              int bb, pp;
              if (row < T_LAT) { bb = row >> 13; pp = 256 + (row & 8191); } else { bb = (row - T_LAT) >> 8; pp = (row - T_LAT) & 255; }
              u32x2 v = {cvtpk(acc[a][b][4 * g], acc[a][b][4 * g + 1]), cvtpk(acc[a][b][4 * g + 2], acc[a][b][4 * g + 3])};
              const int q4 = (pp >> 2) & 3;
              const int pq = (pp & ~15) | ((((q4 & 1) << 1) | (q4 >> 1)) << 2);
              *(u32x2*)(Vt + ((size_t)bb * 1024 + e) * LKV + pq) = v;
            }
          } else {
            u16* G = (u16*)(p.ws + OFF_GB);
#pragma unroll
            for (int i = 0; i < 16; ++i) {
              const int row = rbase + crow(i, h);
              if (row < T_LAT) G[(size_t)row * 1024 + col - 3072] = f2bf(siluf_(acc[a][b][i]));
            }
          }
        } else {
          const float* mod = (const float*)(p.ws + OFF_MOD) + 3 * 3072;
#pragma unroll
          for (int i = 0; i < 16; ++i) {
            const int row = rbase + crow(i, h);
            const float gate = mod[(row >> 13) * 3072 + 2048 + col];
            float* o = p.out + (size_t)row * 1024 + col;
            *o = *o + gate * acc[a][b][i];
          }
        }
      }
  }
}

constexpr int LDW = 80;
template <int EPI>
DI void phase_gemm_wide16(const Params& p, char* smem, const u16* __restrict__ A, const u16* __restrict__ Bt, int Mtiles, int Ntiles, int Mbase = 0) {
  const int TIDX = ltid();
  u16* As = (u16*)smem;
  u16* Bs = As + 128 * LDW;
  const int tid = TIDX, lane = tid & 63, wv = __builtin_amdgcn_readfirstlane(tid >> 6);
  const int lr = lane & 15, lq = lane >> 4;
  const int wm = wv >> 1, wn = wv & 1;
  const int ntiles = Mtiles * Ntiles;
  const int npad = (ntiles + 511) & ~511;
  for (int tt = blockIdx.x; tt < npad; tt += gridDim.x) {
    const int tile = (tt & ~511) + ((tt & 7) << 6) + ((tt >> 3) & 63);
    if (tile >= ntiles) continue;
    const int band = tile / (4 * Ntiles), rem = tile % (4 * Ntiles);
    const int mt_ = band * 4 + (rem & 3), nt_ = rem >> 2;
    const int m0 = (Mbase + mt_) * 128, n0 = nt_ * 256;
    f32x4 acc[4][8];
#pragma unroll
    for (int t = 0; t < 4; ++t)
#pragma unroll
      for (int u = 0; u < 8; ++u) acc[t][u] = f32x4{0.f, 0.f, 0.f, 0.f};
    u32x4 ra[4], rb[8];
    const u16* Ag = A + (size_t)m0 * 1024;
    const u16* Bg = Bt + (size_t)n0 * 1024;
#pragma unroll
    for (int i = 0; i < 8; ++i) {
      const int id = tid + 256 * i; const int row = id >> 3, cc = id & 7;
      if (i < 4) ra[i] = *(const u32x4*)(Ag + (size_t)row * 1024 + cc * 8);
      rb[i] = *(const u32x4*)(Bg + (size_t)row * 1024 + cc * 8);
    }
    for (int kt = 0; kt < 16; ++kt) {
      __syncthreads();
      int ts = tid; asm volatile("" : "+v"(ts));
#pragma unroll
      for (int i = 0; i < 8; ++i) {
        const int id = ts + 256 * i; const int row = id >> 3, cc = id & 7;
        if (i < 4) *(u32x4*)(As + row * LDW + cc * 8) = ra[i];
        *(u32x4*)(Bs + row * LDW + cc * 8) = rb[i];
      }
      __syncthreads();
      if (kt + 1 < 16) {
        int tl = tid; asm volatile("" : "+v"(tl));
#pragma unroll
        for (int i = 0; i < 8; ++i) {
          const int id = tl + 256 * i; const int row = id >> 3, cc = id & 7;
          if (i < 4) ra[i] = *(const u32x4*)(Ag + (size_t)row * 1024 + (kt + 1) * 64 + cc * 8);
          rb[i] = *(const u32x4*)(Bg + (size_t)row * 1024 + (kt + 1) * 64 + cc * 8);
        }
      }
#pragma unroll
      for (int ks = 0; ks < 2; ++ks) {
        bf16x8 fa[4], fb[8];
#pragma unroll
        for (int t = 0; t < 4; ++t) fa[t] = *(const bf16x8*)(As + (wm * 64 + t * 16 + lr) * LDW + ks * 32 + lq * 8);
#pragma unroll
        for (int u = 0; u < 8; ++u) fb[u] = *(const bf16x8*)(Bs + (wn * 128 + u * 16 + lr) * LDW + ks * 32 + lq * 8);
#pragma unroll
        for (int t = 0; t < 4; ++t)
#pragma unroll
          for (int u = 0; u < 8; ++u) acc[t][u] = MFMA16(fa[t], fb[u], acc[t][u]);
      }
    }
#pragma unroll
    for (int t = 0; t < 4; ++t)
#pragma unroll
      for (int u = 0; u < 8; ++u) {
        const int col = n0 + wn * 128 + u * 16 + lr;
        const int row0 = m0 + wm * 64 + t * 16 + 4 * lq;
        if (EPI == 0) {
          u16* C = (u16*)(p.ws + OFF_PROJ);
#pragma unroll
          for (int g = 0; g < 4; ++g) C[(size_t)(row0 + g) * N0 + col] = f2bf(acc[t][u][g]);
        } else if (EPI == 1) {
          const float* mod = (const float*)(p.ws + OFF_MOD);
#pragma unroll
          for (int g = 0; g < 4; ++g) {
            const int row = row0 + g;
            if (row < T_LAT) {
              const float gate = mod[(row >> 13) * 3072 + 2048 + col];
              p.out[(size_t)row * 1024 + col] = p.x[(size_t)row * 1024 + col] + gate * acc[t][u][g];
            } else {
              const int rc = row - T_LAT;
              const float gate = mod[2 * 3072 + 2048 + col];
              ((float*)(p.ws + OFF_XC1))[(size_t)rc * 1024 + col] = p.ctx[(size_t)rc * 1024 + col] + gate * acc[t][u][g];
            }
          }
        } else if (EPI == 3) {
          const float* mod = (const float*)(p.ws + OFF_MOD) + 3 * 3072;
#pragma unroll
          for (int g = 0; g < 4; ++g) {
            const int row = row0 + g;
            const float gate = mod[(row >> 13) * 3072 + 2048 + col];
            float* o = p.out + (size_t)row * 1024 + col;
            *o = *o + gate * acc[t][u][g];
          }
        } else {
          if (n0 < 2048) {
            u16* C = (u16*)(p.ws + OFF_RAW);
#pragma unroll
            for (int g = 0; g < 4; ++g) C[(size_t)(row0 + g) * 2048 + col] = f2bf(acc[t][u][g]);
          } else if (n0 < 3072) {
            u16* Vt = (u16*)(p.ws + OFF_VT);
            const int e = col - 2048;
            int bb, pp;
            if (row0 < T_LAT) { bb = row0 >> 13; pp = 256 + (row0 & 8191); } else { bb = (row0 - T_LAT) >> 8; pp = (row0 - T_LAT) & 255; }
            u32x2 v = {cvtpk(acc[t][u][0], acc[t][u][1]), cvtpk(acc[t][u][2], acc[t][u][3])};
            const int q4 = (pp >> 2) & 3;
            const int pq = (pp & ~15) | ((((q4 & 1) << 1) | (q4 >> 1)) << 2);
            *(u32x2*)(Vt + ((size_t)bb * 1024 + e) * LKV + pq) = v;
          } else {
            u16* G = (u16*)(p.ws + OFF_GB);
#pragma unroll
            for (int g = 0; g < 4; ++g)
              if (row0 + g < T_LAT) G[(size_t)(row0 + g) * 1024 + col - 3072] = f2bf(siluf_(acc[t][u][g]));
          }
        }
      }
  }
}

DI void tokmap(int pos, int d, int b, int& row, bool& hp, bool& hn) {
  if (pos < 256) { const int t = d ? 255 - pos : pos; row = T_LAT + b * 256 + t; hp = t > 0; hn = t < 255; }
  else { const int q = pos - 256; const int t = d ? 8191 - q : q; row = b * 8192 + t; hp = t > 0; hn = t < 8191; }
}

DI void load_mix8(const u16* pr, bool hp, bool hn, const float* mu, float* out) {
  const u32x4 uc = *(const u32x4*)pr;
  u32x4 up = {0u, 0u, 0u, 0u}, un = {0u, 0u, 0u, 0u};
  if (hp) up = *(const u32x4*)(pr - N0);
  if (hn) un = *(const u32x4*)(pr + N0);
  float c[8], a[8], n[8];
  unpack8(uc, c); unpack8(up, a); unpack8(un, n);
  const f32x4 m0 = *(const f32x4*)mu, m1 = *(const f32x4*)(mu + 4);
#pragma unroll
  for (int j = 0; j < 8; ++j) {
    const float m = j < 4 ? m0[j & 3] : m1[j & 3];
    out[j] = c[j] + m * (0.5f * (a[j] + n[j]) - c[j]);
  }
}

DI void mixraw8(const u32x4& uc, const u32x4& up, const u32x4& un, bool hp, bool hn, const float* mu, float* out) {
  float c[8], a[8], n[8];
  unpack8(uc, c); unpack8(up, a); unpack8(un, n);
  const f32x4 m0 = *(const f32x4*)mu, m1 = *(const f32x4*)(mu + 4);
#pragma unroll
  for (int j = 0; j < 8; ++j) {
    const float m = j < 4 ? m0[j & 3] : m1[j & 3];
    const float av = hp ? a[j] : 0.f, nv = hn ? n[j] : 0.f;
    out[j] = c[j] + m * (0.5f * (av + nv) - c[j]);
  }
}

template <int PASS>
DI void phase_scan(const Params& p, char* smem) {
  const int TIDX = ltid();
  const int lane = TIDX & 63, wv = __builtin_amdgcn_readfirstlane(TIDX >> 6);
  float* sm = (float*)smem + wv * 3584;
  float* sW = sm; float* sKK = sm + 512; float* sKKA = sm + 1024; float* sKD = sm + 1536; float* sR = sm + 2048; float* sV = sm + 2560; float* sA = sm + 3072;
  const u16* proj = (const u16*)(p.ws + OFF_PROJ);
  float* stP = (float*)(p.ws + OFF_STP);
  float* stS = (float*)(p.ws + OFF_STS);
  float* bonus = (float*)(p.ws + OFF_BONUS);
  const int nwaves = gridDim.x * 4;
  int reps = (PASS == 1) ? REP_SCAN : 1; asm volatile("" : "+s"(reps));
  for (int rp = 0; rp < reps; ++rp)
  for (int item = blockIdx.x * 4 + wv; item < 2048; item += nwaves) {
    const int chain = item >> 5, chunk = item & 31;
    const int d = chain & 1, hh = (chain >> 1) & 15, b = chain >> 5;
    u16* cB = (u16*)(smem + 57344);
    float* cP = (float*)(smem + 57344 + 18432);
    __syncthreads();
    {
      const int tid = TIDX;
#pragma unroll
      for (int i = 0; i < 4; ++i) {
        const int id = tid + 256 * i;
        const int which = id >> 9, row = (id >> 3) & 63, cc = id & 7;
        const u16* src = (const u16*)(p.ws + (which ? OFF_A2T : OFF_W2T)) + ((size_t)d * 1024 + hh * 64 + row) * 64 + cc * 8;
        *(u32x4*)(cB + (which * 64 + row) * 72 + cc * 8) = *(const u32x4*)src;
      }
      if (tid < 160) {
        const int a = tid >> 4, q = (tid & 15) * 4;
        const float* src;
        switch (a) {
          case 0: src = p.rw_mu + 3072 + d * 64; break;
          case 1: src = p.rw_mu + 3072 + 128 + d * 64; break;
          case 2: src = p.rw_mu + hh * 64; break;
          case 3: src = p.rw_mu + 1024 + hh * 64; break;
          case 4: src = p.rw_mu + 2048 + hh * 64; break;
          case 5: src = p.rw_w0 + d * 1024 + hh * 64; break;
          case 6: src = p.rw_a0 + d * 1024 + hh * 64; break;
          case 7: src = p.rw_kk + hh * 64; break;
          case 8: src = p.rw_ka + hh * 64; break;
          default: src = p.rw_rk + hh * 64; break;
        }
        *(f32x4*)(cP + a * 64 + q) = *(const f32x4*)(src + q);
      }
    }
    __syncthreads();
    if (PASS == 1 && chunk == 31) continue;
    f32x16 S[2][2];
    f32x32 P[2];
    {
      int li = lane; asm volatile("" : "+v"(li));
      const int lv = li & 31, lh = li >> 5;
      if (PASS == 1) {
#pragma unroll
        for (int kt = 0; kt < 2; ++kt)
#pragma unroll
          for (int vt = 0; vt < 2; ++vt)
#pragma unroll
            for (int i = 0; i < 16; ++i) {
              S[kt][vt][i] = 0.f;
              P[vt][16 * kt + i] = (32 * kt + (i & 3) + 8 * (i >> 2) + 4 * lh == 32 * vt + lv) ? 1.f : 0.f;
            }
      } else {
        if (chunk == 0) {
#pragma unroll
          for (int kt = 0; kt < 2; ++kt)
#pragma unroll
            for (int vt = 0; vt < 2; ++vt)
#pragma unroll
              for (int i = 0; i < 16; ++i) S[kt][vt][i] = 0.f;
        } else {
          const float* src = stS + (size_t)(item - 1) * 4096;
#pragma unroll
          for (int kt = 0; kt < 2; ++kt)
#pragma unroll
            for (int vt = 0; vt < 2; ++vt)
#pragma unroll
              for (int g = 0; g < 4; ++g) {
                const f32x4 t = *(const f32x4*)(src + (32 * vt + lv) * 64 + 32 * kt + 8 * g + 4 * lh);
                S[kt][vt][4 * g] = t[0]; S[kt][vt][4 * g + 1] = t[1]; S[kt][vt][4 * g + 2] = t[2]; S[kt][vt][4 * g + 3] = t[3];
              }
        }
      }
    }
    for (int sc = 0; sc < NSUB; ++sc) {
      const int p0 = chunk * LCH + sc * 8;
      int ln = lane; asm volatile("" : "+v"(ln));
      u32x4 rawA[2][3], rawB[3][3];
      bool hpA, hnA, hpB, hnB; int rowB;
      {
        int rowA; tokmap(p0 + (ln & 7), d, b, rowA, hpA, hnA);
        const u16* prA = proj + (size_t)rowA * N0 + 4096 + d * 64 + (ln >> 4) * 8 + ((ln >> 3) & 1) * 32;
        const ptrdiff_t dpA = hpA ? -N0 : 0, dnA = hnA ? N0 : 0;
#pragma unroll
        for (int X = 0; X < 2; ++X) {
          const u16* q = prA + X * 128;
          rawA[X][0] = *(const u32x4*)q; rawA[X][1] = *(const u32x4*)(q + dpA); rawA[X][2] = *(const u32x4*)(q + dnA);
        }
        tokmap(p0 + (ln >> 3), d, b, rowB, hpB, hnB);
        const u16* prB = proj + (size_t)rowB * N0 + hh * 64 + (ln & 7) * 8;
        const ptrdiff_t dpB = hpB ? -N0 : 0, dnB = hnB ? N0 : 0;
#pragma unroll
        for (int X = (PASS == 2 ? 0 : 1); X < 3; ++X) {
          const u16* q = prB + X * 1024;
          rawB[X][0] = *(const u32x4*)q; rawB[X][1] = *(const u32x4*)(q + dpB); rawB[X][2] = *(const u32x4*)(q + dnB);
        }
      }
      {
        const int m = ln & 15, kg = ln >> 4;
        bf16x8 fa[2][2];
        const int ssel = (m >> 3) & 1;
#pragma unroll
        for (int X = 0; X < 2; ++X) {
          float mx[8];
          mixraw8(rawA[X][0], rawA[X][1], rawA[X][2], hpA, hnA, cP + X * 64 + ssel * 32 + kg * 8, mx);
          if (X == 0) {
#pragma unroll
            for (int j = 0; j < 8; ++j) { const float e = __expf(2.0f * mx[j]); mx[j] = 1.0f - 2.0f * __builtin_amdgcn_rcpf(e + 1.0f); }
          }
          u32x4 own = {cvtpk(mx[0], mx[1]), cvtpk(mx[2], mx[3]), cvtpk(mx[4], mx[5]), cvtpk(mx[6], mx[7])};
          u32x4 oth;
#pragma unroll
          for (int q = 0; q < 4; ++q) oth[q] = (unsigned)__shfl_down((int)own[q], 8);
          fa[X][0] = __builtin_bit_cast(bf16x8, own);
          fa[X][1] = __builtin_bit_cast(bf16x8, ssel ? own : oth);
        }
#pragma unroll
        for (int nt = 0; nt < 4; ++nt) {
          f32x4 aw = {0.f, 0.f, 0.f, 0.f}, aa = {0.f, 0.f, 0.f, 0.f};
#pragma unroll
          for (int s = 0; s < 2; ++s) {
            const bf16x8 bw = *(const bf16x8*)(cB + (16 * nt + m) * 72 + s * 32 + kg * 8);
            const bf16x8 ba = *(const bf16x8*)(cB + (64 + 16 * nt + m) * 72 + s * 32 + kg * 8);
            aw = MFMA16(fa[0][s], bw, aw);
            aa = MFMA16(fa[1][s], ba, aa);
          }
          const int ch = 16 * nt + m;
          const float w0 = cP[5 * 64 + ch];
          const float a0 = cP[6 * 64 + ch];
          if (kg < 2) {
#pragma unroll
            for (int rg = 0; rg < 4; ++rg) {
              sW[(4 * kg + rg) * 64 + ch] = w0 + aw[rg];
              sA[(4 * kg + rg) * 64 + ch] = a0 + aa[rg];
            }
          }
        }
      }
      WAVE_LDS_SYNC();
      __builtin_amdgcn_sched_barrier(0);
      {
        const int tk = ln >> 3, g = ln & 7;
        const int row = rowB;
        const int cb = hh * 64 + g * 8;
        float rr[8], kk[8], vv[8];
        if (PASS == 2) mixraw8(rawB[0][0], rawB[0][1], rawB[0][2], hpB, hnB, cP + 2 * 64 + g * 8, rr);
        else { for (int j = 0; j < 8; ++j) rr[j] = 0.f; }
        mixraw8(rawB[1][0], rawB[1][1], rawB[1][2], hpB, hnB, cP + 3 * 64 + g * 8, kk);
        mixraw8(rawB[2][0], rawB[2][1], rawB[2][2], hpB, hnB, cP + 4 * 64 + g * 8, vv);
        float av[8], kkn[8], kd[8], pkkv[8], pkav[8], prkv[8];
        { const f32x4 t0 = *(const f32x4*)(sA + tk * 64 + g * 8), t1 = *(const f32x4*)(sA + tk * 64 + g * 8 + 4);
          av[0] = fsig(t0[0]); av[1] = fsig(t0[1]); av[2] = fsig(t0[2]); av[3] = fsig(t0[3]); av[4] = fsig(t1[0]); av[5] = fsig(t1[1]); av[6] = fsig(t1[2]); av[7] = fsig(t1[3]); }
        { const f32x4 t0 = *(const f32x4*)(sW + tk * 64 + g * 8), t1 = *(const f32x4*)(sW + tk * 64 + g * 8 + 4);
          f32x4 o0, o1;
#pragma unroll
          for (int j = 0; j < 4; ++j) { o0[j] = __expf(-0.6065306597126334f * fsig(t0[j])); o1[j] = __expf(-0.6065306597126334f * fsig(t1[j])); }
          *(f32x4*)(sW + tk * 64 + g * 8) = o0; *(f32x4*)(sW + tk * 64 + g * 8 + 4) = o1; }
        WAVE_LDS_SYNC();
        { float Wc = 1.0f;
#pragma unroll
          for (int j = 0; j < 8; ++j) { Wc *= sW[j * 64 + ln]; sW[j * 64 + ln] = Wc; } }
        WAVE_LDS_SYNC();
        float wcur[8], wprv[8];
        { const f32x4 t0 = *(const f32x4*)(sW + tk * 64 + g * 8), t1 = *(const f32x4*)(sW + tk * 64 + g * 8 + 4);
          const int tp = tk > 0 ? tk - 1 : 0;
          const f32x4 u0 = *(const f32x4*)(sW + tp * 64 + g * 8), u1 = *(const f32x4*)(sW + tp * 64 + g * 8 + 4);
#pragma unroll
          for (int j = 0; j < 4; ++j) { wcur[j] = t0[j]; wcur[j + 4] = t1[j]; wprv[j] = tk > 0 ? u0[j] : 1.0f; wprv[j + 4] = tk > 0 ? u1[j] : 1.0f; } }
        { const float* q7 = cP + 7 * 64 + g * 8;
          const f32x4 a0 = *(const f32x4*)(q7), a1 = *(const f32x4*)(q7 + 4), b0 = *(const f32x4*)(q7 + 64), b1 = *(const f32x4*)(q7 + 68),
                      c0 = *(const f32x4*)(q7 + 128), c1 = *(const f32x4*)(q7 + 132);
#pragma unroll
          for (int j = 0; j < 4; ++j) { pkkv[j] = a0[j]; pkkv[j + 4] = a1[j]; pkav[j] = b0[j]; pkav[j + 4] = b1[j]; prkv[j] = c0[j]; prkv[j + 4] = c1[j]; } }
        float ss = 0.f, bon = 0.f;
#pragma unroll
        for (int j = 0; j < 8; ++j) {
          kkn[j] = kk[j] * pkkv[j]; ss += kkn[j] * kkn[j];
          kd[j] = kk[j] * (1.0f + (av[j] - 1.0f) * pkav[j]);
          bon += rr[j] * kd[j] * prkv[j];
        }
        ss += __shfl_xor(ss, 1); ss += __shfl_xor(ss, 2); ss += __shfl_xor(ss, 4);
        const float inv = rsqrtf(ss + 1e-12f);
        if (PASS == 2) {
          bon += __shfl_xor(bon, 1); bon += __shfl_xor(bon, 2); bon += __shfl_xor(bon, 4);
          if (g == 0) bonus[(size_t)d * (T_ALL * 16) + (size_t)row * 16 + hh] = bon;
        }
        float iw[8];
#pragma unroll
        for (int j = 0; j < 8; ++j) iw[j] = __builtin_amdgcn_rcpf(wcur[j]);
        float* o;
        o = sKK + tk * 64 + g * 8;
        *(f32x4*)o = f32x4{kkn[0] * inv * wprv[0], kkn[1] * inv * wprv[1], kkn[2] * inv * wprv[2], kkn[3] * inv * wprv[3]};
        *(f32x4*)(o + 4) = f32x4{kkn[4] * inv * wprv[4], kkn[5] * inv * wprv[5], kkn[6] * inv * wprv[6], kkn[7] * inv * wprv[7]};
        o = sKKA + tk * 64 + g * 8;
        *(f32x4*)o = f32x4{kkn[0] * inv * av[0] * iw[0], kkn[1] * inv * av[1] * iw[1], kkn[2] * inv * av[2] * iw[2], kkn[3] * inv * av[3] * iw[3]};
        *(f32x4*)(o + 4) = f32x4{kkn[4] * inv * av[4] * iw[4], kkn[5] * inv * av[5] * iw[5], kkn[6] * inv * av[6] * iw[6], kkn[7] * inv * av[7] * iw[7]};
        o = sKD + tk * 64 + g * 8;
        *(f32x4*)o = f32x4{kd[0] * iw[0], kd[1] * iw[1], kd[2] * iw[2], kd[3] * iw[3]};
        *(f32x4*)(o + 4) = f32x4{kd[4] * iw[4], kd[5] * iw[5], kd[6] * iw[6], kd[7] * iw[7]};
        if (PASS == 2) {
          o = sR + tk * 64 + g * 8;
          *(f32x4*)o = f32x4{rr[0] * wcur[0], rr[1] * wcur[1], rr[2] * wcur[2], rr[3] * wcur[3]};
          *(f32x4*)(o + 4) = f32x4{rr[4] * wcur[4], rr[5] * wcur[5], rr[6] * wcur[6], rr[7] * wcur[7]};
        }
        o = sV + tk * 64 + g * 8;
        *(f32x4*)o = f32x4{vv[0], vv[1], vv[2], vv[3]};
        *(f32x4*)(o + 4) = f32x4{vv[4], vv[5], vv[6], vv[7]};
      }
      WAVE_LDS_SYNC();
      __builtin_amdgcn_sched_barrier(0);
      float* obase = nullptr; ptrdiff_t ostep = d ? -1024 : 1024;
      if (PASS == 2) {
        int row0; bool hp0, hn0; tokmap(p0, d, b, row0, hp0, hn0);
        obase = ((row0 < T_LAT) ? (p.out + (size_t)row0 * 1024) : ((float*)(p.ws + OFF_OCTX) + (size_t)(row0 - T_LAT) * 1024)) + hh * 64 + lane;
      }
      const int lv31 = lane & 31, lh1 = lane >> 5;
      __builtin_amdgcn_s_setprio(1);
#pragma unroll 1
      for (int j = 0; j < 8; ++j) {
        f32x4 kkv[2][4];
#pragma unroll
        for (int kt = 0; kt < 2; ++kt)
#pragma unroll
          for (int g = 0; g < 4; ++g) kkv[kt][g] = *(const f32x4*)(sKK + j * 64 + 32 * kt + 8 * g + 4 * lh1);
        float aop[2], vvv[2];
        const float akka = sKKA[j * 64 + lane];
#pragma unroll
        for (int t = 0; t < 2; ++t) {
          aop[t] = (lh1 ? sKD : sKKA)[j * 64 + 32 * t + lv31];
          vvv[t] = sV[j * 64 + 32 * t + lv31];
        }
        float saS[2], saP[2];
#pragma unroll
        for (int vt = 0; vt < 2; ++vt) {
          f2 a2 = {0.f, 0.f}, b2 = {0.f, 0.f};
#pragma unroll
          for (int kt = 0; kt < 2; ++kt)
#pragma unroll
            for (int g = 0; g < 4; ++g) {
              a2 += f2{S[kt][vt][4 * g], S[kt][vt][4 * g + 1]} * f2{kkv[kt][g][0], kkv[kt][g][1]};
              a2 += f2{S[kt][vt][4 * g + 2], S[kt][vt][4 * g + 3]} * f2{kkv[kt][g][2], kkv[kt][g][3]};
              if (PASS == 1) {
                b2 += f2{P[vt][16 * kt + 4 * g], P[vt][16 * kt + 4 * g + 1]} * f2{kkv[kt][g][0], kkv[kt][g][1]};
                b2 += f2{P[vt][16 * kt + 4 * g + 2], P[vt][16 * kt + 4 * g + 3]} * f2{kkv[kt][g][2], kkv[kt][g][3]};
              }
            }
          float x = a2[0] + a2[1];
          x += __shfl_xor(x, 32);
          saS[vt] = x;
          if (PASS == 1) { float y = b2[0] + b2[1]; y += __shfl_xor(y, 32); saP[vt] = y; }
        }
#pragma unroll
        for (int vt = 0; vt < 2; ++vt) {
          const float bS = lh1 ? vvv[vt] : -saS[vt];
          if (PASS == 1) P[vt] = __builtin_amdgcn_mfma_f32_32x32x1f32(akka, -saP[vt], P[vt], 0, 0, 0);
#pragma unroll
          for (int kt = 0; kt < 2; ++kt) {
            S[kt][vt] = __builtin_amdgcn_mfma_f32_32x32x2f32(aop[kt], bS, S[kt][vt], 0, 0, 0);
          }
        }
        if (PASS == 2) {
          f32x4 rv[2][4];
#pragma unroll
          for (int kt = 0; kt < 2; ++kt)
#pragma unroll
            for (int g = 0; g < 4; ++g) rv[kt][g] = *(const f32x4*)(sR + j * 64 + 32 * kt + 8 * g + 4 * lh1);
          float ov[2];
#pragma unroll
          for (int vt = 0; vt < 2; ++vt) {
            f2 a2 = {0.f, 0.f};
#pragma unroll
            for (int kt = 0; kt < 2; ++kt)
#pragma unroll
              for (int g = 0; g < 4; ++g) {
                a2 += f2{S[kt][vt][4 * g], S[kt][vt][4 * g + 1]} * f2{rv[kt][g][0], rv[kt][g][1]};
                a2 += f2{S[kt][vt][4 * g + 2], S[kt][vt][4 * g + 3]} * f2{rv[kt][g][2], rv[kt][g][3]};
              }
            float x = a2[0] + a2[1];
            x += __shfl_xor(x, 32);
            ov[vt] = x;
          }
          atomicAdd(obase + (ptrdiff_t)j * ostep, lh1 ? ov[1] : ov[0]);
        }
      }
      __builtin_amdgcn_s_setprio(0);
      {
        f32x4 w7[2][4];
#pragma unroll
        for (int kt = 0; kt < 2; ++kt)
#pragma unroll
          for (int g = 0; g < 4; ++g) w7[kt][g] = *(const f32x4*)(sW + 7 * 64 + 32 * kt + 8 * g + 4 * lh1);
#pragma unroll
        for (int kt = 0; kt < 2; ++kt)
#pragma unroll
          for (int vt = 0; vt < 2; ++vt)
#pragma unroll
            for (int i = 0; i < 16; ++i) {
              S[kt][vt][i] *= w7[kt][i >> 2][i & 3];
              if (PASS == 1) P[vt][16 * kt + i] *= w7[kt][i >> 2][i & 3];
            }
      }
      WAVE_LDS_SYNC();
    }
    if (PASS == 1) {
      int li = lane; asm volatile("" : "+v"(li));
      const int lv = li & 31, lh = li >> 5;
      float* dP = stP + (size_t)item * 4096;
      float* dS = stS + (size_t)item * 4096;
#pragma unroll
      for (int kt = 0; kt < 2; ++kt)
#pragma unroll
        for (int vt = 0; vt < 2; ++vt)
#pragma unroll
          for (int g = 0; g < 4; ++g) {
            const int off = (32 * vt + lv) * 64 + 32 * kt + 8 * g + 4 * lh;
            *(f32x4*)(dP + off) = f32x4{P[vt][16 * kt + 4 * g], P[vt][16 * kt + 4 * g + 1], P[vt][16 * kt + 4 * g + 2], P[vt][16 * kt + 4 * g + 3]};
            *(f32x4*)(dS + off) = f32x4{S[kt][vt][4 * g], S[kt][vt][4 * g + 1], S[kt][vt][4 * g + 2], S[kt][vt][4 * g + 3]};
          }
    }
  }
}

DI void phase_carry(const Params& p, char* smem) {
  const int TIDX = ltid();
  float* cur = (float*)smem;
  const int tid = TIDX, lane = tid & 63, w = __builtin_amdgcn_readfirstlane(tid >> 6);
  const int lc = lane & 15, lq = lane >> 4;
  float* stP = (float*)(p.ws + OFF_STP);
  float* stS = (float*)(p.ws + OFF_STS);
  for (int it = blockIdx.x; it < 256; it += gridDim.x) {
    const int chain = it >> 2, rg = it & 3;
    const size_t slot0 = (size_t)chain * 32;
    __syncthreads();
    {
      const int row = tid >> 4, c4 = (tid & 15) * 4;
      const f32x4 t = *(const f32x4*)(stS + (slot0 * 64 + rg * 16 + row) * 64 + c4);
      *(f32x4*)(cur + row * 68 + c4) = t;
    }
    __syncthreads();
    float pn[16]; f32x4 an;
    {
      const float* Pm = stP + (slot0 + 1) * 4096;
#pragma unroll
      for (int s = 0; s < 16; ++s) pn[s] = Pm[(size_t)(4 * s + lq) * 64 + 16 * w + lc];
#pragma unroll
      for (int rr = 0; rr < 4; ++rr) an[rr] = stS[((slot0 + 1) * 64 + rg * 16 + 4 * lq + rr) * 64 + 16 * w + lc];
    }
    for (int c = 1; c < 31; ++c) {
      const size_t slot = slot0 + c;
      float pj[16]; f32x4 acc = an;
#pragma unroll
      for (int s = 0; s < 16; ++s) pj[s] = pn[s];
      if (c + 1 < 31) {
        const float* Pm = stP + (slot + 1) * 4096;
#pragma unroll
        for (int s = 0; s < 16; ++s) pn[s] = Pm[(size_t)(4 * s + lq) * 64 + 16 * w + lc];
#pragma unroll
        for (int rr = 0; rr < 4; ++rr) an[rr] = stS[((slot + 1) * 64 + rg * 16 + 4 * lq + rr) * 64 + 16 * w + lc];
      }
#pragma unroll
      for (int s = 0; s < 16; ++s) {
        const float a = cur[lc * 68 + 4 * s + lq];
        acc = __builtin_amdgcn_mfma_f32_16x16x4f32(a, pj[s], acc, 0, 0, 0);
      }
      __syncthreads();
#pragma unroll
      for (int rr = 0; rr < 4; ++rr) {
        cur[(4 * lq + rr) * 68 + 16 * w + lc] = acc[rr];
        stS[(slot * 64 + rg * 16 + 4 * lq + rr) * 64 + 16 * w + lc] = acc[rr];
      }
      __syncthreads();
    }
  }
  {
    const int nidle = (int)gridDim.x > 256 ? (int)gridDim.x - 256 : 0;
    int t0, tstep;
    if (nidle > 0) { t0 = (int)blockIdx.x - 256; tstep = nidle; if (t0 < 0) t0 = 1 << 30; }
    else { t0 = (int)blockIdx.x; tstep = (int)gridDim.x; }
    __syncthreads();
    for (int t = t0; t < 1280; t += tstep) {
      if (t < 1024) transpose_tile(p.da_in, (u16*)(p.ws + OFF_WT_IN1), 1024, N1, t >> 6, t & 63, (float*)smem);
      else { const int j = t - 1024; transpose_tile(p.da_out, (u16*)(p.ws + OFF_WT_OUT1), 1024, 1024, j >> 4, j & 15, (float*)smem); }
    }
  }
}

DI void phase_readout(const Params& p) {
  const int TIDX = ltid();
  const int lane = TIDX & 63, wv = __builtin_amdgcn_readfirstlane(TIDX >> 6);
  const u16* proj = (const u16*)(p.ws + OFF_PROJ);
  const float* bonus = (const float*)(p.ws + OFF_BONUS);
  u16* hb = (u16*)(p.ws + OFF_HB);
  for (int row = blockIdx.x * 4 + wv; row < T_ALL; row += gridDim.x * 4) {
    const float* o = (row < T_LAT) ? (p.out + (size_t)row * 1024) : ((const float*)(p.ws + OFF_OCTX) + (size_t)(row - T_LAT) * 1024);
    bool hp, hn;
    if (row < T_LAT) { const int t = row & 8191; hp = t > 0; hn = t < 8191; } else { const int t = (row - T_LAT) & 255; hp = t > 0; hn = t < 255; }
    const int c0 = lane * 16, hh = lane >> 2;
    float ov[16];
    float s = 0.f;
#pragma unroll
    for (int q = 0; q < 4; ++q) { const f32x4 t = *(const f32x4*)(o + c0 + q * 4); ov[q * 4] = t[0]; ov[q * 4 + 1] = t[1]; ov[q * 4 + 2] = t[2]; ov[q * 4 + 3] = t[3]; s += t[0] + t[1] + t[2] + t[3]; }
    s += __shfl_xor(s, 1); s += __shfl_xor(s, 2);
    const float mean = s * (1.0f / 64.0f);
    float vs = 0.f;
#pragma unroll
    for (int j = 0; j < 16; ++j) { const float dlt = ov[j] - mean; vs += dlt * dlt; }
    vs += __shfl_xor(vs, 1); vs += __shfl_xor(vs, 2);
    const float rstd = rsqrtf(vs * (1.0f / 64.0f) + 64e-5f);
    const float bon = bonus[(size_t)row * 16 + hh] + bonus[(size_t)(T_ALL * 16) + (size_t)row * 16 + hh];
    float vm[16];
    const u16* pr = proj + (size_t)row * N0;
    load_mix8(pr + 2048 + c0, hp, hn, p.rw_mu + 2048 + c0, vm);
    load_mix8(pr + 2048 + c0 + 8, hp, hn, p.rw_mu + 2048 + c0 + 8, vm + 8);
    float gv[16];
    unpack8(*(const u32x4*)(pr + 3072 + c0), gv);
    unpack8(*(const u32x4*)(pr + 3072 + c0 + 8), gv + 8);
    unsigned pk[8];
#pragma unroll
    for (int j = 0; j < 8; ++j) {
      const int ca = c0 + 2 * j, cb = ca + 1;
      const float ya = ((ov[2 * j] - mean) * rstd * p.rw_gn_g[ca] + p.rw_gn_b[ca] + bon * vm[2 * j]) * siluf_(gv[2 * j]);
      const float yb = ((ov[2 * j + 1] - mean) * rstd * p.rw_gn_g[cb] + p.rw_gn_b[cb] + bon * vm[2 * j + 1]) * siluf_(gv[2 * j + 1]);
      pk[j] = pack2(ya, yb);
    }
    u32x4* dd = (u32x4*)(hb + (size_t)row * 1024 + c0);
    dd[0] = u32x4{pk[0], pk[1], pk[2], pk[3]};
    dd[1] = u32x4{pk[4], pk[5], pk[6], pk[7]};
  }
}

DI void phase_qkprep(const Params& p) {
  const int TIDX = ltid();
  const int lane = TIDX & 63, wv = __builtin_amdgcn_readfirstlane(TIDX >> 6);
  const u16* raw = (const u16*)(p.ws + OFF_RAW);
  u16* Qs = (u16*)(p.ws + OFF_QS);
  u16* Ks = (u16*)(p.ws + OFF_KS);
  const float* rope = (const float*)(p.ws + OFF_ROPE);
  const int grp = lane >> 1, axis = lane & 1;
  const bool isq = grp < 16;
  const int hd = (grp & 15) >> 1, comp = grp & 1;
  const float* gain = (isq ? p.da_qn : p.da_kn) + axis * 32;
  for (int row = blockIdx.x * 4 + wv; row < T_ALL; row += gridDim.x * 4) {
    const bool lat = row < T_LAT;
    int b, t;
    if (lat) { b = row >> 13; t = row & 8191; } else { b = (row - T_LAT) >> 8; t = (row - T_LAT) & 255; }
    const u16* src = raw + (size_t)row * 2048 + lane * 32;
    float v[32];
#pragma unroll
    for (int q = 0; q < 4; ++q) unpack8(*(const u32x4*)(src + q * 8), v + q * 8);
    float ss = 0.f;
#pragma unroll
    for (int j = 0; j < 32; ++j) ss += v[j] * v[j];
    ss += __shfl_xor(ss, 1);
    const float rstd = rsqrtf(ss * (1.0f / 64.0f) + 1e-6f);
#pragma unroll
    for (int j = 0; j < 32; ++j) v[j] = v[j] * rstd * gain[j];
    if (lat) {
      const int pos = axis == 0 ? (t >> 6) : (t & 63);
#pragma unroll
      for (int f = 0; f < 16; ++f) {
        const float c = rope[pos * 16 + f], s = rope[2048 + pos * 16 + f];
        const float x1 = v[f], x2 = v[16 + f];
        v[f] = x1 * c - x2 * s; v[16 + f] = x2 * c + x1 * s;
      }
    }
    u16* dst;
    float sc = 1.0f;
    if (isq) {
      if (!lat) continue;
      sc = 0.125f * 1.4426950408889634f;
      dst = Qs + (((size_t)(b * 8 + hd) * 2 + comp) * 8192 + t) * 64 + axis * 32;
    } else {
      const int pp = lat ? 256 + t : t;
      dst = Ks + (((size_t)(b * 8 + hd) * 2 + comp) * LKV + pp) * 64 + axis * 32;
    }
#pragma unroll
    for (int q = 0; q < 4; ++q) {
      u32x4 o = {pack2(v[q * 8] * sc, v[q * 8 + 1] * sc), pack2(v[q * 8 + 2] * sc, v[q * 8 + 3] * sc),
                 pack2(v[q * 8 + 4] * sc, v[q * 8 + 5] * sc), pack2(v[q * 8 + 6] * sc, v[q * 8 + 7] * sc)};
      *(u32x4*)(dst + q * 8) = o;
    }
  }
}

typedef __attribute__((address_space(3))) unsigned* lds_uptr;
typedef __attribute__((address_space(1))) const unsigned* glb_uptr;
DI void dma16(const void* g, char* ldsbase) {
  __builtin_amdgcn_global_load_lds((glb_uptr)(g), (lds_uptr)(ldsbase), 16, 0, 0);
}

DI void attn_issue_tile(const u16* Kg, const u16* Vg, int k0, char* buf, int wv, int lane) {
  asm volatile("" : "+v"(lane));
  const int rr = lane >> 3, cp = lane & 7;
#pragma unroll
  for (int i = 0; i < 4; ++i) {
    const int seg = wv * 4 + i;
    const int c = seg >> 3, key = (seg & 7) * 8 + rr;
    const int sw = (key >> 1) & 7;
    dma16(Kg + ((size_t)c * LKV + k0 + key) * 64 + ((cp ^ sw) << 3), buf + seg * 1024);
    const int e = seg * 8 + rr;
    const int swv = (e >> 1) & 7;
    dma16(Vg + (size_t)e * LKV + k0 + ((cp ^ swv) << 3), buf + 16384 + seg * 1024);
  }
}

DI void phase_attn(const Params& p, char* smem) {
  const int TIDX = ltid();
  const int tid = TIDX, lane = tid & 63, wv = __builtin_amdgcn_readfirstlane(tid >> 6);
  const int r = lane & 31, h = lane >> 5;
  const u16* Qs = (const u16*)(p.ws + OFF_QS);
  const u16* Ks = (const u16*)(p.ws + OFF_KS);
  const u16* Vt = (const u16*)(p.ws + OFF_VT);
  const u16* GB = (const u16*)(p.ws + OFF_GB);
  u16* Y2 = (u16*)(p.ws + OFF_Y2);
  float lam;
  {
    float a = p.da_lam[lane] * p.da_lam[64 + lane];
    float bq = p.da_lam[128 + lane] * p.da_lam[192 + lane];
#pragma unroll
    for (int o = 32; o >= 1; o >>= 1) { a += __shfl_xor(a, o); bq += __shfl_xor(bq, o); }
    lam = __expf(a) - __expf(bq) + 0.35550906759096927f;
  }
  const float one_m_li = 1.0f - 0.35550906759096927f;
  const int sw = (r >> 1) & 7;
  int repa = REP_ATTN; asm volatile("" : "+s"(repa));
  for (int rp = 0; rp < repa; ++rp)
  for (int item = blockIdx.x; item < 1024; item += gridDim.x) {
    const int bh = (item & 7) * 2 + (item >> 9), qt = (item >> 3) & 63;
    const int q0 = qt * 128 + wv * 32;
    const u16* Kg = Ks + (size_t)bh * 2 * LKV * 64;
    const u16* Vg = Vt + (size_t)bh * 128 * LKV;
    __syncthreads();
    attn_issue_tile(Kg, Vg, 0, smem, wv, lane);
    bf16x8 qf[2][4];
#pragma unroll
    for (int c = 0; c < 2; ++c)
#pragma unroll
      for (int s = 0; s < 4; ++s)
        qf[c][s] = *(const bf16x8*)(Qs + (((size_t)bh * 2 + c) * 8192 + q0 + r) * 64 + s * 16 + 8 * h);
    f32x16 O[2][4];
#pragma unroll
    for (int c = 0; c < 2; ++c)
#pragma unroll
      for (int e = 0; e < 4; ++e)
#pragma unroll
        for (int i = 0; i < 16; ++i) O[c][e][i] = 0.f;
    f2 lsum[2] = {f2{0.f, 0.f}, f2{0.f, 0.f}};
#pragma unroll 1
    for (int kt = 0; kt < LKV / 64; ++kt) {
      char* buf = smem + (kt & 1) * 32768;
      asm volatile("s_waitcnt vmcnt(0)" ::: "memory");
      __syncthreads();
      if (kt + 1 < LKV / 64) attn_issue_tile(Kg, Vg, (kt + 1) * 64, smem + ((kt + 1) & 1) * 32768, wv, lane);
      const char* Kb = buf + r * 128;
      const char* Vb = buf + 16384 + r * 128;
      __builtin_amdgcn_s_setprio(1);
#pragma unroll
      for (int sub = 0; sub < 2; ++sub) {
        f32x16 sacc[2];
#pragma unroll
        for (int c = 0; c < 2; ++c) {
#pragma unroll
          for (int i = 0; i < 16; ++i) sacc[c][i] = 0.f;
#pragma unroll
          for (int s = 0; s < 4; ++s) {
            const bf16x8 kf = *(const bf16x8*)(Kb + c * 8192 + sub * 4096 + (((2 * s + h) ^ sw) << 4));
            sacc[c] = MFMA32(kf, qf[c][s], sacc[c]);
          }
        }
#pragma unroll
        for (int c = 0; c < 2; ++c) {
          bf16x8 pf[2];
#pragma unroll
          for (int s = 0; s < 2; ++s) {
            float ps[8];
#pragma unroll
            for (int i = 0; i < 8; ++i) ps[i] = __builtin_amdgcn_exp2f(sacc[c][8 * s + i]);
            lsum[c] += f2{ps[0], ps[1]}; lsum[c] += f2{ps[2], ps[3]}; lsum[c] += f2{ps[4], ps[5]}; lsum[c] += f2{ps[6], ps[7]};
            u32x4 pk = {cvtpk(ps[0], ps[1]), cvtpk(ps[2], ps[3]), cvtpk(ps[4], ps[5]), cvtpk(ps[6], ps[7])};
            pf[s] = __builtin_bit_cast(bf16x8, pk);
          }
#pragma unroll
          for (int e = 0; e < 4; ++e)
#pragma unroll
            for (int s = 0; s < 2; ++s) {
              const bf16x8 vf = *(const bf16x8*)(Vb + e * 4096 + (((sub * 4 + 2 * s + h) ^ sw) << 4));
              O[c][e] = MFMA32(vf, pf[s], O[c][e]);
            }
        }
      }
      __builtin_amdgcn_s_setprio(0);
    }
    float l0 = lsum[0][0] + lsum[0][1], l1 = lsum[1][0] + lsum[1][1];
    l0 += __shfl_xor(l0, 32); l1 += __shfl_xor(l1, 32);
    const float i0 = 1.0f / l0, i1 = lam / l1;
    float ss = 0.f;
#pragma unroll
    for (int e = 0; e < 4; ++e)
#pragma unroll
      for (int i = 0; i < 16; ++i) { const float o = O[0][e][i] * i0 - O[1][e][i] * i1; O[0][e][i] = o; ss += o * o; }
    ss += __shfl_xor(ss, 32);
    const float rstd = rsqrtf(ss * (1.0f / 128.0f) + 1e-5f) * one_m_li;
    const int b = bh >> 3, hd = bh & 7;
    int rl = r; asm volatile("" : "+v"(rl));
    const size_t row = (size_t)b * 8192 + q0 + rl;
#pragma unroll
    for (int e = 0; e < 4; ++e) {
#pragma unroll
      for (int g = 0; g < 4; ++g) {
        const int ee = e * 32 + 8 * g + 4 * h;
        const u32x2 gg = *(const u32x2*)(GB + row * 1024 + hd * 128 + ee);
        const float g0 = bflo(gg[0]), g1 = bfhi(gg[0]), g2 = bflo(gg[1]), g3 = bfhi(gg[1]);
        const f32x4 sl = *(const f32x4*)(p.da_subln + ee);
        const float y0 = O[0][e][4 * g] * rstd * sl[0] * g0;
        const float y1 = O[0][e][4 * g + 1] * rstd * sl[1] * g1;
        const float y2 = O[0][e][4 * g + 2] * rstd * sl[2] * g2;
        const float y3 = O[0][e][4 * g + 3] * rstd * sl[3] * g3;
        *(u32x2*)(Y2 + row * 1024 + hd * 128 + ee) = u32x2{cvtpk(y0, y1), cvtpk(y2, y3)};
      }
      asm volatile("" ::: "memory");
    }
  }
}

#define XB_TMO      128
#define XB_XCNT(j)  (256  + 64 * (j))
#define XB_XSUB(j)  (1280 + 64 * (j))
#define XB_XGEN(j)  (2304 + 64 * (j))
#define XB_TOP      3328
#define XB_TOPGEN   3392
#define XCD_BAR_WORDS 3456
#define XB_SPIN_CAP (1u << 18)
#define LAS __attribute__((address_space(3)))

__device__ __forceinline__ unsigned xb_ld(unsigned* p)              { return __hip_atomic_load(p, __ATOMIC_RELAXED, __HIP_MEMORY_SCOPE_AGENT); }
__device__ __forceinline__ unsigned xb_add(unsigned* p, unsigned v) { return __hip_atomic_fetch_add(p, v, __ATOMIC_RELAXED, __HIP_MEMORY_SCOPE_AGENT); }
__device__ __forceinline__ unsigned xb_xcc_id() { return (unsigned)__builtin_amdgcn_s_getreg((3 << 11) | 20) & 0xFu; }
#define XB_SPIN(cond, bar) do { unsigned _sp = 0; while (cond) { __builtin_amdgcn_s_sleep(1); \
    if ((++_sp & 255u) == 0u) { if (xb_ld(&(bar)[XB_TMO])) break; if (_sp > XB_SPIN_CAP) { atomicAdd(&(bar)[XB_TMO], 1u); break; } } } } while (0)

struct XcdBarrier {
    unsigned* bar; unsigned x;
    volatile LAS unsigned* st;
};

__device__ __forceinline__ XcdBarrier xcd_barrier_post(unsigned* bar, volatile LAS unsigned* st) {
    XcdBarrier b; b.bar = bar; b.x = xb_xcc_id(); b.st = st;
    if (threadIdx.x == 0) (void)xb_add(&bar[XB_XCNT(b.x)], 1u);
    return b;
}
__device__ __forceinline__ void xcd_barrier_complete(unsigned* bar, unsigned x, unsigned& nloc, unsigned& nx) {
    const unsigned G = gridDim.x * gridDim.y * gridDim.z;
    unsigned sum, cnt, mine, sp = 0u;
    for (;;) {
        sum = 0u; cnt = 0u; mine = 0u;
#pragma unroll
        for (unsigned j = 0; j < 16; ++j) { const unsigned c = xb_ld(&bar[XB_XCNT(j)]); sum += c; cnt += (c > 0u) ? 1u : 0u; mine = (j == x) ? c : mine; }
        if (sum == G) break;
        __builtin_amdgcn_s_sleep(1);
        if ((++sp & 255u) == 0u) { if (xb_ld(&bar[XB_TMO])) break; if (sp > XB_SPIN_CAP) { atomicAdd(&bar[XB_TMO], 1u); break; } }
    }
    nloc = mine > 0u ? mine : 1u; nx = cnt > 0u ? cnt : 1u;
}

__device__ __forceinline__ void xcd_barrier(const XcdBarrier& b) {
    asm volatile("s_waitcnt vmcnt(0)" ::: "memory");
    __syncthreads();
    if (threadIdx.x == 0) {
        unsigned* bar = b.bar;
        __builtin_amdgcn_s_waitcnt(0);
        unsigned nloc = b.st[0], nx = b.st[1];
        if (nloc == 0u) { xcd_barrier_complete(bar, b.x, nloc, nx); b.st[0] = nloc; b.st[1] = nx; }
        const unsigned old = xb_add(&bar[XB_XSUB(b.x)], 1u);
        const unsigned gen = old / nloc;
        if (old + 1u == (gen + 1u) * nloc) {
            __builtin_amdgcn_fence(__ATOMIC_RELEASE, "agent");
            asm volatile("s_waitcnt vmcnt(0)" ::: "memory");
            const unsigned og = xb_add(&bar[XB_TOP], 1u);
            const unsigned tg = og / nx;
            if (og + 1u == (tg + 1u) * nx) xb_add(&bar[XB_TOPGEN], 1u);
            else XB_SPIN(xb_ld(&bar[XB_TOPGEN]) == tg, bar);
            __builtin_amdgcn_fence(__ATOMIC_ACQUIRE, "agent");
            xb_add(&bar[XB_XGEN(b.x)], 1u);
            asm volatile("s_waitcnt vmcnt(0)" ::: "memory");
        } else {
            XB_SPIN(xb_ld(&bar[XB_XGEN(b.x)]) == gen, bar);
            __builtin_amdgcn_fence(__ATOMIC_ACQUIRE, "agent");
            asm volatile("s_waitcnt vmcnt(0)" ::: "memory");
        }
    }
    __syncthreads();
}


__global__ void __launch_bounds__(256, 2) fwd_megakernel(Params p) {
  extern __shared__ __attribute__((aligned(16))) char smem[];
  __shared__ uint4 xb_words;
  cg::grid_group grid = cg::this_grid();
  if (threadIdx.x == 0) xb_words = make_uint4(0u, 0u, 0u, 0u);
  __syncthreads();
  XcdBarrier xb = xcd_barrier_post((unsigned*)(p.ws + OFF_BAR), (volatile LAS unsigned*)&xb_words);
  phase_prep(p, smem);
  if (p.ws == nullptr) grid.sync();
  xcd_barrier(xb);
  phase_normmod(p, 0, p.x, p.ctx, true);
  xcd_barrier(xb);
  phase_gemm_wide16<0>(p, smem, (const u16*)(p.ws + OFF_HB), (const u16*)(p.ws + OFF_WT_IN0), 120, N0 / 256);
  phase_gemm<0>(p, smem, (const u16*)(p.ws + OFF_HB), (const u16*)(p.ws + OFF_WT_IN0), T_ALL / 128 - 120, N0 / 128, 120);
  xcd_barrier(xb);
  phase_scan<1>(p, smem);
  xcd_barrier(xb);
  phase_carry(p, smem);
  xcd_barrier(xb);
  phase_scan<2>(p, smem);
  xcd_barrier(xb);
  phase_readout(p);
  xcd_barrier(xb);
  phase_gemm_wide16<1>(p, smem, (const u16*)(p.ws + OFF_HB), (const u16*)(p.ws + OFF_WT_OUT0), 128, 4);
  phase_gemm<1>(p, smem, (const u16*)(p.ws + OFF_HB), (const u16*)(p.ws + OFF_WT_OUT0), T_ALL / 128 - 128, 8, 128);
  xcd_barrier(xb);
  phase_normmod(p, 1, p.out, (const float*)(p.ws + OFF_XC1), false);
  xcd_barrier(xb);
  phase_gemm_wide16<2>(p, smem, (const u16*)(p.ws + OFF_HB), (const u16*)(p.ws + OFF_WT_IN1), 128, N1 / 256);
  phase_gemm<2>(p, smem, (const u16*)(p.ws + OFF_HB), (const u16*)(p.ws + OFF_WT_IN1), T_ALL / 128 - 128, N1 / 128, 128);
  xcd_barrier(xb);
  phase_qkprep(p);
  xcd_barrier(xb);
  phase_attn(p, smem);
  xcd_barrier(xb);
  phase_gemm_wide16<3>(p, smem, (const u16*)(p.ws + OFF_Y2), (const u16*)(p.ws + OFF_WT_OUT1), T_LAT / 128, 4);
}

extern "C" void kernel_launch(void* const* d_in, const int* in_sizes, int n_in, void* d_out, int out_size, void* d_ws,
                              size_t ws_size, hipStream_t stream) {
  static int grid_blocks = 0;
  if (!grid_blocks) {
    int dev = 0, cus = 0, per_cu = 0;
    hipGetDevice(&dev);
    hipDeviceGetAttribute(&cus, hipDeviceAttributeMultiprocessorCount, dev);
    hipFuncSetAttribute((const void*)fwd_megakernel, hipFuncAttributeMaxDynamicSharedMemorySize, LDS_BYTES);
    hipOccupancyMaxActiveBlocksPerMultiprocessor(&per_cu, fwd_megakernel, 256, LDS_BYTES);
    if (per_cu < 1) per_cu = 1;
    if (per_cu > 2) per_cu = 2;
    grid_blocks = cus * per_cu;
    if (ws_size < 256 * MiB) fprintf(stderr, "kernel_launch: workspace too small: %zu\n", ws_size);
  }
  Params p{};
  const float** pp = (const float**)&p;
  for (int i = 0; i < 25; ++i) pp[i] = (const float*)d_in[i];
  p.out = (float*)d_out;
  p.ws = (char*)d_ws;
  hipMemsetAsync((char*)d_ws + OFF_BAR, 0, XCD_BAR_WORDS * sizeof(unsigned), stream);
  void* args[] = {&p};
  hipError_t e = hipLaunchCooperativeKernel((void*)fwd_megakernel, dim3(grid_blocks), dim3(256), args, LDS_BYTES, stream);
  if (e != hipSuccess) fprintf(stderr, "cooperative launch failed: %s (grid %d)\n", hipGetErrorString(e), grid_blocks);
}
```

```cpp
#include <hip/hip_runtime.h>
#include <hip/hip_cooperative_groups.h>
#include <cstdio>
namespace cg = cooperative_groups;

#define DI __device__ __forceinline__
typedef unsigned short u16;
using bf16x8 = __attribute__((ext_vector_type(8))) short;
using s16x4  = __attribute__((ext_vector_type(4))) short;
using f32x16 = __attribute__((ext_vector_type(16))) float;
using f32x4  = __attribute__((ext_vector_type(4))) float;
using f32x32 = __attribute__((ext_vector_type(32))) float;
using f2     = __attribute__((ext_vector_type(2))) float;
using u32x4  = __attribute__((ext_vector_type(4))) unsigned;
using u32x2  = __attribute__((ext_vector_type(2))) unsigned;

constexpr int T_LAT = 16384, T_CTX = 512, T_ALL = 16896, DM = 1024;
constexpr int N0 = 4352, N1 = 4096;
constexpr int LKV = 8448;
constexpr int NCHUNK = 32, LCH = 264, NSUB = 33;

constexpr size_t MiB = 1048576;
constexpr size_t OFF_WT_IN0 = 0;
constexpr size_t OFF_WT_OUT0 = 8912896;
constexpr size_t OFF_WT_IN1 = 11010048;
constexpr size_t OFF_WT_OUT1 = 19398656;
constexpr size_t OFF_W2T = 21495808;
constexpr size_t OFF_A2T = 21757952;
constexpr size_t OFF_MOD = 21 * MiB;
constexpr size_t OFF_ROPE = OFF_MOD + 73728;
constexpr size_t OFF_BONUS = 21 * MiB + 131072;
constexpr size_t OFF_XC1 = 24 * MiB;
constexpr size_t OFF_OCTX = 26 * MiB;
constexpr size_t OFF_BAR = 29 * MiB;
constexpr size_t OFF_PROJ = 30 * MiB;
constexpr size_t OFF_HB = 171 * MiB;
constexpr size_t OFF_STP = 171 * MiB;
constexpr size_t OFF_STS = 203 * MiB;
constexpr size_t OFF_RAW = 30 * MiB;
constexpr size_t OFF_VT = 96 * MiB;
constexpr size_t OFF_KS = 129 * MiB;
constexpr size_t OFF_GB = 204 * MiB;
constexpr size_t OFF_QS = OFF_HB;
constexpr size_t OFF_Y2 = OFF_RAW;

constexpr int LDS_BYTES = 78336;

struct Params {
  const float *x, *c, *ctx, *c_ctx, *ada_w, *ada_b, *norm_g, *rw_in, *rw_mu, *rw_w0, *rw_w2, *rw_a0, *rw_a2,
      *rw_kk, *rw_ka, *rw_rk, *rw_gn_g, *rw_gn_b, *rw_out, *da_in, *da_qn, *da_kn, *da_lam, *da_subln, *da_out;
  float* out;
  char* ws;
};

DI u16 f2bf(float x) { unsigned u = __float_as_uint(x); u += 0x7fffu + ((u >> 16) & 1u); return (u16)(u >> 16); }
DI float bf2f(u16 h) { return __uint_as_float(((unsigned)h) << 16); }
DI unsigned pack2(float a, float b) { return (unsigned)f2bf(a) | ((unsigned)f2bf(b) << 16); }
typedef __bf16 bf16v2 __attribute__((ext_vector_type(2)));
DI unsigned cvtpk(float a, float b) { f2 v = {a, b}; return __builtin_bit_cast(unsigned, __builtin_convertvector(v, bf16v2)); }
DI float fsig(float x) { return __builtin_amdgcn_rcpf(1.0f + __expf(-x)); }
DI int ltid() { int t = threadIdx.x; asm volatile("" : "+v"(t)); return t; }
DI float bflo(unsigned u) { return __uint_as_float(u << 16); }
DI float bfhi(unsigned u) { return __uint_as_float(u & 0xffff0000u); }
DI float sigmoidf_(float x) { return 1.0f / (1.0f + __expf(-x)); }
DI float siluf_(float x) { return x * sigmoidf_(x); }
DI int crow(int i, int h) { return (i & 3) + 8 * (i >> 2) + 4 * h; }
DI void unpack8(const u32x4& u, float* f) {
  f[0] = bflo(u[0]); f[1] = bfhi(u[0]); f[2] = bflo(u[1]); f[3] = bfhi(u[1]);
  f[4] = bflo(u[2]); f[5] = bfhi(u[2]); f[6] = bflo(u[3]); f[7] = bfhi(u[3]);
}
#define WAVE_LDS_SYNC() asm volatile("s_waitcnt lgkmcnt(0)" ::: "memory")
#define MFMA32(a, b, c) __builtin_amdgcn_mfma_f32_32x32x16_bf16((a), (b), (c), 0, 0, 0)
#define MFMA16(a, b, c) __builtin_amdgcn_mfma_f32_16x16x32_bf16((a), (b), (c), 0, 0, 0)

__device__ const float INV_FREQ[16] = {
    1.0f, 0.5623413251903491f, 0.31622776601683794f, 0.1778279410038923f, 0.1f, 0.05623413251903491f,
    0.03162277660168379f, 0.01778279410038923f, 0.01f, 0.005623413251903491f, 0.0031622776601683794f,
    0.001778279410038923f, 0.001f, 0.0005623413251903491f, 0.00031622776601683794f, 0.0001778279410038923f};

DI void transpose_tile(const float* __restrict__ src, u16* __restrict__ dst, int K, int N, int kt, int nt, float* tile) {
  const int TIDX = ltid();
  const int tid = TIDX;
  {
    const int n = tid & 63, k0 = tid >> 6;
#pragma unroll
    for (int i = 0; i < 16; ++i) {
      const int k = k0 + 4 * i;
      tile[k * 65 + n] = src[(size_t)(kt * 64 + k) * N + nt * 64 + n];
    }
  }
  __syncthreads();
  {
    const int n = tid >> 2, kq = tid & 3;
    unsigned pk[8];
#pragma unroll
    for (int j = 0; j < 8; ++j) pk[j] = pack2(tile[(kq * 16 + 2 * j) * 65 + n], tile[(kq * 16 + 2 * j + 1) * 65 + n]);
    u32x4* d = (u32x4*)(dst + (size_t)(nt * 64 + n) * K + kt * 64 + kq * 16);
    d[0] = u32x4{pk[0], pk[1], pk[2], pk[3]};
    d[1] = u32x4{pk[4], pk[5], pk[6], pk[7]};
  }
  __syncthreads();
}

DI void phase_prep(const Params& p, char* smem) {
  const int TIDX = ltid();
  float* tile = (float*)smem;
  const int tid = TIDX;
  constexpr int T_IN0 = 16 * 68, T_OUT = 256, T_IN1 = 16 * 64, T_LORA = 16;
  constexpr int E0 = T_IN0, E1 = E0 + T_OUT, E2 = E1 + T_IN1, E3 = E2 + T_OUT, E4 = E3 + 2 * T_LORA, E5 = E4 + 2 * T_LORA;
  constexpr int NMOD = 192;
  constexpr int TOTAL = E5 + NMOD + 1;
  for (int it = blockIdx.x; it < TOTAL; it += gridDim.x) {
    if (it < E0) { transpose_tile(p.rw_in, (u16*)(p.ws + OFF_WT_IN0), 1024, N0, it / 68, it % 68, tile); }
    else if (it < E1) { int j = it - E0; transpose_tile(p.rw_out, (u16*)(p.ws + OFF_WT_OUT0), 1024, 1024, j >> 4, j & 15, tile); }
    else if (it < E3) {   }
    else if (it < E4) { int j = it - E3; int d = j >> 4; transpose_tile(p.rw_w2 + (size_t)d * 65536, (u16*)(p.ws + OFF_W2T) + (size_t)d * 65536, 64, 1024, 0, j & 15, tile); }
    else if (it < E5) { int j = it - E4; int d = j >> 4; transpose_tile(p.rw_a2 + (size_t)d * 65536, (u16*)(p.ws + OFF_A2T) + (size_t)d * 65536, 64, 1024, 0, j & 15, tile); }
    else if (it < E5 + NMOD) {
      const int j = it - E5; const int layer = j / 96; const int nb = (j % 96) * 32;
      const int n = nb + (tid & 31), kg = tid >> 5;
      const float* W = p.ada_w + (size_t)layer * 1024 * 3072;
      float a0 = 0.f, a1 = 0.f, a2 = 0.f;
#pragma unroll 8
      for (int k = kg * 128; k < kg * 128 + 128; ++k) {
        const float w = W[(size_t)k * 3072 + n];
        a0 += siluf_(p.c[k]) * w; a1 += siluf_(p.c[1024 + k]) * w; a2 += siluf_(p.c_ctx[k]) * w;
      }
      tile[(kg * 3 + 0) * 32 + (tid & 31)] = a0; tile[(kg * 3 + 1) * 32 + (tid & 31)] = a1; tile[(kg * 3 + 2) * 32 + (tid & 31)] = a2;
      __syncthreads();
      if (tid < 96) {
        const int s = tid >> 5, nn = tid & 31;
        float acc = p.ada_b[layer * 3072 + nb + nn];
#pragma unroll
        for (int g = 0; g < 8; ++g) acc += tile[(g * 3 + s) * 32 + nn];
        ((float*)(p.ws + OFF_MOD))[(layer * 3 + s) * 3072 + nb + nn] = acc;
      }
      __syncthreads();
    } else {
      float* rope = (float*)(p.ws + OFF_ROPE);
      for (int e = tid; e < 2048; e += 256) {
        const int pos = e >> 4, f = e & 15;
        const float ang = (float)pos * INV_FREQ[f];
        const float rev = ang * 0.15915494309189535f;
        const float fr = rev - rintf(rev);
        const float a = fr * 6.283185307179586f;
        rope[e] = __cosf(a); rope[2048 + e] = __sinf(a);
      }
    }
  }
}

DI void phase_normmod(const Params& p, int layer, const float* __restrict__ xl, const float* __restrict__ xc, bool zero_o) {
  const int TIDX = ltid();
  const int lane = TIDX & 63, wv = __builtin_amdgcn_readfirstlane(TIDX >> 6);
  const float* mod = (const float*)(p.ws + OFF_MOD) + layer * 3 * 3072;
  const float* g = p.norm_g + layer * 1024;
  u16* hb = (u16*)(p.ws + OFF_HB);
  for (int row = blockIdx.x * 4 + wv; row < T_ALL; row += gridDim.x * 4) {
    const float* src; const float* m;
    if (row < T_LAT) { src = xl + (size_t)row * 1024; m = mod + (row >> 13) * 3072; }
    else { src = xc + (size_t)(row - T_LAT) * 1024; m = mod + 2 * 3072; }
    float v[16];
    float ss = 0.f;
#pragma unroll
    for (int q = 0; q < 4; ++q) {
      const f32x4 t = *(const f32x4*)(src + lane * 16 + q * 4);
      v[q * 4] = t[0]; v[q * 4 + 1] = t[1]; v[q * 4 + 2] = t[2]; v[q * 4 + 3] = t[3];
      ss += t[0] * t[0] + t[1] * t[1] + t[2] * t[2] + t[3] * t[3];
    }
#pragma unroll
    for (int o = 32; o >= 1; o >>= 1) ss += __shfl_xor(ss, o);
    const float rstd = rsqrtf(ss * (1.0f / 1024.0f) + 1e-6f);
    unsigned pk[8];
#pragma unroll
    for (int j = 0; j < 8; ++j) {
      const int c0 = lane * 16 + 2 * j;
      const float h0 = v[2 * j] * rstd * g[c0] * (1.0f + m[1024 + c0]) + m[c0];
      const float h1 = v[2 * j + 1] * rstd * g[c0 + 1] * (1.0f + m[1024 + c0 + 1]) + m[c0 + 1];
      pk[j] = pack2(h0, h1);
    }
    u32x4* d = (u32x4*)(hb + (size_t)row * 1024 + lane * 16);
    d[0] = u32x4{pk[0], pk[1], pk[2], pk[3]};
    d[1] = u32x4{pk[4], pk[5], pk[6], pk[7]};
    if (zero_o) {
      float* o = (row < T_LAT) ? (p.out + (size_t)row * 1024) : ((float*)(p.ws + OFF_OCTX) + (size_t)(row - T_LAT) * 1024);
      const f32x4 z = {0.f, 0.f, 0.f, 0.f};
#pragma unroll
      for (int q = 0; q < 4; ++q) *(f32x4*)(o + lane * 16 + q * 4) = z;
    }
  }
}

constexpr int LDT = 72;
#ifndef REP_GEMM
#define REP_GEMM 1
#endif
#ifndef REP_SCAN
#define REP_SCAN 1
#endif
#ifndef REP_ATTN
#define REP_ATTN 1
#endif
template <int EPI>
DI void phase_gemm(const Params& p, char* smem, const u16* __restrict__ A, const u16* __restrict__ Bt, int Mtiles, int Ntiles, int Mbase = 0) {
  const int TIDX = ltid();
  u16* As0 = (u16*)smem;
  const int tid = TIDX, lane = tid & 63, wv = __builtin_amdgcn_readfirstlane(tid >> 6);
  const int r = lane & 31, h = lane >> 5;
  const int wm = wv >> 1, wn = wv & 1;
  const int ntiles = Mtiles * Ntiles;
  const int npad = (ntiles + 511) & ~511;
  int repg = (EPI == 0 || EPI == 2) ? REP_GEMM : 1; asm volatile("" : "+s"(repg));
  for (int rp = 0; rp < repg; ++rp)
  for (int tt = blockIdx.x; tt < npad; tt += gridDim.x) {
    const int tile = (tt & ~511) + ((tt & 7) << 6) + ((tt >> 3) & 63);
    if (tile >= ntiles) continue;
    const int band = tile / (4 * Ntiles), rem = tile % (4 * Ntiles);
    const int mt_ = band * 4 + (rem & 3), nt_ = rem >> 2;
    const int m0 = (Mbase + mt_) * 128, n0 = nt_ * 128;
    f32x16 acc[2][2];
#pragma unroll
    for (int a = 0; a < 2; ++a)
#pragma unroll
      for (int b = 0; b < 2; ++b)
#pragma unroll
        for (int i = 0; i < 16; ++i) acc[a][b][i] = 0.f;
    u32x4 ra[4], rb[4];
    const u16* Ag = A + (size_t)m0 * 1024;
    const u16* Bg = Bt + (size_t)n0 * 1024;
#pragma unroll
    for (int i = 0; i < 4; ++i) {
      const int id = tid + 256 * i; const int row = id >> 3, cc = id & 7;
      ra[i] = *(const u32x4*)(Ag + (size_t)row * 1024 + cc * 8);
      rb[i] = *(const u32x4*)(Bg + (size_t)row * 1024 + cc * 8);
    }
    __syncthreads();
    for (int kt = 0; kt < 16; ++kt) {
      u16* As = As0 + (kt & 1) * (256 * LDT);
      u16* Bs = As + 128 * LDT;
#pragma unroll
      for (int i = 0; i < 4; ++i) {
        const int id = tid + 256 * i; const int row = id >> 3, cc = id & 7;
        *(u32x4*)(As + row * LDT + cc * 8) = ra[i];
        *(u32x4*)(Bs + row * LDT + cc * 8) = rb[i];
      }
      __syncthreads();
      if (kt + 1 < 16) {
#pragma unroll
        for (int i = 0; i < 4; ++i) {
          const int id = tid + 256 * i; const int row = id >> 3, cc = id & 7;
          ra[i] = *(const u32x4*)(Ag + (size_t)row * 1024 + (kt + 1) * 64 + cc * 8);
          rb[i] = *(const u32x4*)(Bg + (size_t)row * 1024 + (kt + 1) * 64 + cc * 8);
        }
      }
#pragma unroll
      for (int ks = 0; ks < 4; ++ks) {
        bf16x8 fa[2], fb[2];
#pragma unroll
        for (int t = 0; t < 2; ++t) {
          fa[t] = *(const bf16x8*)(As + (wm * 64 + t * 32 + r) * LDT + ks * 16 + 8 * h);
          fb[t] = *(const bf16x8*)(Bs + (wn * 64 + t * 32 + r) * LDT + ks * 16 + 8 * h);
        }
#pragma unroll
        for (int a = 0; a < 2; ++a)
#pragma unroll
          for (int b = 0; b < 2; ++b) acc[a][b] = MFMA32(fa[a], fb[b], acc[a][b]);
      }
    }
#pragma unroll
    for (int a = 0; a < 2; ++a)
#pragma unroll
      for (int b = 0; b < 2; ++b) {
        const int col = n0 + wn * 64 + b * 32 + r;
        const int rbase = m0 + wm * 64 + a * 32;
        if (EPI == 0) {
          u16* C = (u16*)(p.ws + OFF_PROJ);
#pragma unroll
          for (int i = 0; i < 16; ++i) C[(size_t)(rbase + crow(i, h)) * N0 + col] = f2bf(acc[a][b][i]);
        } else if (EPI == 1) {
          const float* mod = (const float*)(p.ws + OFF_MOD);
#pragma unroll
          for (int i = 0; i < 16; ++i) {
            const int row = rbase + crow(i, h);
            if (row < T_LAT) {
              const float gate = mod[(row >> 13) * 3072 + 2048 + col];
              p.out[(size_t)row * 1024 + col] = p.x[(size_t)row * 1024 + col] + gate * acc[a][b][i];
            } else {
              const int rc = row - T_LAT;
              const float gate = mod[2 * 3072 + 2048 + col];
              ((float*)(p.ws + OFF_XC1))[(size_t)rc * 1024 + col] = p.ctx[(size_t)rc * 1024 + col] + gate * acc[a][b][i];
            }
          }
        } else if (EPI == 2) {
          if (n0 < 2048) {
            u16* C = (u16*)(p.ws + OFF_RAW);
#pragma unroll
            for (int i = 0; i < 16; ++i) C[(size_t)(rbase + crow(i, h)) * 2048 + col] = f2bf(acc[a][b][i]);
          } else if (n0 < 3072) {
            u16* Vt = (u16*)(p.ws + OFF_VT);
            const int e = col - 2048;
#pragma unroll
            for (int g = 0; g < 4; ++g) {
              const int row = rbase + 8 * g + 4 * h;
              int bb, pp;
              if (row < T_LAT) { bb = row >> 13; pp = 256 + (row & 8191); } else { bb = (row - T_LAT) >> 8; pp = (row - T_LAT) & 255; }
              u32x2 v = {cvtpk(acc[a][b][4 * g], acc[a][b][4 * g + 1]), cvtpk(acc[a][b][4 * g + 2], acc[a][b][4 * g + 3])};
              const int q4 = (pp >> 2) & 3;
              const int pq = (pp & ~15) | ((((q4 & 1) << 1) | (q4 >> 1)) << 2);
              *(u32x2*)(Vt + ((size_t)bb * 1024 + e) * LKV + pq) = v;
            }
          } else {
            u16* G = (u16*)(p.ws + OFF_GB);
#pragma unroll
            for (int i = 0; i < 16; ++i) {
              const int row = rbase + crow(i, h);
              if (row < T_LAT) G[(size_t)row * 1024 + col - 3072] = f2bf(siluf_(acc[a][b][i]));
            }
          }
        } else {
          const float* mod = (const float*)(p.ws + OFF_MOD) + 3 * 3072;
#pragma unroll
          for (int i = 0; i < 16; ++i) {
            const int row = rbase + crow(i, h);
            const float gate = mod[(row >> 13) * 3072 + 2048 + col];
            float* o = p.out + (size_t)row * 1024 + col;
            *o = *o + gate * acc[a][b][i];
          }
        }
      }
  }
}

template <int EPI>
DI void phase_gemm_wide(const Params& p, char* smem, const u16* __restrict__ A, const u16* __restrict__ Bt, int Mtiles, int Ntiles, int Mbase = 0) {
  const int TIDX = ltid();
  u16* As = (u16*)smem;
  u16* Bs = As + 128 * LDT;
  const int tid = TIDX, lane = tid & 63, wv = __builtin_amdgcn_readfirstlane(tid >> 6);
  const int r = lane & 31, h = lane >> 5;
  const int wm = wv >> 1, wn = wv & 1;
  const int ntiles = Mtiles * Ntiles;
  const int npad = (ntiles + 511) & ~511;
  int repg = (EPI == 0 || EPI == 2) ? REP_GEMM : 1; asm volatile("" : "+s"(repg));
  for (int rp = 0; rp < repg; ++rp)
  for (int tt = blockIdx.x; tt < npad; tt += gridDim.x) {
    const int tile = (tt & ~511) + ((tt & 7) << 6) + ((tt >> 3) & 63);
    if (tile >= ntiles) continue;
    const int band = tile / (4 * Ntiles), rem = tile % (4 * Ntiles);
    const int mt_ = band * 4 + (rem & 3), nt_ = rem >> 2;
    const int m0 = (Mbase + mt_) * 128, n0 = nt_ * 256;
    f32x16 acc[2][4];
#pragma unroll
    for (int a = 0; a < 2; ++a)
#pragma unroll
      for (int b = 0; b < 4; ++b)
#pragma unroll
        for (int i = 0; i < 16; ++i) acc[a][b][i] = 0.f;
    u32x4 ra[4], rb[8];
    const u16* Ag = A + (size_t)m0 * 1024;
    const u16* Bg = Bt + (size_t)n0 * 1024;
#pragma unroll
    for (int i = 0; i < 8; ++i) {
      const int id = tid + 256 * i; const int row = id >> 3, cc = id & 7;
      if (i < 4) ra[i] = *(const u32x4*)(Ag + (size_t)row * 1024 + cc * 8);
      rb[i] = *(const u32x4*)(Bg + (size_t)row * 1024 + cc * 8);
    }
    for (int kt = 0; kt < 16; ++kt) {
      __syncthreads();
      int ts = tid; asm volatile("" : "+v"(ts));
#pragma unroll
      for (int i = 0; i < 8; ++i) {
        const int id = ts + 256 * i; const int row = id >> 3, cc = id & 7;
        if (i < 4) *(u32x4*)(As + row * LDT + cc * 8) = ra[i];
        *(u32x4*)(Bs + row * LDT + cc * 8) = rb[i];
      }
      __syncthreads();
      if (kt + 1 < 16) {
        int tl = tid; asm volatile("" : "+v"(tl));
#pragma unroll
        for (int i = 0; i < 8; ++i) {
          const int id = tl + 256 * i; const int row = id >> 3, cc = id & 7;
          if (i < 4) ra[i] = *(const u32x4*)(Ag + (size_t)row * 1024 + (kt + 1) * 64 + cc * 8);
          rb[i] = *(const u32x4*)(Bg + (size_t)row * 1024 + (kt + 1) * 64 + cc * 8);
        }
      }
#pragma unroll
      for (int ks = 0; ks < 4; ++ks) {
        bf16x8 fa[2], fb[4];
#pragma unroll
        for (int t = 0; t < 2; ++t) fa[t] = *(const bf16x8*)(As + (wm * 64 + t * 32 + r) * LDT + ks * 16 + 8 * h);
#pragma unroll
        for (int t = 0; t < 4; ++t) fb[t] = *(const bf16x8*)(Bs + (wn * 128 + t * 32 + r) * LDT + ks * 16 + 8 * h);
#pragma unroll
        for (int a = 0; a < 2; ++a)
#pragma unroll
          for (int b = 0; b < 4; ++b) acc[a][b] = MFMA32(fa[a], fb[b], acc[a][b]);
      }
    }
#pragma unroll
    for (int a = 0; a < 2; ++a)
#pragma unroll
      for (int b = 0; b < 4; ++b) {
        const int col = n0 + wn * 128 + b * 32 + r;
        const int rbase = m0 + wm * 64 + a * 32;
        if (EPI == 0) {
          u16* C = (u16*)(p.ws + OFF_PROJ);
#pragma unroll
          for (int i = 0; i < 16; ++i) C[(size_t)(rbase + crow(i, h)) * N0 + col] = f2bf(acc[a][b][i]);
        } else if (EPI == 1) {
          const float* mod = (const float*)(p.ws + OFF_MOD);
#pragma unroll
          for (int i = 0; i < 16; ++i) {
            const int row = rbase + crow(i, h);
            if (row < T_LAT) {
              const float gate = mod[(row >> 13) * 3072 + 2048 + col];
              p.out[(size_t)row * 1024 + col] = p.x[(size_t)row * 1024 + col] + gate * acc[a][b][i];
            } else {
              const int rc = row - T_LAT;
              const float gate = mod[2 * 3072 + 2048 + col];
              ((float*)(p.ws + OFF_XC1))[(size_t)rc * 1024 + col] = p.ctx[(size_t)rc * 1024 + col] + gate * acc[a][b][i];
            }
          }
        } else if (EPI == 2) {
          if (n0 < 2048) {
            u16* C = (u16*)(p.ws + OFF_RAW);
#pragma unroll
            for (int i = 0; i < 16; ++i) C[(size_t)(rbase + crow(i, h)) * 2048 + col] = f2bf(acc[a][b][i]);
          } else if (n0 < 3072) {
            u16* Vt = (u16*)(p.ws + OFF_VT);
            const int e = col - 2048;
#pragma unroll
            for (int g = 0; g < 4; ++g) {
              const int row = rbase + 8 * g + 4 * h;
              int bb, pp;
              if (row < T_LAT) { bb = row >> 13; pp = 256 + (row & 8191); } else { bb = (row - T_LAT) >> 8; pp = (row - T_LAT) & 255; }
              u32x2 v = {cvtpk(acc[a][b][4 * g], acc[a][b][4 * g + 1]), cvtpk(acc[a][b][4 * g + 2], acc[a][b][4 * g + 3])};
              const int q4 = (pp >> 2) & 3;
              const int pq = (pp & ~15) | ((((q4 & 1) << 1) | (q4 >> 1)) << 2);
              *(u32x2*)(Vt + ((size_t)bb * 1024 + e) * LKV + pq) = v;
            }
          } else {
            u16* G = (u16*)(p.ws + OFF_GB);
#pragma unroll
            for (int i = 0; i < 16; ++i) {
              const int row = rbase + crow(i, h);
              if (row < T_LAT) G[(size_t)row * 1024 + col - 3072] = f2bf(siluf_(acc[a][b][i]));
            }
          }
        } else {
          const float* mod = (const float*)(p.ws + OFF_MOD) + 3 * 3072;
#pragma unroll
          for (int i = 0; i < 16; ++i) {
            const int row = rbase + crow(i, h);
            const float gate = mod[(row >> 13) * 3072 + 2048 + col];
            float* o = p.out + (size_t)row * 1024 + col;
            *o = *o + gate * acc[a][b][i];
          }
        }
      }
  }
}

constexpr int LDW = 80;
template <int EPI>
DI void phase_gemm_wide16(const Params& p, char* smem, const u16* __restrict__ A, const u16* __restrict__ Bt, int Mtiles, int Ntiles, int Mbase = 0) {
  const int TIDX = ltid();
  u16* As = (u16*)smem;
  u16* Bs = As + 128 * LDW;
  const int tid = TIDX, lane = tid & 63, wv = __builtin_amdgcn_readfirstlane(tid >> 6);
  const int lr = lane & 15, lq = lane >> 4;
  const int wm = wv >> 1, wn = wv & 1;
  const int ntiles = Mtiles * Ntiles;
  const int npad = (ntiles + 511) & ~511;
  for (int tt = blockIdx.x; tt < npad; tt += gridDim.x) {
    const int tile = (tt & ~511) + ((tt & 7) << 6) + ((tt >> 3) & 63);
    if (tile >= ntiles) continue;
    const int band = tile / (4 * Ntiles), rem = tile % (4 * Ntiles);
    const int mt_ = band * 4 + (rem & 3), nt_ = rem >> 2;
    const int m0 = (Mbase + mt_) * 128, n0 = nt_ * 256;
    f32x4 acc[4][8];
#pragma unroll
    for (int t = 0; t < 4; ++t)
#pragma unroll
      for (int u = 0; u < 8; ++u) acc[t][u] = f32x4{0.f, 0.f, 0.f, 0.f};
    u32x4 ra[4], rb[8];
    const u16* Ag = A + (size_t)m0 * 1024;
    const u16* Bg = Bt + (size_t)n0 * 1024;
#pragma unroll
    for (int i = 0; i < 8; ++i) {
      const int id = tid + 256 * i; const int row = id >> 3, cc = id & 7;
      if (i < 4) ra[i] = *(const u32x4*)(Ag + (size_t)row * 1024 + cc * 8);
      rb[i] = *(const u32x4*)(Bg + (size_t)row * 1024 + cc * 8);
    }
    for (int kt = 0; kt < 16; ++kt) {
      __syncthreads();
      int ts = tid; asm volatile("" : "+v"(ts));
#pragma unroll
      for (int i = 0; i < 8; ++i) {
        const int id = ts + 256 * i; const int row = id >> 3, cc = id & 7;
        if (i < 4) *(u32x4*)(As + row * LDW + cc * 8) = ra[i];
        *(u32x4*)(Bs + row * LDW + cc * 8) = rb[i];
      }
      __syncthreads();
      if (kt + 1 < 16) {
        int tl = tid; asm volatile("" : "+v"(tl));
#pragma unroll
        for (int i = 0; i < 8; ++i) {
          const int id = tl + 256 * i; const int row = id >> 3, cc = id & 7;
          if (i < 4) ra[i] = *(const u32x4*)(Ag + (size_t)row * 1024 + (kt + 1) * 64 + cc * 8);
          rb[i] = *(const u32x4*)(Bg + (size_t)row * 1024 + (kt + 1) * 64 + cc * 8);
        }
      }
#pragma unroll
      for (int ks = 0; ks < 2; ++ks) {
        bf16x8 fa[4], fb[8];
#pragma unroll
        for (int t = 0; t < 4; ++t) fa[t] = *(const bf16x8*)(As + (wm * 64 + t * 16 + lr) * LDW + ks * 32 + lq * 8);
#pragma unroll
        for (int u = 0; u < 8; ++u) fb[u] = *(const bf16x8*)(Bs + (wn * 128 + u * 16 + lr) * LDW + ks * 32 + lq * 8);
#pragma unroll
        for (int t = 0; t < 4; ++t)
#pragma unroll
          for (int u = 0; u < 8; ++u) acc[t][u] = MFMA16(fa[t], fb[u], acc[t][u]);
      }
    }
#pragma unroll
    for (int t = 0; t < 4; ++t)
#pragma unroll
      for (int u = 0; u < 8; ++u) {
        const int col = n0 + wn * 128 + u * 16 + lr;
        const int row0 = m0 + wm * 64 + t * 16 + 4 * lq;
        if (EPI == 0) {
          u16* C = (u16*)(p.ws + OFF_PROJ);
#pragma unroll
          for (int g = 0; g < 4; ++g) C[(size_t)(row0 + g) * N0 + col] = f2bf(acc[t][u][g]);
        } else if (EPI == 1) {
          const float* mod = (const float*)(p.ws + OFF_MOD);
#pragma unroll
          for (int g = 0; g < 4; ++g) {
            const int row = row0 + g;
            if (row < T_LAT) {
              const float gate = mod[(row >> 13) * 3072 + 2048 + col];
              p.out[(size_t)row * 1024 + col] = p.x[(size_t)row * 1024 + col] + gate * acc[t][u][g];
            } else {
              const int rc = row - T_LAT;
              const float gate = mod[2 * 3072 + 2048 + col];
              ((float*)(p.ws + OFF_XC1))[(size_t)rc * 1024 + col] = p.ctx[(size_t)rc * 1024 + col] + gate * acc[t][u][g];
            }
          }
        } else if (EPI == 3) {
          const float* mod = (const float*)(p.ws + OFF_MOD) + 3 * 3072;
#pragma unroll
          for (int g = 0; g < 4; ++g) {
            const int row = row0 + g;
            const float gate = mod[(row >> 13) * 3072 + 2048 + col];
            float* o = p.out + (size_t)row * 1024 + col;
            *o = *o + gate * acc[t][u][g];
          }
        } else {
          if (n0 < 2048) {
            u16* C = (u16*)(p.ws + OFF_RAW);
#pragma unroll
            for (int g = 0; g < 4; ++g) C[(size_t)(row0 + g) * 2048 + col] = f2bf(acc[t][u][g]);
          } else if (n0 < 3072) {
            u16* Vt = (u16*)(p.ws + OFF_VT);
            const int e = col - 2048;
            int bb, pp;
            if (row0 < T_LAT) { bb = row0 >> 13; pp = 256 + (row0 & 8191); } else { bb = (row0 - T_LAT) >> 8; pp = (row0 - T_LAT) & 255; }
            u32x2 v = {cvtpk(acc[t][u][0], acc[t][u][1]), cvtpk(acc[t][u][2], acc[t][u][3])};
            const int q4 = (pp >> 2) & 3;
            const int pq = (pp & ~15) | ((((q4 & 1) << 1) | (q4 >> 1)) << 2);
            *(u32x2*)(Vt + ((size_t)bb * 1024 + e) * LKV + pq) = v;
          } else {
            u16* G = (u16*)(p.ws + OFF_GB);
#pragma unroll
            for (int g = 0; g < 4; ++g)
              if (row0 + g < T_LAT) G[(size_t)(row0 + g) * 1024 + col - 3072] = f2bf(siluf_(acc[t][u][g]));
          }
        }
      }
  }
}

DI void tokmap(int pos, int d, int b, int& row, bool& hp, bool& hn) {
  if (pos < 256) { const int t = d ? 255 - pos : pos; row = T_LAT + b * 256 + t; hp = t > 0; hn = t < 255; }
  else { const int q = pos - 256; const int t = d ? 8191 - q : q; row = b * 8192 + t; hp = t > 0; hn = t < 8191; }
}

DI void load_mix8(const u16* pr, bool hp, bool hn, const float* mu, float* out) {
  const u32x4 uc = *(const u32x4*)pr;
  u32x4 up = {0u, 0u, 0u, 0u}, un = {0u, 0u, 0u, 0u};
  if (hp) up = *(const u32x4*)(pr - N0);
  if (hn) un = *(const u32x4*)(pr + N0);
  float c[8], a[8], n[8];
  unpack8(uc, c); unpack8(up, a); unpack8(un, n);
  const f32x4 m0 = *(const f32x4*)mu, m1 = *(const f32x4*)(mu + 4);
#pragma unroll
  for (int j = 0; j < 8; ++j) {
    const float m = j < 4 ? m0[j & 3] : m1[j & 3];
    out[j] = c[j] + m * (0.5f * (a[j] + n[j]) - c[j]);
  }
}

DI void mixraw8(const u32x4& uc, const u32x4& up, const u32x4& un, bool hp, bool hn, const float* mu, float* out) {
  float c[8], a[8], n[8];
  unpack8(uc, c); unpack8(up, a); unpack8(un, n);
  const f32x4 m0 = *(const f32x4*)mu, m1 = *(const f32x4*)(mu + 4);
#pragma unroll
  for (int j = 0; j < 8; ++j) {
    const float m = j < 4 ? m0[j & 3] : m1[j & 3];
    const float av = hp ? a[j] : 0.f, nv = hn ? n[j] : 0.f;
    out[j] = c[j] + m * (0.5f * (av + nv) - c[j]);
  }
}

template <int PASS>
DI void phase_scan(const Params& p, char* smem) {
  const int TIDX = ltid();
  const int lane = TIDX & 63, wv = __builtin_amdgcn_readfirstlane(TIDX >> 6);
  float* sm = (float*)smem + wv * 3584;
  float* sW = sm; float* sKK = sm + 512; float* sKKA = sm + 1024; float* sKD = sm + 1536; float* sR = sm + 2048; float* sV = sm + 2560; float* sA = sm + 3072;
  const u16* proj = (const u16*)(p.ws + OFF_PROJ);
  float* stP = (float*)(p.ws + OFF_STP);
  float* stS = (float*)(p.ws + OFF_STS);
  float* bonus = (float*)(p.ws + OFF_BONUS);
  const int nwaves = gridDim.x * 4;
  int reps = (PASS == 1) ? REP_SCAN : 1; asm volatile("" : "+s"(reps));
  for (int rp = 0; rp < reps; ++rp)
  for (int item = blockIdx.x * 4 + wv; item < 2048; item += nwaves) {
    const int chain = item >> 5, chunk = item & 31;
    const int d = chain & 1, hh = (chain >> 1) & 15, b = chain >> 5;
    u16* cB = (u16*)(smem + 57344);
    float* cP = (float*)(smem + 57344 + 18432);
    __syncthreads();
    {
      const int tid = TIDX;
#pragma unroll
      for (int i = 0; i < 4; ++i) {
        const int id = tid + 256 * i;
        const int which = id >> 9, row = (id >> 3) & 63, cc = id & 7;
        const u16* src = (const u16*)(p.ws + (which ? OFF_A2T : OFF_W2T)) + ((size_t)d * 1024 + hh * 64 + row) * 64 + cc * 8;
        *(u32x4*)(cB + (which * 64 + row) * 72 + cc * 8) = *(const u32x4*)src;
      }
      if (tid < 160) {
        const int a = tid >> 4, q = (tid & 15) * 4;
        const float* src;
        switch (a) {
          case 0: src = p.rw_mu + 3072 + d * 64; break;
          case 1: src = p.rw_mu + 3072 + 128 + d * 64; break;
          case 2: src = p.rw_mu + hh * 64; break;
          case 3: src = p.rw_mu + 1024 + hh * 64; break;
          case 4: src = p.rw_mu + 2048 + hh * 64; break;
          case 5: src = p.rw_w0 + d * 1024 + hh * 64; break;
          case 6: src = p.rw_a0 + d * 1024 + hh * 64; break;
          case 7: src = p.rw_kk + hh * 64; break;
          case 8: src = p.rw_ka + hh * 64; break;
          default: src = p.rw_rk + hh * 64; break;
        }
        *(f32x4*)(cP + a * 64 + q) = *(const f32x4*)(src + q);
      }
    }
    __syncthreads();
    if (PASS == 1 && chunk == 31) continue;
    f32x16 S[2][2];
    f32x32 P[2];
    {
      int li = lane; asm volatile("" : "+v"(li));
      const int lv = li & 31, lh = li >> 5;
      if (PASS == 1) {
#pragma unroll
        for (int kt = 0; kt < 2; ++kt)
#pragma unroll
          for (int vt = 0; vt < 2; ++vt)
#pragma unroll
            for (int i = 0; i < 16; ++i) {
              S[kt][vt][i] = 0.f;
              P[vt][16 * kt + i] = (32 * kt + (i & 3) + 8 * (i >> 2) + 4 * lh == 32 * vt + lv) ? 1.f : 0.f;
            }
      } else {
        if (chunk == 0) {
#pragma unroll
          for (int kt = 0; kt < 2; ++kt)
#pragma unroll
            for (int vt = 0; vt < 2; ++vt)
#pragma unroll
              for (int i = 0; i < 16; ++i) S[kt][vt][i] = 0.f;
        } else {
          const float* src = stS + (size_t)(item - 1) * 4096;
#pragma unroll
          for (int kt = 0; kt < 2; ++kt)
#pragma unroll
            for (int vt = 0; vt < 2; ++vt)
#pragma unroll
              for (int g = 0; g < 4; ++g) {
                const f32x4 t = *(const f32x4*)(src + (32 * vt + lv) * 64 + 32 * kt + 8 * g + 4 * lh);
                S[kt][vt][4 * g] = t[0]; S[kt][vt][4 * g + 1] = t[1]; S[kt][vt][4 * g + 2] = t[2]; S[kt][vt][4 * g + 3] = t[3];
              }
        }
      }
    }
    for (int sc = 0; sc < NSUB; ++sc) {
      const int p0 = chunk * LCH + sc * 8;
      int ln = lane; asm volatile("" : "+v"(ln));
      u32x4 rawA[2][3], rawB[3][3];
      bool hpA, hnA, hpB, hnB; int rowB;
      {
        int rowA; tokmap(p0 + (ln & 7), d, b, rowA, hpA, hnA);
        const u16* prA = proj + (size_t)rowA * N0 + 4096 + d * 64 + (ln >> 4) * 8 + ((ln >> 3) & 1) * 32;
        const ptrdiff_t dpA = hpA ? -N0 : 0, dnA = hnA ? N0 : 0;
#pragma unroll
        for (int X = 0; X < 2; ++X) {
          const u16* q = prA + X * 128;
          rawA[X][0] = *(const u32x4*)q; rawA[X][1] = *(const u32x4*)(q + dpA); rawA[X][2] = *(const u32x4*)(q + dnA);
        }
        tokmap(p0 + (ln >> 3), d, b, rowB, hpB, hnB);
        const u16* prB = proj + (size_t)rowB * N0 + hh * 64 + (ln & 7) * 8;
        const ptrdiff_t dpB = hpB ? -N0 : 0, dnB = hnB ? N0 : 0;
#pragma unroll
        for (int X = (PASS == 2 ? 0 : 1); X < 3; ++X) {
          const u16* q = prB + X * 1024;
          rawB[X][0] = *(const u32x4*)q; rawB[X][1] = *(const u32x4*)(q + dpB); rawB[X][2] = *(const u32x4*)(q + dnB);
        }
      }
      {
        const int m = ln & 15, kg = ln >> 4;
        bf16x8 fa[2][2];
        const int ssel = (m >> 3) & 1;
#pragma unroll
        for (int X = 0; X < 2; ++X) {
          float mx[8];
          mixraw8(rawA[X][0], rawA[X][1], rawA[X][2], hpA, hnA, cP + X * 64 + ssel * 32 + kg * 8, mx);
          if (X == 0) {
#pragma unroll
            for (int j = 0; j < 8; ++j) { const float e = __expf(2.0f * mx[j]); mx[j] = 1.0f - 2.0f * __builtin_amdgcn_rcpf(e + 1.0f); }
          }
          u32x4 own = {cvtpk(mx[0], mx[1]), cvtpk(mx[2], mx[3]), cvtpk(mx[4], mx[5]), cvtpk(mx[6], mx[7])};
          u32x4 oth;
#pragma unroll
          for (int q = 0; q < 4; ++q) oth[q] = (unsigned)__shfl_down((int)own[q], 8);
          fa[X][0] = __builtin_bit_cast(bf16x8, own);
          fa[X][1] = __builtin_bit_cast(bf16x8, ssel ? own : oth);
        }
#pragma unroll
        for (int nt = 0; nt < 4; ++nt) {
          f32x4 aw = {0.f, 0.f, 0.f, 0.f}, aa = {0.f, 0.f, 0.f, 0.f};
#pragma unroll
          for (int s = 0; s < 2; ++s) {
            const bf16x8 bw = *(const bf16x8*)(cB + (16 * nt + m) * 72 + s * 32 + kg * 8);
            const bf16x8 ba = *(const bf16x8*)(cB + (64 + 16 * nt + m) * 72 + s * 32 + kg * 8);
            aw = MFMA16(fa[0][s], bw, aw);
            aa = MFMA16(fa[1][s], ba, aa);
          }
          const int ch = 16 * nt + m;
          const float w0 = cP[5 * 64 + ch];
          const float a0 = cP[6 * 64 + ch];
          if (kg < 2) {
#pragma unroll
            for (int rg = 0; rg < 4; ++rg) {
              sW[(4 * kg + rg) * 64 + ch] = w0 + aw[rg];
              sA[(4 * kg + rg) * 64 + ch] = a0 + aa[rg];
            }
          }
        }
      }
      WAVE_LDS_SYNC();
      __builtin_amdgcn_sched_barrier(0);
      {
        const int tk = ln >> 3, g = ln & 7;
        const int row = rowB;
        const int cb = hh * 64 + g * 8;
        float rr[8], kk[8], vv[8];
        if (PASS == 2) mixraw8(rawB[0][0], rawB[0][1], rawB[0][2], hpB, hnB, cP + 2 * 64 + g * 8, rr);
        else { for (int j = 0; j < 8; ++j) rr[j] = 0.f; }
        mixraw8(rawB[1][0], rawB[1][1], rawB[1][2], hpB, hnB, cP + 3 * 64 + g * 8, kk);
        mixraw8(rawB[2][0], rawB[2][1], rawB[2][2], hpB, hnB, cP + 4 * 64 + g * 8, vv);
        float av[8], kkn[8], kd[8], pkkv[8], pkav[8], prkv[8];
        { const f32x4 t0 = *(const f32x4*)(sA + tk * 64 + g * 8), t1 = *(const f32x4*)(sA + tk * 64 + g * 8 + 4);
          av[0] = fsig(t0[0]); av[1] = fsig(t0[1]); av[2] = fsig(t0[2]); av[3] = fsig(t0[3]); av[4] = fsig(t1[0]); av[5] = fsig(t1[1]); av[6] = fsig(t1[2]); av[7] = fsig(t1[3]); }
        { const f32x4 t0 = *(const f32x4*)(sW + tk * 64 + g * 8), t1 = *(const f32x4*)(sW + tk * 64 + g * 8 + 4);
          f32x4 o0, o1;
#pragma unroll
          for (int j = 0; j < 4; ++j) { o0[j] = __expf(-0.6065306597126334f * fsig(t0[j])); o1[j] = __expf(-0.6065306597126334f * fsig(t1[j])); }
          *(f32x4*)(sW + tk * 64 + g * 8) = o0; *(f32x4*)(sW + tk * 64 + g * 8 + 4) = o1; }
        WAVE_LDS_SYNC();
        { float Wc = 1.0f;
#pragma unroll
          for (int j = 0; j < 8; ++j) { Wc *= sW[j * 64 + ln]; sW[j * 64 + ln] = Wc; } }
        WAVE_LDS_SYNC();
        float wcur[8], wprv[8];
        { const f32x4 t0 = *(const f32x4*)(sW + tk * 64 + g * 8), t1 = *(const f32x4*)(sW + tk * 64 + g * 8 + 4);
          const int tp = tk > 0 ? tk - 1 : 0;
          const f32x4 u0 = *(const f32x4*)(sW + tp * 64 + g * 8), u1 = *(const f32x4*)(sW + tp * 64 + g * 8 + 4);
#pragma unroll
          for (int j = 0; j < 4; ++j) { wcur[j] = t0[j]; wcur[j + 4] = t1[j]; wprv[j] = tk > 0 ? u0[j] : 1.0f; wprv[j + 4] = tk > 0 ? u1[j] : 1.0f; } }
        { const float* q7 = cP + 7 * 64 + g * 8;
          const f32x4 a0 = *(const f32x4*)(q7), a1 = *(const f32x4*)(q7 + 4), b0 = *(const f32x4*)(q7 + 64), b1 = *(const f32x4*)(q7 + 68),
                      c0 = *(const f32x4*)(q7 + 128), c1 = *(const f32x4*)(q7 + 132);
#pragma unroll
          for (int j = 0; j < 4; ++j) { pkkv[j] = a0[j]; pkkv[j + 4] = a1[j]; pkav[j] = b0[j]; pkav[j + 4] = b1[j]; prkv[j] = c0[j]; prkv[j + 4] = c1[j]; } }
        float ss = 0.f, bon = 0.f;
#pragma unroll
        for (int j = 0; j < 8; ++j) {
          kkn[j] = kk[j] * pkkv[j]; ss += kkn[j] * kkn[j];
          kd[j] = kk[j] * (1.0f + (av[j] - 1.0f) * pkav[j]);
          bon += rr[j] * kd[j] * prkv[j];
        }
        ss += __shfl_xor(ss, 1); ss += __shfl_xor(ss, 2); ss += __shfl_xor(ss, 4);
        const float inv = rsqrtf(ss + 1e-12f);
        if (PASS == 2) {
          bon += __shfl_xor(bon, 1); bon += __shfl_xor(bon, 2); bon += __shfl_xor(bon, 4);
          if (g == 0) bonus[(size_t)d * (T_ALL * 16) + (size_t)row * 16 + hh] = bon;
        }
        float iw[8];
#pragma unroll
        for (int j = 0; j < 8; ++j) iw[j] = __builtin_amdgcn_rcpf(wcur[j]);
        float* o;
        o = sKK + tk * 64 + g * 8;
        *(f32x4*)o = f32x4{kkn[0] * inv * wprv[0], kkn[1] * inv * wprv[1], kkn[2] * inv * wprv[2], kkn[3] * inv * wprv[3]};
        *(f32x4*)(o + 4) = f32x4{kkn[4] * inv * wprv[4], kkn[5] * inv * wprv[5], kkn[6] * inv * wprv[6], kkn[7] * inv * wprv[7]};
        o = sKKA + tk * 64 + g * 8;
        *(f32x4*)o = f32x4{kkn[0] * inv * av[0] * iw[0], kkn[1] * inv * av[1] * iw[1], kkn[2] * inv * av[2] * iw[2], kkn[3] * inv * av[3] * iw[3]};
        *(f32x4*)(o + 4) = f32x4{kkn[4] * inv * av[4] * iw[4], kkn[5] * inv * av[5] * iw[5], kkn[6] * inv * av[6] * iw[6], kkn[7] * inv * av[7] * iw[7]};
        o = sKD + tk * 64 + g * 8;
        *(f32x4*)o = f32x4{kd[0] * iw[0], kd[1] * iw[1], kd[2] * iw[2], kd[3] * iw[3]};
        *(f32x4*)(o + 4) = f32x4{kd[4] * iw[4], kd[5] * iw[5], kd[6] * iw[6], kd[7] * iw[7]};
        if (PASS == 2) {
          o = sR + tk * 64 + g * 8;
          *(f32x4*)o = f32x4{rr[0] * wcur[0], rr[1] * wcur[1], rr[2] * wcur[2], rr[3] * wcur[3]};
          *(f32x4*)(o + 4) = f32x4{rr[4] * wcur[4], rr[5] * wcur[5], rr[6] * wcur[6], rr[7] * wcur[7]};
        }
        o = sV + tk * 64 + g * 8;
        *(f32x4*)o = f32x4{vv[0], vv[1], vv[2], vv[3]};
        *(f32x4*)(o + 4) = f32x4{vv[4], vv[5], vv[6], vv[7]};
      }
      WAVE_LDS_SYNC();
      __builtin_amdgcn_sched_barrier(0);
      float* obase = nullptr; ptrdiff_t ostep = d ? -1024 : 1024;
      if (PASS == 2) {
        int row0; bool hp0, hn0; tokmap(p0, d, b, row0, hp0, hn0);
        obase = ((row0 < T_LAT) ? (p.out + (size_t)row0 * 1024) : ((float*)(p.ws + OFF_OCTX) + (size_t)(row0 - T_LAT) * 1024)) + hh * 64 + lane;
      }
      const int lv31 = lane & 31, lh1 = lane >> 5;
      __builtin_amdgcn_s_setprio(1);
#pragma unroll 1
      for (int j = 0; j < 8; ++j) {
        f32x4 kkv[2][4];
#pragma unroll
        for (int kt = 0; kt < 2; ++kt)
#pragma unroll
          for (int g = 0; g < 4; ++g) kkv[kt][g] = *(const f32x4*)(sKK + j * 64 + 32 * kt + 8 * g + 4 * lh1);
        float aop[2], vvv[2];
        const float akka = sKKA[j * 64 + lane];
#pragma unroll
        for (int t = 0; t < 2; ++t) {
          aop[t] = (lh1 ? sKD : sKKA)[j * 64 + 32 * t + lv31];
          vvv[t] = sV[j * 64 + 32 * t + lv31];
        }
        float saS[2], saP[2];
#pragma unroll
        for (int vt = 0; vt < 2; ++vt) {
          f2 a2 = {0.f, 0.f}, b2 = {0.f, 0.f};
#pragma unroll
          for (int kt = 0; kt < 2; ++kt)
#pragma unroll
            for (int g = 0; g < 4; ++g) {
              a2 += f2{S[kt][vt][4 * g], S[kt][vt][4 * g + 1]} * f2{kkv[kt][g][0], kkv[kt][g][1]};
              a2 += f2{S[kt][vt][4 * g + 2], S[kt][vt][4 * g + 3]} * f2{kkv[kt][g][2], kkv[kt][g][3]};
              if (PASS == 1) {
                b2 += f2{P[vt][16 * kt + 4 * g], P[vt][16 * kt + 4 * g + 1]} * f2{kkv[kt][g][0], kkv[kt][g][1]};
                b2 += f2{P[vt][16 * kt + 4 * g + 2], P[vt][16 * kt + 4 * g + 3]} * f2{kkv[kt][g][2], kkv[kt][g][3]};
              }
            }
          float x = a2[0] + a2[1];
          x += __shfl_xor(x, 32);
          saS[vt] = x;
          if (PASS == 1) { float y = b2[0] + b2[1]; y += __shfl_xor(y, 32); saP[vt] = y; }
        }
#pragma unroll
        for (int vt = 0; vt < 2; ++vt) {
          const float bS = lh1 ? vvv[vt] : -saS[vt];
          if (PASS == 1) P[vt] = __builtin_amdgcn_mfma_f32_32x32x1f32(akka, -saP[vt], P[vt], 0, 0, 0);
#pragma unroll
          for (int kt = 0; kt < 2; ++kt) {
            S[kt][vt] = __builtin_amdgcn_mfma_f32_32x32x2f32(aop[kt], bS, S[kt][vt], 0, 0, 0);
          }
        }
        if (PASS == 2) {
          f32x4 rv[2][4];
#pragma unroll
          for (int kt = 0; kt < 2; ++kt)
#pragma unroll
            for (int g = 0; g < 4; ++g) rv[kt][g] = *(const f32x4*)(sR + j * 64 + 32 * kt + 8 * g + 4 * lh1);
          float ov[2];
#pragma unroll
          for (int vt = 0; vt < 2; ++vt) {
            f2 a2 = {0.f, 0.f};
#pragma unroll
            for (int kt = 0; kt < 2; ++kt)
#pragma unroll
              for (int g = 0; g < 4; ++g) {
                a2 += f2{S[kt][vt][4 * g], S[kt][vt][4 * g + 1]} * f2{rv[kt][g][0], rv[kt][g][1]};
                a2 += f2{S[kt][vt][4 * g + 2], S[kt][vt][4 * g + 3]} * f2{rv[kt][g][2], rv[kt][g][3]};
              }
            float x = a2[0] + a2[1];
            x += __shfl_xor(x, 32);
            ov[vt] = x;
          }
          atomicAdd(obase + (ptrdiff_t)j * ostep, lh1 ? ov[1] : ov[0]);
        }
      }
      __builtin_amdgcn_s_setprio(0);
      {
        f32x4 w7[2][4];
#pragma unroll
        for (int kt = 0; kt < 2; ++kt)
#pragma unroll
          for (int g = 0; g < 4; ++g) w7[kt][g] = *(const f32x4*)(sW + 7 * 64 + 32 * kt + 8 * g + 4 * lh1);
#pragma unroll
        for (int kt = 0; kt < 2; ++kt)
#pragma unroll
          for (int vt = 0; vt < 2; ++vt)
#pragma unroll
            for (int i = 0; i < 16; ++i) {
              S[kt][vt][i] *= w7[kt][i >> 2][i & 3];
              if (PASS == 1) P[vt][16 * kt + i] *= w7[kt][i >> 2][i & 3];
            }
      }
      WAVE_LDS_SYNC();
    }
    if (PASS == 1) {
      int li = lane; asm volatile("" : "+v"(li));
      const int lv = li & 31, lh = li >> 5;
      float* dP = stP + (size_t)item * 4096;
      float* dS = stS + (size_t)item * 4096;
#pragma unroll
      for (int kt = 0; kt < 2; ++kt)
#pragma unroll
        for (int vt = 0; vt < 2; ++vt)
#pragma unroll
          for (int g = 0; g < 4; ++g) {
            const int off = (32 * vt + lv) * 64 + 32 * kt + 8 * g + 4 * lh;
            *(f32x4*)(dP + off) = f32x4{P[vt][16 * kt + 4 * g], P[vt][16 * kt + 4 * g + 1], P[vt][16 * kt + 4 * g + 2], P[vt][16 * kt + 4 * g + 3]};
            *(f32x4*)(dS + off) = f32x4{S[kt][vt][4 * g], S[kt][vt][4 * g + 1], S[kt][vt][4 * g + 2], S[kt][vt][4 * g + 3]};
          }
    }
  }
}

DI void phase_carry(const Params& p, char* smem) {
  const int TIDX = ltid();
  float* cur = (float*)smem;
  const int tid = TIDX, lane = tid & 63, w = __builtin_amdgcn_readfirstlane(tid >> 6);
  const int lc = lane & 15, lq = lane >> 4;
  float* stP = (float*)(p.ws + OFF_STP);
  float* stS = (float*)(p.ws + OFF_STS);
  for (int it = blockIdx.x; it < 256; it += gridDim.x) {
    const int chain = it >> 2, rg = it & 3;
    const size_t slot0 = (size_t)chain * 32;
    __syncthreads();
    {
      const int row = tid >> 4, c4 = (tid & 15) * 4;
      const f32x4 t = *(const f32x4*)(stS + (slot0 * 64 + rg * 16 + row) * 64 + c4);
      *(f32x4*)(cur + row * 68 + c4) = t;
    }
    __syncthreads();
    float pn[16]; f32x4 an;
    {
      const float* Pm = stP + (slot0 + 1) * 4096;
#pragma unroll
      for (int s = 0; s < 16; ++s) pn[s] = Pm[(size_t)(4 * s + lq) * 64 + 16 * w + lc];
#pragma unroll
      for (int rr = 0; rr < 4; ++rr) an[rr] = stS[((slot0 + 1) * 64 + rg * 16 + 4 * lq + rr) * 64 + 16 * w + lc];
    }
    __builtin_amdgcn_s_setprio(1);
    for (int c = 1; c < 31; ++c) {
      const size_t slot = slot0 + c;
      float pj[16]; f32x4 acc = an;
#pragma unroll
      for (int s = 0; s < 16; ++s) pj[s] = pn[s];
      if (c + 1 < 31) {
        const float* Pm = stP + (slot + 1) * 4096;
#pragma unroll
        for (int s = 0; s < 16; ++s) pn[s] = Pm[(size_t)(4 * s + lq) * 64 + 16 * w + lc];
#pragma unroll
        for (int rr = 0; rr < 4; ++rr) an[rr] = stS[((slot + 1) * 64 + rg * 16 + 4 * lq + rr) * 64 + 16 * w + lc];
      }
#pragma unroll
      for (int s = 0; s < 16; ++s) {
        const float a = cur[lc * 68 + 4 * s + lq];
        acc = __builtin_amdgcn_mfma_f32_16x16x4f32(a, pj[s], acc, 0, 0, 0);
      }
      __syncthreads();
#pragma unroll
      for (int rr = 0; rr < 4; ++rr) {
        cur[(4 * lq + rr) * 68 + 16 * w + lc] = acc[rr];
        stS[(slot * 64 + rg * 16 + 4 * lq + rr) * 64 + 16 * w + lc] = acc[rr];
      }
      __syncthreads();
    }
  }
  __builtin_amdgcn_s_setprio(0);
  {
    const int nidle = (int)gridDim.x > 256 ? (int)gridDim.x - 256 : 0;
    int t0, tstep;
    if (nidle > 0) { t0 = (int)blockIdx.x - 256; tstep = nidle; if (t0 < 0) t0 = 1 << 30; }
    else { t0 = (int)blockIdx.x; tstep = (int)gridDim.x; }
    __syncthreads();
    for (int t = t0; t < 1280; t += tstep) {
      if (t < 1024) transpose_tile(p.da_in, (u16*)(p.ws + OFF_WT_IN1), 1024, N1, t >> 6, t & 63, (float*)smem);
      else { const int j = t - 1024; transpose_tile(p.da_out, (u16*)(p.ws + OFF_WT_OUT1), 1024, 1024, j >> 4, j & 15, (float*)smem); }
    }
  }
}

DI void phase_readout(const Params& p) {
  const int TIDX = ltid();
  const int lane = TIDX & 63, wv = __builtin_amdgcn_readfirstlane(TIDX >> 6);
  const u16* proj = (const u16*)(p.ws + OFF_PROJ);
  const float* bonus = (const float*)(p.ws + OFF_BONUS);
  u16* hb = (u16*)(p.ws + OFF_HB);
  for (int row = blockIdx.x * 4 + wv; row < T_ALL; row += gridDim.x * 4) {
    const float* o = (row < T_LAT) ? (p.out + (size_t)row * 1024) : ((const float*)(p.ws + OFF_OCTX) + (size_t)(row - T_LAT) * 1024);
    bool hp, hn;
    if (row < T_LAT) { const int t = row & 8191; hp = t > 0; hn = t < 8191; } else { const int t = (row - T_LAT) & 255; hp = t > 0; hn = t < 255; }
    const int c0 = lane * 16, hh = lane >> 2;
    float ov[16];
    float s = 0.f;
#pragma unroll
    for (int q = 0; q < 4; ++q) { const f32x4 t = *(const f32x4*)(o + c0 + q * 4); ov[q * 4] = t[0]; ov[q * 4 + 1] = t[1]; ov[q * 4 + 2] = t[2]; ov[q * 4 + 3] = t[3]; s += t[0] + t[1] + t[2] + t[3]; }
    s += __shfl_xor(s, 1); s += __shfl_xor(s, 2);
    const float mean = s * (1.0f / 64.0f);
    float vs = 0.f;
#pragma unroll
    for (int j = 0; j < 16; ++j) { const float dlt = ov[j] - mean; vs += dlt * dlt; }
    vs += __shfl_xor(vs, 1); vs += __shfl_xor(vs, 2);
    const float rstd = rsqrtf(vs * (1.0f / 64.0f) + 64e-5f);
    const float bon = bonus[(size_t)row * 16 + hh] + bonus[(size_t)(T_ALL * 16) + (size_t)row * 16 + hh];
    float vm[16];
    const u16* pr = proj + (size_t)row * N0;
    load_mix8(pr + 2048 + c0, hp, hn, p.rw_mu + 2048 + c0, vm);
    load_mix8(pr + 2048 + c0 + 8, hp, hn, p.rw_mu + 2048 + c0 + 8, vm + 8);
    float gv[16];
    unpack8(*(const u32x4*)(pr + 3072 + c0), gv);
    unpack8(*(const u32x4*)(pr + 3072 + c0 + 8), gv + 8);
    unsigned pk[8];
#pragma unroll
    for (int j = 0; j < 8; ++j) {
      const int ca = c0 + 2 * j, cb = ca + 1;
      const float ya = ((ov[2 * j] - mean) * rstd * p.rw_gn_g[ca] + p.rw_gn_b[ca] + bon * vm[2 * j]) * siluf_(gv[2 * j]);
      const float yb = ((ov[2 * j + 1] - mean) * rstd * p.rw_gn_g[cb] + p.rw_gn_b[cb] + bon * vm[2 * j + 1]) * siluf_(gv[2 * j + 1]);
      pk[j] = pack2(ya, yb);
    }
    u32x4* dd = (u32x4*)(hb + (size_t)row * 1024 + c0);
    dd[0] = u32x4{pk[0], pk[1], pk[2], pk[3]};
    dd[1] = u32x4{pk[4], pk[5], pk[6], pk[7]};
  }
}

DI void phase_qkprep(const Params& p) {
  const int TIDX = ltid();
  const int lane = TIDX & 63, wv = __builtin_amdgcn_readfirstlane(TIDX >> 6);
  const u16* raw = (const u16*)(p.ws + OFF_RAW);
  u16* Qs = (u16*)(p.ws + OFF_QS);
  u16* Ks = (u16*)(p.ws + OFF_KS);
  const float* rope = (const float*)(p.ws + OFF_ROPE);
  const int grp = lane >> 1, axis = lane & 1;
  const bool isq = grp < 16;
  const int hd = (grp & 15) >> 1, comp = grp & 1;
  const float* gain = (isq ? p.da_qn : p.da_kn) + axis * 32;
  for (int row = blockIdx.x * 4 + wv; row < T_ALL; row += gridDim.x * 4) {
    const bool lat = row < T_LAT;
    int b, t;
    if (lat) { b = row >> 13; t = row & 8191; } else { b = (row - T_LAT) >> 8; t = (row - T_LAT) & 255; }
    const u16* src = raw + (size_t)row * 2048 + lane * 32;
    float v[32];
#pragma unroll
    for (int q = 0; q < 4; ++q) unpack8(*(const u32x4*)(src + q * 8), v + q * 8);
    float ss = 0.f;
#pragma unroll
    for (int j = 0; j < 32; ++j) ss += v[j] * v[j];
    ss += __shfl_xor(ss, 1);
    const float rstd = rsqrtf(ss * (1.0f / 64.0f) + 1e-6f);
#pragma unroll
    for (int j = 0; j < 32; ++j) v[j] = v[j] * rstd * gain[j];
    if (lat) {
      const int pos = axis == 0 ? (t >> 6) : (t & 63);
#pragma unroll
      for (int f = 0; f < 16; ++f) {
        const float c = rope[pos * 16 + f], s = rope[2048 + pos * 16 + f];
        const float x1 = v[f], x2 = v[16 + f];
        v[f] = x1 * c - x2 * s; v[16 + f] = x2 * c + x1 * s;
      }
    }
    u16* dst;
    float sc = 1.0f;
    if (isq) {
      if (!lat) continue;
      sc = 0.125f * 1.4426950408889634f;
      dst = Qs + (((size_t)(b * 8 + hd) * 2 + comp) * 8192 + t) * 64 + axis * 32;
    } else {
      const int pp = lat ? 256 + t : t;
      dst = Ks + (((size_t)(b * 8 + hd) * 2 + comp) * LKV + pp) * 64 + axis * 32;
    }
#pragma unroll
    for (int q = 0; q < 4; ++q) {
      u32x4 o = {pack2(v[q * 8] * sc, v[q * 8 + 1] * sc), pack2(v[q * 8 + 2] * sc, v[q * 8 + 3] * sc),
                 pack2(v[q * 8 + 4] * sc, v[q * 8 + 5] * sc), pack2(v[q * 8 + 6] * sc, v[q * 8 + 7] * sc)};
      *(u32x4*)(dst + q * 8) = o;
    }
  }
}

typedef __attribute__((address_space(3))) unsigned* lds_uptr;
typedef __attribute__((address_space(1))) const unsigned* glb_uptr;
DI void dma16(const void* g, char* ldsbase) {
  __builtin_amdgcn_global_load_lds((glb_uptr)(g), (lds_uptr)(ldsbase), 16, 0, 0);
}

DI void attn_issue_tile(const u16* Kg, const u16* Vg, int k0, char* buf, int wv, int lane) {
  asm volatile("" : "+v"(lane));
  const int rr = lane >> 3, cp = lane & 7;
#pragma unroll
  for (int i = 0; i < 4; ++i) {
    const int seg = wv * 4 + i;
    const int c = seg >> 3, key = (seg & 7) * 8 + rr;
    const int sw = (key >> 1) & 7;
    dma16(Kg + ((size_t)c * LKV + k0 + key) * 64 + ((cp ^ sw) << 3), buf + seg * 1024);
    const int e = seg * 8 + rr;
    const int swv = (e >> 1) & 7;
    dma16(Vg + (size_t)e * LKV + k0 + ((cp ^ swv) << 3), buf + 16384 + seg * 1024);
  }
}

DI void phase_attn(const Params& p, char* smem) {
  const int TIDX = ltid();
  const int tid = TIDX, lane = tid & 63, wv = __builtin_amdgcn_readfirstlane(tid >> 6);
  const int r = lane & 31, h = lane >> 5;
  const u16* Qs = (const u16*)(p.ws + OFF_QS);
  const u16* Ks = (const u16*)(p.ws + OFF_KS);
  const u16* Vt = (const u16*)(p.ws + OFF_VT);
  const u16* GB = (const u16*)(p.ws + OFF_GB);
  u16* Y2 = (u16*)(p.ws + OFF_Y2);
  float lam;
  {
    float a = p.da_lam[lane] * p.da_lam[64 + lane];
    float bq = p.da_lam[128 + lane] * p.da_lam[192 + lane];
#pragma unroll
    for (int o = 32; o >= 1; o >>= 1) { a += __shfl_xor(a, o); bq += __shfl_xor(bq, o); }
    lam = __expf(a) - __expf(bq) + 0.35550906759096927f;
  }
  const float one_m_li = 1.0f - 0.35550906759096927f;
  const int sw = (r >> 1) & 7;
  int repa = REP_ATTN; asm volatile("" : "+s"(repa));
  for (int rp = 0; rp < repa; ++rp)
  for (int item = blockIdx.x; item < 1024; item += gridDim.x) {
    const int bh = (item & 7) * 2 + (item >> 9), qt = (item >> 3) & 63;
    const int q0 = qt * 128 + wv * 32;
    const u16* Kg = Ks + (size_t)bh * 2 * LKV * 64;
    const u16* Vg = Vt + (size_t)bh * 128 * LKV;
    __syncthreads();
    attn_issue_tile(Kg, Vg, 0, smem, wv, lane);
    bf16x8 qf[2][4];
#pragma unroll
    for (int c = 0; c < 2; ++c)
#pragma unroll
      for (int s = 0; s < 4; ++s)
        qf[c][s] = *(const bf16x8*)(Qs + (((size_t)bh * 2 + c) * 8192 + q0 + r) * 64 + s * 16 + 8 * h);
    f32x16 O[2][4];
#pragma unroll
    for (int c = 0; c < 2; ++c)
#pragma unroll
      for (int e = 0; e < 4; ++e)
#pragma unroll
        for (int i = 0; i < 16; ++i) O[c][e][i] = 0.f;
    f2 lsum[2] = {f2{0.f, 0.f}, f2{0.f, 0.f}};
#pragma unroll 1
    for (int kt = 0; kt < LKV / 64; ++kt) {
      char* buf = smem + (kt & 1) * 32768;
      asm volatile("s_waitcnt vmcnt(0)" ::: "memory");
      __syncthreads();
      if (kt + 1 < LKV / 64) attn_issue_tile(Kg, Vg, (kt + 1) * 64, smem + ((kt + 1) & 1) * 32768, wv, lane);
      const char* Kb = buf + r * 128;
      const char* Vb = buf + 16384 + r * 128;
      __builtin_amdgcn_s_setprio(1);
#pragma unroll
      for (int sub = 0; sub < 2; ++sub) {
        f32x16 sacc[2];
#pragma unroll
        for (int c = 0; c < 2; ++c) {
#pragma unroll
          for (int i = 0; i < 16; ++i) sacc[c][i] = 0.f;
#pragma unroll
          for (int s = 0; s < 4; ++s) {
            const bf16x8 kf = *(const bf16x8*)(Kb + c * 8192 + sub * 4096 + (((2 * s + h) ^ sw) << 4));
            sacc[c] = MFMA32(kf, qf[c][s], sacc[c]);
          }
        }
#pragma unroll
        for (int c = 0; c < 2; ++c) {
          bf16x8 pf[2];
#pragma unroll
          for (int s = 0; s < 2; ++s) {
            float ps[8];
#pragma unroll
            for (int i = 0; i < 8; ++i) ps[i] = __builtin_amdgcn_exp2f(sacc[c][8 * s + i]);
            lsum[c] += f2{ps[0], ps[1]}; lsum[c] += f2{ps[2], ps[3]}; lsum[c] += f2{ps[4], ps[5]}; lsum[c] += f2{ps[6], ps[7]};
            u32x4 pk = {cvtpk(ps[0], ps[1]), cvtpk(ps[2], ps[3]), cvtpk(ps[4], ps[5]), cvtpk(ps[6], ps[7])};
            pf[s] = __builtin_bit_cast(bf16x8, pk);
          }
#pragma unroll
          for (int e = 0; e < 4; ++e)
#pragma unroll
            for (int s = 0; s < 2; ++s) {
              const bf16x8 vf = *(const bf16x8*)(Vb + e * 4096 + (((sub * 4 + 2 * s + h) ^ sw) << 4));
              O[c][e] = MFMA32(vf, pf[s], O[c][e]);
            }
        }
      }
      __builtin_amdgcn_s_setprio(0);
    }
    float l0 = lsum[0][0] + lsum[0][1], l1 = lsum[1][0] + lsum[1][1];
    l0 += __shfl_xor(l0, 32); l1 += __shfl_xor(l1, 32);
    const float i0 = 1.0f / l0, i1 = lam / l1;
    float ss = 0.f;
#pragma unroll
    for (int e = 0; e < 4; ++e)
#pragma unroll
      for (int i = 0; i < 16; ++i) { const float o = O[0][e][i] * i0 - O[1][e][i] * i1; O[0][e][i] = o; ss += o * o; }
    ss += __shfl_xor(ss, 32);
    const float rstd = rsqrtf(ss * (1.0f / 128.0f) + 1e-5f) * one_m_li;
    const int b = bh >> 3, hd = bh & 7;
    int rl = r; asm volatile("" : "+v"(rl));
    const size_t row = (size_t)b * 8192 + q0 + rl;
#pragma unroll
    for (int e = 0; e < 4; ++e) {
#pragma unroll
      for (int g = 0; g < 4; ++g) {
        const int ee = e * 32 + 8 * g + 4 * h;
        const u32x2 gg = *(const u32x2*)(GB + row * 1024 + hd * 128 + ee);
        const float g0 = bflo(gg[0]), g1 = bfhi(gg[0]), g2 = bflo(gg[1]), g3 = bfhi(gg[1]);
        const f32x4 sl = *(const f32x4*)(p.da_subln + ee);
        const float y0 = O[0][e][4 * g] * rstd * sl[0] * g0;
        const float y1 = O[0][e][4 * g + 1] * rstd * sl[1] * g1;
        const float y2 = O[0][e][4 * g + 2] * rstd * sl[2] * g2;
        const float y3 = O[0][e][4 * g + 3] * rstd * sl[3] * g3;
        *(u32x2*)(Y2 + row * 1024 + hd * 128 + ee) = u32x2{cvtpk(y0, y1), cvtpk(y2, y3)};
      }
      asm volatile("" ::: "memory");
    }
  }
}

#define XB_TMO      128
#define XB_XCNT(j)  (256  + 64 * (j))
#define XB_XSUB(j)  (1280 + 64 * (j))
#define XB_XGEN(j)  (2304 + 64 * (j))
#define XB_TOP      3328
#define XB_TOPGEN   3392
#define XCD_BAR_WORDS 3456
#define XB_SPIN_CAP (1u << 18)
#define LAS __attribute__((address_space(3)))

__device__ __forceinline__ unsigned xb_ld(unsigned* p)              { return __hip_atomic_load(p, __ATOMIC_RELAXED, __HIP_MEMORY_SCOPE_AGENT); }
__device__ __forceinline__ unsigned xb_add(unsigned* p, unsigned v) { return __hip_atomic_fetch_add(p, v, __ATOMIC_RELAXED, __HIP_MEMORY_SCOPE_AGENT); }
__device__ __forceinline__ unsigned xb_xcc_id() { return (unsigned)__builtin_amdgcn_s_getreg((3 << 11) | 20) & 0xFu; }
#define XB_SPIN(cond, bar) do { unsigned _sp = 0; while (cond) { __builtin_amdgcn_s_sleep(1); \
    if ((++_sp & 255u) == 0u) { if (xb_ld(&(bar)[XB_TMO])) break; if (_sp > XB_SPIN_CAP) { atomicAdd(&(bar)[XB_TMO], 1u); break; } } } } while (0)

struct XcdBarrier {
    unsigned* bar; unsigned x;
    volatile LAS unsigned* st;
};

__device__ __forceinline__ XcdBarrier xcd_barrier_post(unsigned* bar, volatile LAS unsigned* st) {
    XcdBarrier b; b.bar = bar; b.x = xb_xcc_id(); b.st = st;
    if (threadIdx.x == 0) (void)xb_add(&bar[XB_XCNT(b.x)], 1u);
    return b;
}
__device__ __forceinline__ void xcd_barrier_complete(unsigned* bar, unsigned x, unsigned& nloc, unsigned& nx) {
    const unsigned G = gridDim.x * gridDim.y * gridDim.z;
    unsigned sum, cnt, mine, sp = 0u;
    for (;;) {
        sum = 0u; cnt = 0u; mine = 0u;
#pragma unroll
        for (unsigned j = 0; j < 16; ++j) { const unsigned c = xb_ld(&bar[XB_XCNT(j)]); sum += c; cnt += (c > 0u) ? 1u : 0u; mine = (j == x) ? c : mine; }
        if (sum == G) break;
        __builtin_amdgcn_s_sleep(1);
        if ((++sp & 255u) == 0u) { if (xb_ld(&bar[XB_TMO])) break; if (sp > XB_SPIN_CAP) { atomicAdd(&bar[XB_TMO], 1u); break; } }
    }
    nloc = mine > 0u ? mine : 1u; nx = cnt > 0u ? cnt : 1u;
}

__device__ __forceinline__ void xcd_barrier(const XcdBarrier& b) {
    asm volatile("s_waitcnt vmcnt(0)" ::: "memory");
    __syncthreads();
    if (threadIdx.x == 0) {
        unsigned* bar = b.bar;
        __builtin_amdgcn_s_waitcnt(0);
        unsigned nloc = b.st[0], nx = b.st[1];
        if (nloc == 0u) { xcd_barrier_complete(bar, b.x, nloc, nx); b.st[0] = nloc; b.st[1] = nx; }
        const unsigned old = xb_add(&bar[XB_XSUB(b.x)], 1u);
        const unsigned gen = old / nloc;
        if (old + 1u == (gen + 1u) * nloc) {
            __builtin_amdgcn_fence(__ATOMIC_RELEASE, "agent");
            asm volatile("s_waitcnt vmcnt(0)" ::: "memory");
            const unsigned og = xb_add(&bar[XB_TOP], 1u);
            const unsigned tg = og / nx;
            if (og + 1u == (tg + 1u) * nx) xb_add(&bar[XB_TOPGEN], 1u);
            else XB_SPIN(xb_ld(&bar[XB_TOPGEN]) == tg, bar);
            __builtin_amdgcn_fence(__ATOMIC_ACQUIRE, "agent");
            xb_add(&bar[XB_XGEN(b.x)], 1u);
            asm volatile("s_waitcnt vmcnt(0)" ::: "memory");
        } else {
            XB_SPIN(xb_ld(&bar[XB_XGEN(b.x)]) == gen, bar);
            __builtin_amdgcn_fence(__ATOMIC_ACQUIRE, "agent");
            asm volatile("s_waitcnt vmcnt(0)" ::: "memory");
        }
    }
    __syncthreads();
}


__global__ void __launch_bounds__(256, 2) fwd_megakernel(Params p) {
  extern __shared__ __attribute__((aligned(16))) char smem[];
  __shared__ uint4 xb_words;
  cg::grid_group grid = cg::this_grid();
  if (threadIdx.x == 0) xb_words = make_uint4(0u, 0u, 0u, 0u);
  __syncthreads();
  XcdBarrier xb = xcd_barrier_post((unsigned*)(p.ws + OFF_BAR), (volatile LAS unsigned*)&xb_words);
  phase_prep(p, smem);
  if (p.ws == nullptr) grid.sync();
  xcd_barrier(xb);
  phase_normmod(p, 0, p.x, p.ctx, true);
  xcd_barrier(xb);
  phase_gemm_wide16<0>(p, smem, (const u16*)(p.ws + OFF_HB), (const u16*)(p.ws + OFF_WT_IN0), 120, N0 / 256);
  phase_gemm<0>(p, smem, (const u16*)(p.ws + OFF_HB), (const u16*)(p.ws + OFF_WT_IN0), T_ALL / 128 - 120, N0 / 128, 120);
  xcd_barrier(xb);
  phase_scan<1>(p, smem);
  xcd_barrier(xb);
  phase_carry(p, smem);
  xcd_barrier(xb);
  phase_scan<2>(p, smem);
  xcd_barrier(xb);
  phase_readout(p);
  xcd_barrier(xb);
  phase_gemm_wide16<1>(p, smem, (const u16*)(p.ws + OFF_HB), (const u16*)(p.ws + OFF_WT_OUT0), 128, 4);
  phase_gemm<1>(p, smem, (const u16*)(p.ws + OFF_HB), (const u16*)(p.ws + OFF_WT_OUT0), T_ALL / 128 - 128, 8, 128);
  xcd_barrier(xb);
  phase_normmod(p, 1, p.out, (const float*)(p.ws + OFF_XC1), false);
  xcd_barrier(xb);
  phase_gemm_wide16<2>(p, smem, (const u16*)(p.ws + OFF_HB), (const u16*)(p.ws + OFF_WT_IN1), 128, N1 / 256);
  phase_gemm<2>(p, smem, (const u16*)(p.ws + OFF_HB), (const u16*)(p.ws + OFF_WT_IN1), T_ALL / 128 - 128, N1 / 128, 128);
  xcd_barrier(xb);
  phase_qkprep(p);
  xcd_barrier(xb);
  phase_attn(p, smem);
  xcd_barrier(xb);
  phase_gemm_wide16<3>(p, smem, (const u16*)(p.ws + OFF_Y2), (const u16*)(p.ws + OFF_WT_OUT1), T_LAT / 128, 4);
}

extern "C" void kernel_launch(void* const* d_in, const int* in_sizes, int n_in, void* d_out, int out_size, void* d_ws,
                              size_t ws_size, hipStream_t stream) {
  static int grid_blocks = 0;
  if (!grid_blocks) {
    int dev = 0, cus = 0, per_cu = 0;
    hipGetDevice(&dev);
    hipDeviceGetAttribute(&cus, hipDeviceAttributeMultiprocessorCount, dev);
    hipFuncSetAttribute((const void*)fwd_megakernel, hipFuncAttributeMaxDynamicSharedMemorySize, LDS_BYTES);
    hipOccupancyMaxActiveBlocksPerMultiprocessor(&per_cu, fwd_megakernel, 256, LDS_BYTES);
    if (per_cu < 1) per_cu = 1;
    if (per_cu > 2) per_cu = 2;
    grid_blocks = cus * per_cu;
    if (ws_size < 256 * MiB) fprintf(stderr, "kernel_launch: workspace too small: %zu\n", ws_size);
  }
  Params p{};
  const float** pp = (const float**)&p;
  for (int i = 0; i < 25; ++i) pp[i] = (const float*)d_in[i];
  p.out = (float*)d_out;
  p.ws = (char*)d_ws;
  hipMemsetAsync((char*)d_ws + OFF_BAR, 0, XCD_BAR_WORDS * sizeof(unsigned), stream);
  void* args[] = {&p};
  hipError_t e = hipLaunchCooperativeKernel((void*)fwd_megakernel, dim3(grid_blocks), dim3(256), args, LDS_BYTES, stream);
  if (e != hipSuccess) fprintf(stderr, "cooperative launch failed: %s (grid %d)\n", hipGetErrorString(e), grid_blocks);
}
```
